# Optimizing an MI355X kernel written in HIP

```python
import math
import jax, jax.numpy as jnp
from jax import lax
import numpy as np

D_MODEL = 1024
BATCH = 8
SEQ = 4096
DEPTH = 2

CHUNK = 64
N_MIXERS = 4
MIX_WIDTH = D_MODEL
GROUP_WIDTH = MIX_WIDTH // N_MIXERS
N_HEADS = 4
HEAD_DIM = GROUP_WIDTH // N_HEADS
CONV_WIDTH = 4
GDN_DK = HEAD_DIM
GDN_DV = HEAD_DIM
DIFF_DH = HEAD_DIM // 2
DIFF_DV = HEAD_DIM
Q_BLOCK = 128
REL_BUCKETS = 32
REL_MAX_DIST = 128
RG_C = 8.0
RG_BLOCKS = N_HEADS
RG_BLOCK_W = GROUP_WIDTH // RG_BLOCKS
GLA_DK = HEAD_DIM // 2
GLA_DV = HEAD_DIM
GLA_RANK = 16
GLA_TAU = 16.0
D_FF = 2816
N_EXPERTS = 8
TOP_K = 2
D_FF_EXPERT = 3584
MOE_BLOCK = 128
N_DENSE = (DEPTH + 1) // 2
N_MOE = DEPTH // 2
EPS = 1e-6

SPLIT_SIZES = (
    N_HEADS * GDN_DK, N_HEADS * GDN_DK, N_HEADS * GDN_DV, N_HEADS * GDN_DV, N_HEADS, N_HEADS,
    N_HEADS * 2 * DIFF_DH, N_HEADS * 2 * DIFF_DH, N_HEADS * DIFF_DV,
    GROUP_WIDTH, GROUP_WIDTH,
    N_HEADS * GLA_DK, N_HEADS * GLA_DK, N_HEADS * GLA_DV, N_HEADS * GLA_DV, GLA_RANK,
)
D_IN = sum(SPLIT_SIZES)
SPLIT_POINTS = tuple(int(v) for v in np.cumsum(SPLIT_SIZES)[:-1])
GDN_CONV_CH = N_HEADS * (2 * GDN_DK + GDN_DV)

kernel_name = 'hybrid_parallel_heads_chunk_causal_encoder'

f32 = jnp.float32


def rmsnorm(x, g):
    xf = x.astype(f32)
    y = xf * lax.rsqrt(jnp.mean(xf * xf, axis=-1, keepdims=True) + EPS)
    return (y * g.astype(f32)).astype(x.dtype)


def l2norm(x):
    return x * lax.rsqrt(jnp.sum(x * x, axis=-1, keepdims=True) + EPS)


def causal_dwconv(x, w):
    S = x.shape[1]
    width = w.shape[0]
    xp = jnp.pad(x, ((0, 0), (width - 1, 0), (0, 0)))
    y = xp[:, 0:S] * w[0]
    for j in range(1, width):
        y = y + xp[:, j:j + S] * w[j]
    return y


def to_chunks(t):
    B, S, H, d = t.shape
    return t.reshape(B, S // CHUNK, CHUNK, H, d).transpose(0, 3, 1, 2, 4)


def from_chunks(t):
    B, H, N, C, d = t.shape
    return t.transpose(0, 2, 3, 1, 4).reshape(B, N * C, H, d)


def gated_deltanet(q, k, v, gate, beta_logit, alpha_in, conv_w, A_log, dt_bias, norm_g):
    B, S, _ = q.shape
    qkv = jax.nn.silu(causal_dwconv(jnp.concatenate([q, k, v], axis=-1), conv_w.astype(f32)))
    q, k, v = jnp.split(qkv, [N_HEADS * GDN_DK, 2 * N_HEADS * GDN_DK], axis=-1)
    q = l2norm(q.reshape(B, S, N_HEADS, GDN_DK)) * GDN_DK ** -0.5
    k = l2norm(k.reshape(B, S, N_HEADS, GDN_DK))
    v = v.reshape(B, S, N_HEADS, GDN_DV)
    beta = jax.nn.sigmoid(beta_logit)[..., None]
    g = (-jnp.exp(A_log.astype(f32)) * jax.nn.softplus(alpha_in + dt_bias.astype(f32)))[..., None]
    qc, kc, vc, bc = to_chunks(q), to_chunks(k), to_chunks(v), to_chunks(beta)
    G = jnp.cumsum(to_chunks(g)[..., 0], axis=-1)
    idx = jnp.arange(CHUNK)
    causal = idx[:, None] >= idx[None, :]
    strict = idx[:, None] > idx[None, :]
    gamma = jnp.exp(jnp.where(causal, G[..., :, None] - G[..., None, :], -jnp.inf))
    kb = kc * bc
    a_kk = jnp.where(strict, jnp.einsum('bhnid,bhnjd->bhnij', kb, kc) * gamma, 0.0)
    rhs = jnp.concatenate([vc * bc, kb * jnp.exp(G)[..., None]], axis=-1)
    sol = lax.linalg.triangular_solve(a_kk, rhs, left_side=True, lower=True, unit_diagonal=True)
    u, w = sol[..., :GDN_DV], sol[..., GDN_DV:]
    a_qk = jnp.einsum('bhnid,bhnjd->bhnij', qc, kc) * gamma
    qg = qc * jnp.exp(G)[..., None]
    g_last = G[..., -1]
    kd = kc * jnp.exp(g_last[..., None] - G)[..., None]
    dl = jnp.exp(g_last)

    def step(state, xs):
        u_, w_, qg_, aqk_, kd_, dl_ = xs
        v_new = u_ - jnp.einsum('bhck,bhkv->bhcv', w_, state)
        o = jnp.einsum('bhck,bhkv->bhcv', qg_, state) + jnp.einsum('bhij,bhjv->bhiv', aqk_, v_new)
        state = dl_[..., None, None] * state + jnp.einsum('bhck,bhcv->bhkv', kd_, v_new)
        return state, o

    xs = tuple(jnp.moveaxis(t, 2, 0) for t in (u, w, qg, a_qk, kd, dl))
    _, o = lax.scan(step, jnp.zeros((B, N_HEADS, GDN_DK, GDN_DV), f32), xs)
    o = from_chunks(jnp.moveaxis(o, 0, 2))
    o = rmsnorm(o, norm_g) * jax.nn.silu(gate.reshape(B, S, N_HEADS, GDN_DV))
    return o.reshape(B, S, N_HEADS * GDN_DV)


def t5_bucket(rel):
    nb = REL_BUCKETS // 2
    bucket = jnp.where(rel > 0, nb, 0)
    n = jnp.abs(rel)
    max_exact = nb // 2
    large = max_exact + (jnp.log(jnp.maximum(n, 1).astype(f32) / max_exact)
                         / math.log(REL_MAX_DIST / max_exact) * (nb - max_exact)).astype(jnp.int32)
    large = jnp.minimum(large, nb - 1)
    return bucket + jnp.where(n < max_exact, n, large)


def diff_attention(q, k, v, lam_vecs, lam_init, rel_bias, norm_g):
    B, S, _ = q.shape
    q = q.reshape(B, S, N_HEADS, 2, DIFF_DH) * DIFF_DH ** -0.5
    k = k.reshape(B, S, N_HEADS, 2, DIFF_DH)
    v = v.reshape(B, S, N_HEADS, DIFF_DV)
    lv = lam_vecs.astype(f32)
    lam = jnp.exp(jnp.sum(lv[0] * lv[1])) - jnp.exp(jnp.sum(lv[2] * lv[3])) + lam_init
    n_qb = S // Q_BLOCK
    qb = q.reshape(B, n_qb, Q_BLOCK, N_HEADS, 2, DIFF_DH).transpose(1, 0, 3, 4, 2, 5)
    kt = k.transpose(0, 2, 3, 1, 4)
    vt = v.transpose(0, 2, 1, 3)
    kpos = jnp.arange(S)
    table = rel_bias.astype(f32)

    def block(args):
        qblk, bi = args
        qpos = bi * Q_BLOCK + jnp.arange(Q_BLOCK)
        bias = table[t5_bucket(kpos[None, :] - qpos[:, None])].transpose(2, 0, 1)[:, None]
        mask = (kpos[None, :] // CHUNK) <= (qpos[:, None] // CHUNK)
        s = jnp.einsum('bhcqd,bhckd->bhcqk', qblk, kt) + bias
        p = jax.nn.softmax(jnp.where(mask, s, -jnp.inf), axis=-1)
        attn = p[:, :, 0] - lam * p[:, :, 1]
        return jnp.einsum('bhqk,bhkd->bhqd', attn, vt)

    o = lax.map(block, (qb, jnp.arange(n_qb)))
    o = o.transpose(1, 0, 3, 2, 4).reshape(B, S, N_HEADS, DIFF_DV)
    o = rmsnorm(o, norm_g) * (1.0 - lam_init)
    return o.reshape(B, S, N_HEADS * DIFF_DV)


def rglru_block(xb, gb, conv_w, conv_b, w_a, b_a, w_x, b_x, a_param):
    B, S, W = xb.shape
    xc = causal_dwconv(xb, conv_w.astype(f32)) + conv_b.astype(f32)
    xh = xc.reshape(B, S, RG_BLOCKS, RG_BLOCK_W)
    gate_a = jax.nn.sigmoid(jnp.einsum('bsnc,ncd->bsnd', xh, w_a.astype(f32)).reshape(B, S, W) + b_a)
    gate_x = jax.nn.sigmoid(jnp.einsum('bsnc,ncd->bsnd', xh, w_x.astype(f32)).reshape(B, S, W) + b_x)
    log_a = -RG_C * gate_a * jax.nn.softplus(a_param.astype(f32))
    a = jnp.exp(log_a)
    u = xc * gate_x * jnp.sqrt(-jnp.expm1(2.0 * log_a))

    def combine(lhs, rhs):
        return (lhs[0] * rhs[0], rhs[0] * lhs[1] + rhs[1])

    _, h = lax.associative_scan(combine, (a, u), axis=1)
    return h * jax.nn.gelu(gb)


def gla(q, k, v, r, lr, w_lr, b_lr, norm_g):
    B, S, _ = q.shape
    q = q.reshape(B, S, N_HEADS, GLA_DK) * GLA_DK ** -0.5
    k = k.reshape(B, S, N_HEADS, GLA_DK)
    v = v.reshape(B, S, N_HEADS, GLA_DV)
    log_alpha = jax.nn.log_sigmoid(lr @ w_lr.astype(f32) + b_lr.astype(f32)) / GLA_TAU
    log_alpha = log_alpha.reshape(B, S, N_HEADS, GLA_DK)
    qc, kc, vc = to_chunks(q), to_chunks(k), to_chunks(v)
    G = jnp.cumsum(to_chunks(log_alpha), axis=3)
    ref = G[:, :, :, CHUNK // 2:CHUNK // 2 + 1]
    idx = jnp.arange(CHUNK)
    causal = idx[:, None] >= idx[None, :]
    a_in = jnp.einsum('bhnid,bhnjd->bhnij', qc * jnp.exp(G - ref), kc * jnp.exp(ref - G))
    o_intra = jnp.einsum('bhnij,bhnjv->bhniv', jnp.where(causal, a_in, 0.0), vc)
    qg = qc * jnp.exp(G)
    g_last = G[:, :, :, -1]
    kd = kc * jnp.exp(g_last[:, :, :, None, :] - G)
    dl = jnp.exp(g_last)

    def step(state, xs):
        qg_, kd_, v_, dl_ = xs
        o = jnp.einsum('bhck,bhkv->bhcv', qg_, state)
        state = dl_[..., :, None] * state + jnp.einsum('bhck,bhcv->bhkv', kd_, v_)
        return state, o

    xs = tuple(jnp.moveaxis(t, 2, 0) for t in (qg, kd, vc, dl))
    _, o_inter = lax.scan(step, jnp.zeros((B, N_HEADS, GLA_DK, GLA_DV), f32), xs)
    o = from_chunks(o_intra + jnp.moveaxis(o_inter, 0, 2))
    o = rmsnorm(o, norm_g) * jax.nn.silu(r.reshape(B, S, N_HEADS, GLA_DV))
    return o.reshape(B, S, N_HEADS * GLA_DV)


def swiglu(h, w_gate, w_up, w_down):
    return (jax.nn.silu(h @ w_gate) * (h @ w_up)) @ w_down


def moe_swiglu(h, w_router, w_gate, w_up, w_down):
    B, S, D = h.shape
    T = B * S
    hf = h.reshape(T, D)
    logits = (hf @ w_router).astype(f32)
    top_logit, top_e = lax.top_k(logits, TOP_K)
    top_w = jax.nn.softmax(top_logit, axis=-1)
    n_assign = T * TOP_K
    flat_e = top_e.reshape(n_assign)
    order = jnp.argsort(flat_e)
    sorted_e = flat_e[order]
    counts = jnp.bincount(flat_e, length=N_EXPERTS)
    padded = (counts + MOE_BLOCK - 1) // MOE_BLOCK * MOE_BLOCK
    pad_end = jnp.cumsum(padded)
    pad_start = pad_end - padded
    grp_start = jnp.cumsum(counts) - counts
    dest = pad_start[sorted_e] + jnp.arange(n_assign) - grp_start[sorted_e]
    n_blocks = -(-n_assign // MOE_BLOCK) + N_EXPERTS
    n_slots = n_blocks * MOE_BLOCK
    slot_tok = jnp.zeros((n_slots,), jnp.int32).at[dest].set((order // TOP_K).astype(jnp.int32))
    slot_w = jnp.zeros((n_slots,), f32).at[dest].set(top_w.reshape(n_assign)[order])
    block_e = jnp.minimum(jnp.searchsorted(pad_end, jnp.arange(n_blocks) * MOE_BLOCK, side='right'),
                          N_EXPERTS - 1)
    xs = hf[slot_tok].reshape(n_blocks, MOE_BLOCK, D)

    def expert_block(args):
        xb, e = args
        return (jax.nn.silu(xb @ w_gate[e]) * (xb @ w_up[e])) @ w_down[e]

    ys = lax.map(expert_block, (xs, block_e)).reshape(n_slots, D)
    y = jnp.zeros((T, D), f32).at[slot_tok].add(ys.astype(f32) * slot_w[:, None])
    return y.astype(h.dtype).reshape(B, S, D)


def setup_inputs(seed: int = 0) -> dict:
    key = jax.random.key(seed)
    k = jax.random.split(key, 30)
    L = DEPTH

    def nrm(i, shape, scale):
        return jax.random.normal(k[i], shape, f32) * scale

    def gain(i, shape):
        return 1.0 + nrm(i, shape, 0.02)

    A_log = jnp.log(jax.random.uniform(k[4], (L, N_HEADS), f32, 1.0, 16.0))
    dt = jnp.exp(jax.random.uniform(k[5], (L, N_HEADS), f32, math.log(1e-3), math.log(1e-1)))
    dt_bias = dt + jnp.log(-jnp.expm1(-dt))
    sp = -0.5 * jnp.log(jax.random.uniform(k[16], (L, GROUP_WIDTH), f32, 0.81, 0.998))
    a_param = jnp.log(jnp.expm1(sp))
    return {
        'x': nrm(0, (BATCH, SEQ, D_MODEL), 1.0),
        'norm_mix': gain(1, (L, D_MODEL)),
        'w_in': nrm(2, (L, D_MODEL, D_IN), D_MODEL ** -0.5),
        'a_conv': nrm(3, (L, CONV_WIDTH, GDN_CONV_CH), CONV_WIDTH ** -0.5),
        'a_A_log': A_log,
        'a_dt_bias': dt_bias,
        'a_norm': gain(6, (L, GDN_DV)),
        'b_lambda': nrm(7, (L, 4, DIFF_DH), 0.1),
        'b_norm': gain(8, (L, DIFF_DV)),
        'rel_bias': nrm(9, (REL_BUCKETS, N_HEADS), 0.5),
        'c_conv_w': nrm(10, (L, CONV_WIDTH, GROUP_WIDTH), CONV_WIDTH ** -0.5),
        'c_conv_b': nrm(11, (L, GROUP_WIDTH), 0.02),
        'c_w_a': nrm(12, (L, RG_BLOCKS, RG_BLOCK_W, RG_BLOCK_W), RG_BLOCK_W ** -0.5),
        'c_b_a': nrm(13, (L, GROUP_WIDTH), 0.1),
        'c_w_x': nrm(14, (L, RG_BLOCKS, RG_BLOCK_W, RG_BLOCK_W), RG_BLOCK_W ** -0.5),
        'c_b_x': nrm(15, (L, GROUP_WIDTH), 0.1),
        'c_a_param': a_param,
        'd_w_lr': nrm(17, (L, GLA_RANK, N_HEADS * GLA_DK), GLA_RANK ** -0.5),
        'd_b_lr': nrm(18, (L, N_HEADS * GLA_DK), 0.1),
        'd_norm': gain(19, (L, GLA_DV)),
        'w_out': nrm(20, (L, MIX_WIDTH, D_MODEL), MIX_WIDTH ** -0.5),
        'norm_ffn': gain(21, (L, D_MODEL)),
        'ffn_w_gate': nrm(22, (N_DENSE, D_MODEL, D_FF), D_MODEL ** -0.5),
        'ffn_w_up': nrm(23, (N_DENSE, D_MODEL, D_FF), D_MODEL ** -0.5),
        'ffn_w_down': nrm(24, (N_DENSE, D_FF, D_MODEL), D_FF ** -0.5),
        'moe_router': nrm(25, (N_MOE, D_MODEL, N_EXPERTS), D_MODEL ** -0.5),
        'moe_w_gate': nrm(26, (N_MOE, N_EXPERTS, D_MODEL, D_FF_EXPERT), D_MODEL ** -0.5),
        'moe_w_up': nrm(27, (N_MOE, N_EXPERTS, D_MODEL, D_FF_EXPERT), D_MODEL ** -0.5),
        'moe_w_down': nrm(28, (N_MOE, N_EXPERTS, D_FF_EXPERT, D_MODEL), D_FF_EXPERT ** -0.5),
        'norm_final': gain(29, (D_MODEL,)),
    }


def reference(x, norm_mix, w_in, a_conv, a_A_log, a_dt_bias, a_norm, b_lambda, b_norm, rel_bias,
              c_conv_w, c_conv_b, c_w_a, c_b_a, c_w_x, c_b_x, c_a_param, d_w_lr, d_b_lr, d_norm,
              w_out, norm_ffn, ffn_w_gate, ffn_w_up, ffn_w_down, moe_router, moe_w_gate, moe_w_up,
              moe_w_down, norm_final):
    for l in range(DEPTH):
        h = rmsnorm(x, norm_mix[l])
        proj = (h @ w_in[l]).astype(f32)
        (qa, ka, va, ga, ba, aa, qb, kb, vb, xc, gc, qd, kd, vd, rd, lrd) = jnp.split(proj, SPLIT_POINTS, axis=-1)
        o_a = gated_deltanet(qa, ka, va, ga, ba, aa, a_conv[l], a_A_log[l], a_dt_bias[l], a_norm[l])
        lam_init = 0.8 - 0.6 * math.exp(-0.3 * l)
        o_b = diff_attention(qb, kb, vb, b_lambda[l], lam_init, rel_bias, b_norm[l])
        o_c = rglru_block(xc, gc, c_conv_w[l], c_conv_b[l], c_w_a[l], c_b_a[l], c_w_x[l], c_b_x[l], c_a_param[l])
        o_d = gla(qd, kd, vd, rd, lrd, d_w_lr[l], d_b_lr[l], d_norm[l])
        mix = jnp.concatenate([o_a, o_b, o_c, o_d], axis=-1).astype(x.dtype)
        x = x + mix @ w_out[l]
        h = rmsnorm(x, norm_ffn[l])
        if l % 2 == 0:
            x = x + swiglu(h, ffn_w_gate[l // 2], ffn_w_up[l // 2], ffn_w_down[l // 2])
        else:
            x = x + moe_swiglu(h, moe_router[l // 2], moe_w_gate[l // 2], moe_w_up[l // 2], moe_w_down[l // 2])
    return rmsnorm(x, norm_final)
```

```cpp
#include <hip/hip_runtime.h>
#include <cstdio>
#include <cstdint>

#ifndef PHMASK
#define PHMASK 0xffff
#endif
#define PHON(k) ((PHMASK >> (k)) & 1)
#ifndef DUMPS
#define DUMPS 0
#endif
#ifndef FINPARTS
#define FINPARTS 7
#endif
#ifndef ABL
#define ABL 0
#endif
#ifndef MK_ONE_LAUNCH
#define MK_ONE_LAUNCH 1
#endif

#define LAS __attribute__((address_space(3)))
#define GAS __attribute__((address_space(1)))
typedef unsigned short bf16;
typedef short bf16x8 __attribute__((ext_vector_type(8)));
typedef short s16x4 __attribute__((ext_vector_type(4)));
typedef float f32x4 __attribute__((ext_vector_type(4)));
typedef float f32x16 __attribute__((ext_vector_type(16)));
typedef unsigned u32x4 __attribute__((ext_vector_type(4)));
typedef unsigned u32x2 __attribute__((ext_vector_type(2)));

constexpr int T = 32768, D = 1024, SEQ = 4096, NB = 8, NCH = 64, CH = 64;
constexpr int PP = 3072;
constexpr int QA = 0, KA = 256, VA = 512, GA = 768, QB = 1024, KB = 1280, VB = 1536, XC = 1792, GC = 2048, QD = 2304, KD = 2432, VD = 2560, RD = 2816;
constexpr int NIN = 3328;
constexpr int DFF = 2816, DFE = 3584, NE = 8;
constexpr float EPS = 1e-6f;
constexpr float LOG2E = 1.4426950408889634f;

constexpr size_t MiB = 1u << 20;
constexpr size_t WS_CTL = 0, CTL_ZERO_BYTES = 1 * MiB;
constexpr size_t WS_STOK = 1 * MiB;
constexpr size_t WS_SW = 3 * MiB;
constexpr size_t WS_WIN = 5 * MiB;
constexpr size_t WS_WOUT = 18 * MiB;
constexpr size_t WS_WGU = 22 * MiB;
constexpr size_t WS_WD = 33 * MiB;
constexpr size_t WS_HM = 39 * MiB;
constexpr size_t WS_SMALL = 103 * MiB;
constexpr size_t WS_PROJ = 107 * MiB;
constexpr size_t WS_TMP = 299 * MiB;
constexpr size_t WS_GM = WS_TMP;
constexpr size_t WS_GN = WS_GM + 32 * MiB;
constexpr size_t WS_GQ = WS_GN + 32 * MiB;
constexpr size_t WS_GO = WS_GQ + 32 * MiB;
constexpr size_t WS_LOI = WS_GO + 32 * MiB;
constexpr size_t WS_LQG = WS_LOI + 32 * MiB;
constexpr size_t WS_LKV = WS_LQG + 16 * MiB;
constexpr size_t WS_RHL = WS_LKV + 16 * MiB;
constexpr size_t WS_RP = WS_RHL + 16 * MiB;
constexpr size_t WS_MISC = WS_RP + 16 * MiB;
constexpr size_t WS_LDL = WS_MISC;
constexpr size_t WS_RAT = WS_MISC + 512 * 1024;
constexpr size_t WS_RHE = WS_RAT + 512 * 1024;
constexpr size_t WS_RCA = WS_RHE + 512 * 1024;
constexpr size_t WS_TMP_END = WS_MISC + 2 * MiB;
constexpr size_t WS_MOEW_GU = 345 * MiB;
constexpr size_t WS_MOEW_D = 457 * MiB;
constexpr size_t WS_END = 513 * MiB;
constexpr size_t WS_NEED = 525 * MiB;
static_assert(WS_TMP_END <= WS_NEED && WS_END <= WS_NEED, "ws map");
static_assert(WS_PROJ + (size_t)34816 * DFE * 2 <= WS_MOEW_GU, "moe act fits under moe weights");
constexpr int CW_TMO = 0;
constexpr int CW_QUEUE = 64;
constexpr int CW_MOECNT = 1024;
constexpr int CW_BAR = 4096;

constexpr int RING_BYTES = 131072;
constexpr int MISC_OFF = RING_BYTES;
constexpr int LDS_BYTES = RING_BYTES + 4096;
constexpr int NWAVES = 8, NTHR = 512;

__device__ __forceinline__ unsigned f2bf(float f) { unsigned u = __builtin_bit_cast(unsigned, f); return (u + 0x7fffu + ((u >> 16) & 1u)) >> 16; }
__device__ __forceinline__ unsigned pk2(float lo, float hi) { return f2bf(lo) | (f2bf(hi) << 16); }
__device__ __forceinline__ float bflo(unsigned w) { return __builtin_bit_cast(float, w << 16); }
__device__ __forceinline__ float bfhi(unsigned w) { return __builtin_bit_cast(float, w & 0xffff0000u); }
__device__ __forceinline__ float bf2f(bf16 b) { return __builtin_bit_cast(float, ((unsigned)b) << 16); }
__device__ __forceinline__ float wave_sum(float v) {
#pragma unroll
    for (int o = 1; o < 64; o <<= 1) v += __shfl_xor(v, o);
    return v;
}
__device__ __forceinline__ float fexp(float x) { return __builtin_amdgcn_exp2f(x * LOG2E); }
__device__ __forceinline__ float sigmoidf_(float x) { return 1.0f / (1.0f + __expf(-x)); }
__device__ __forceinline__ float siluf_(float x) { return x / (1.0f + __expf(-x)); }
__device__ __forceinline__ float softplusf_(float x) { return fmaxf(x, 0.f) + log1pf(__expf(-fabsf(x))); }
__device__ __forceinline__ float gelu_tanh(float x) { const float u = 0.7978845608028654f * (x + 0.044715f * x * x * x); return 0.5f * x * (1.0f + tanhf(u)); }
#define LDS_WAIT() asm volatile("s_waitcnt lgkmcnt(0)" ::: "memory")
#define VM_WAIT() asm volatile("s_waitcnt vmcnt(0)" ::: "memory")

namespace pg8 {
constexpr int BM = 256, BK = 64, HALF = 128, HTB = HALF * BK * 2, STAGE_BYTES = 8 * HTB, NXCD = 8, WGM = 8;
__host__ __device__ __forceinline__ int lds_byte(int r, int c) { const int st = (r >> 4) * 2 + (c >> 5), rr = r & 15, cc = c & 31, ob = rr * 64 + cc * 2; return st * 1024 + (ob ^ (((ob >> 9) & 1) << 5)); }
__host__ __device__ __forceinline__ void stage_rc(int b, int& R, int& C) { const int st = b / 1024, sb = b % 1024, swz = sb ^ (((sb >> 9) & 1) << 5); R = (st >> 1) * 16 + swz / 64; C = (st & 1) * 32 + (swz % 64) / 2; }
__host__ __device__ __forceinline__ int perm32(int rho) { const int n = rho >> 4, i = rho & 15; return 8 * (i >> 2) + 4 * n + (i & 3); }

struct Unit { int pm, pn, e, vr, lbase; };

struct StaticOrder {
    int nM, nN, nwg, G, c;
    __device__ void init(int M, int N, int G_, int c_) { nM = M / BM; nN = N / BM; nwg = nM * nN; G = G_; c = c_; }
    __device__ bool next(int i, Unit& u) const {
        const long L = (long)i * G + c; if (L >= nwg) return false;
        int wgid = (int)L; { const int q = nwg / NXCD, r = nwg % NXCD, xcd = wgid % NXCD, off = wgid / NXCD; wgid = (xcd < r ? xcd * (q + 1) : r * (q + 1) + (xcd - r) * q) + off; }
        const int nig = WGM * nN, gid = wgid / nig, fm = gid * WGM, gsz = (nM - fm) < WGM ? (nM - fm) : WGM;
        u.pm = fm + ((wgid % nig) % gsz); u.pn = (wgid % nig) / gsz; u.e = 0; u.vr = 256; u.lbase = 0; return true;
    }
};
struct MoeOrder {
    int pre[9], cnt[8], nN, G, c, total;
    __device__ void init(const unsigned* gcnt, int nN_, int G_, int c_) {
        int p = 0;
#pragma unroll
        for (int e = 0; e < 8; ++e) { cnt[e] = (int)__hip_atomic_load(gcnt + e, __ATOMIC_RELAXED, __HIP_MEMORY_SCOPE_AGENT); pre[e] = p; p += (cnt[e] + 255) >> 8; }
        pre[8] = p; nN = nN_; G = G_; c = c_; total = p * nN_;
    }
    __device__ bool next(int i, Unit& u) const {
        const long L = (long)i * G + c; if (L >= total) return false;
        const int pm = (int)(L / nN), pl = (int)(L % nN); int e = 0;
#pragma unroll
        for (int j = 1; j < 8; ++j) if (pm >= pre[j]) e = j;
        int pe = 0, ce = 0;
#pragma unroll
        for (int j = 0; j < 8; ++j) if (j == e) { pe = pre[j]; ce = cnt[j]; }
        const int lt = pm - pe, rem = ce - lt * 256;
        u.pm = pm; u.pn = e * nN + pl; u.e = e; u.vr = rem < 256 ? rem : 256; u.lbase = e * T + lt * 256; return true;
    }
};

__device__ __forceinline__ unsigned cvt_pk_bf16(float lo, float hi) { unsigned r; asm volatile("v_cvt_pk_bf16_f32 %0, %1, %2" : "=v"(r) : "v"(lo), "v"(hi)); return r; }

struct EpiProj {
    static constexpr bool PERM = true;
    bf16* P; float* SM;
    __device__ __forceinline__ void operator()(const f32x4 (&acc)[2][2][4][2], const Unit& u, int wr, int wc, int fr, int fq) const {
        const int row0 = u.pm * BM + wr * 64 + fr;
        if (u.pn < 12) {
            const int col0 = u.pn * BM + wc * 32 + 8 * fq;
#pragma unroll
            for (int ai = 0; ai < 2; ++ai)
#pragma unroll
                for (int m = 0; m < 4; ++m) { bf16* rowp = P + (size_t)(row0 + ai * HALF + m * 16) * PP + col0;
#pragma unroll
                    for (int bj = 0; bj < 2; ++bj) { const f32x4 v0 = acc[ai][bj][m][0], v1 = acc[ai][bj][m][1];
                        u32x4 w; w.x = cvt_pk_bf16(v0[0], v0[1]); w.y = cvt_pk_bf16(v0[2], v0[3]); w.z = cvt_pk_bf16(v1[0], v1[1]); w.w = cvt_pk_bf16(v1[2], v1[3]);
                        *(u32x4*)(rowp + bj * HALF) = w; } }
        } else if (wc == 0) {
#pragma unroll
            for (int ai = 0; ai < 2; ++ai)
#pragma unroll
                for (int m = 0; m < 4; ++m) { float* sp = SM + (size_t)(row0 + ai * HALF + m * 16) * 32 + 8 * fq;
                    *(f32x4*)sp = acc[ai][0][m][0]; *(f32x4*)(sp + 4) = acc[ai][0][m][1]; }
        }
    }
};
struct EpiResid {
    static constexpr bool PERM = false;
    const float* res; float* out;
    __device__ __forceinline__ void operator()(const f32x4 (&acc)[2][2][4][2], const Unit& u, int wr, int wc, int fr, int fq) const {
        const int row0 = u.pm * BM + wr * 64 + fr, col0 = u.pn * BM + wc * 32 + 4 * fq;
#pragma unroll
        for (int ai = 0; ai < 2; ++ai)
#pragma unroll
            for (int m = 0; m < 4; ++m) { const size_t off = (size_t)(row0 + ai * HALF + m * 16) * D + col0;
#pragma unroll
                for (int bj = 0; bj < 2; ++bj)
#pragma unroll
                    for (int n = 0; n < 2; ++n) { const size_t o = off + bj * HALF + n * 16; *(f32x4*)(out + o) = *(const f32x4*)(res + o) + acc[ai][bj][m][n]; }
                asm volatile("" ::: "memory"); }
    }
};
struct EpiSwiglu {
    static constexpr bool PERM = true;
    bf16* act; int ldc, nN;
    __device__ __forceinline__ void operator()(const f32x4 (&acc)[2][2][4][2], const Unit& u, int wr, int wc, int fr, int fq) const {
        const int pl = u.pn % nN;
        const int row0 = u.pm * BM + wr * 64 + fr, col0 = pl * HALF + wc * 32 + 8 * fq;
#pragma unroll
        for (int ai = 0; ai < 2; ++ai)
#pragma unroll
            for (int m = 0; m < 4; ++m) { bf16* rowp = act + (size_t)(row0 + ai * HALF + m * 16) * ldc + col0;
                float o[8];
#pragma unroll
                for (int n = 0; n < 2; ++n)
#pragma unroll
                    for (int j = 0; j < 4; ++j) { const float g = acc[ai][0][m][n][j], up = acc[ai][1][m][n][j];
                        o[4 * n + j] = g * up * __builtin_amdgcn_rcpf(1.0f + __builtin_amdgcn_exp2f(-g * LOG2E)); }
                u32x4 w; w.x = cvt_pk_bf16(o[0], o[1]); w.y = cvt_pk_bf16(o[2], o[3]); w.z = cvt_pk_bf16(o[4], o[5]); w.w = cvt_pk_bf16(o[6], o[7]);
                *(u32x4*)rowp = w; asm volatile("" ::: "memory"); }
    }
};
struct EpiScatter {
    static constexpr bool PERM = false;
    float* x; const int* tok; const float* wgt; int nN;
    __device__ __forceinline__ void operator()(const f32x4 (&acc)[2][2][4][2], const Unit& u, int wr, int wc, int fr, int fq) const {
        const int pl = u.pn % nN;
        const int rl0 = wr * 64 + fr, col0 = pl * BM + wc * 32 + 4 * fq;
#pragma unroll
        for (int ai = 0; ai < 2; ++ai)
#pragma unroll
            for (int m = 0; m < 4; ++m) { const int rl = rl0 + ai * HALF + m * 16;
                if (rl < u.vr) { const int t = tok[u.lbase + rl]; const float w = wgt[u.lbase + rl]; float* xp = x + (size_t)t * D + col0;
#pragma unroll
                    for (int bj = 0; bj < 2; ++bj)
#pragma unroll
                        for (int n = 0; n < 2; ++n) { f32x4* p = (f32x4*)(xp + bj * HALF + n * 16); *p = *p + acc[ai][bj][m][n] * w; } }
                asm volatile("" ::: "memory"); }
    }
};

template <class Epi, class Sched, bool GATHER>
__device__ __forceinline__ void gemm_phase(LAS unsigned char* lds, const bf16* A, const bf16* Bt, const int K, const Sched& S, const Epi& E, const int* glist) {
    int tid_ = threadIdx.x; asm volatile("" : "+v"(tid_));
    const int tid = tid_, wid = __builtin_amdgcn_readfirstlane(tid >> 6), lane = tid & 63, wr = wid >> 2, wc = wid & 3, fr = lane & 15, fq = lane >> 4;
    const int nt = K / BK;
    unsigned voffA[2], voffB[2]; int gR[2], gC[2];
#pragma unroll
    for (int i = 0; i < 2; ++i) { int R, C; stage_rc(tid * 16 + i * 8192, R, C); const int Rb = Epi::PERM ? ((R & ~31) + perm32(R & 31)) : R;
        voffA[i] = (unsigned)(R * K + C) * 2u; voffB[i] = (unsigned)(Rb * K + C) * 2u; gR[i] = R; gC[i] = C; }
    const size_t kstep = (size_t)(BK * 2);
    const size_t hstep = (size_t)HALF * K * 2;
    const size_t tstep = 2 * hstep;
    const unsigned ldsw = (unsigned)wid * 1024u;
    const int aoff = lds_byte(wr * 64 + fr, fq * 8), boff = lds_byte(wc * 32 + fr, fq * 8);
#define PG8_SA(b, h) (((b) * 2 + (h)) * HTB)
#define PG8_SB(b, h) ((4 + (b) * 2 + (h)) * HTB)
#define PG8_STAGE(bufoff, gbase, voff) do { _Pragma("unroll") for (int _i = 0; _i < 2; ++_i) \
        __builtin_amdgcn_global_load_lds((const unsigned*)((const char*)(gbase) + (voff)[_i]), (LAS unsigned*)(lds + (bufoff) + ldsw + _i * 8192), 16, 0, 0); } while (0)
#define PG8_STAGE_A(b, h, ubase, koff, OFFS) do { if constexpr (GATHER) { PG8_STAGE(PG8_SA(b, h), (const char*)A + (koff), (OFFS)[h]); } \
        else { PG8_STAGE(PG8_SA(b, h), (ubase) + (size_t)(h) * hstep + (koff), voffA); } } while (0)
#define PG8_LDA(dst, b, h) do { _Pragma("unroll") for (int m = 0; m < 4; ++m) _Pragma("unroll") for (int k = 0; k < 2; ++k) dst[m][k] = *(const LAS bf16x8*)(lds + PG8_SA(b, h) + aoff + m * 2048 + k * 1024); } while (0)
#define PG8_LDB(dst, b, h) do { _Pragma("unroll") for (int n = 0; n < 2; ++n) _Pragma("unroll") for (int k = 0; k < 2; ++k) dst[n][k] = *(const LAS bf16x8*)(lds + PG8_SB(b, h) + boff + n * 2048 + k * 1024); } while (0)
#define PG8_MMA(ai, bj, At, Bt_) do { __builtin_amdgcn_s_setprio(1); _Pragma("unroll") for (int m = 0; m < 4; ++m) _Pragma("unroll") for (int n = 0; n < 2; ++n) _Pragma("unroll") for (int k = 0; k < 2; ++k) \
        acc[ai][bj][m][n] = __builtin_amdgcn_mfma_f32_16x16x32_bf16(Bt_[n][k], At[m][k], acc[ai][bj][m][n], 0, 0, 0); __builtin_amdgcn_s_setprio(0); } while (0)
#define PG8_WAIT_V(n) asm volatile("s_waitcnt vmcnt(" #n ")" ::: "memory")
#define PG8_WAIT_L(n) asm volatile("s_waitcnt lgkmcnt(" #n ")" ::: "memory")
#define PG8_BAR __builtin_amdgcn_s_barrier()
#define PG8_SCHED __builtin_amdgcn_sched_barrier(0)
#define PG8_GOFF(dst, U) do { _Pragma("unroll") for (int _h = 0; _h < 2; ++_h) _Pragma("unroll") for (int _i = 0; _i < 2; ++_i) { const int _row = _h * HALF + gR[_i]; \
        const int _tk = (_row < (U).vr) ? glist[(U).lbase + _row] : 0; dst[_h][_i] = (unsigned)(_tk * K + gC[_i]) * 2u; } } while (0)
    Unit cur, nxt; int ui = 0;
    if (!S.next(0, cur)) return;
    f32x4 acc[2][2][4][2];
#pragma unroll
    for (int a = 0; a < 2; ++a)
#pragma unroll
        for (int b = 0; b < 2; ++b)
#pragma unroll
            for (int m = 0; m < 4; ++m)
#pragma unroll
                for (int n = 0; n < 2; ++n) acc[a][b][m][n] = (f32x4){0.f, 0.f, 0.f, 0.f};
    bf16x8 At[4][2], B0[2][2], B1[2][2];
    unsigned gofc[2][2] = {{0u, 0u}, {0u, 0u}}, gofn[2][2] = {{0u, 0u}, {0u, 0u}};
    if constexpr (GATHER) { PG8_GOFF(gofc, cur); }
    const char* cA = (const char*)A + (size_t)cur.pm * tstep; const char* cB = (const char*)Bt + (size_t)cur.pn * tstep;
    PG8_STAGE(PG8_SB(0, 0), cB, voffB); PG8_STAGE(PG8_SB(0, 1), cB + hstep, voffB); PG8_STAGE_A(0, 0, cA, 0, gofc); PG8_STAGE_A(0, 1, cA, 0, gofc);
    if (wr == 1) PG8_BAR;
    PG8_WAIT_V(2); PG8_BAR;
    PG8_STAGE(PG8_SB(1, 0), cB + kstep, voffB); PG8_STAGE_A(1, 0, cA, kstep, gofc); PG8_STAGE(PG8_SB(1, 1), cB + hstep + kstep, voffB);
    PG8_WAIT_V(6); PG8_BAR;
    for (;;) {
        const bool has_next = S.next(ui + 1, nxt);
        const char* nA = has_next ? (const char*)A + (size_t)nxt.pm * tstep : cA; const char* nB = has_next ? (const char*)Bt + (size_t)nxt.pn * tstep : cB;
        if constexpr (GATHER) { if (has_next) { PG8_GOFF(gofn, nxt); } else {
#pragma unroll
            for (int h = 0; h < 2; ++h)
#pragma unroll
                for (int i = 0; i < 2; ++i) gofn[h][i] = gofc[h][i]; } }
        for (int t = 0; t < nt; t += 2) {
            const bool last = (t == nt - 2);
            const size_t k1 = (size_t)(t + 1) * kstep;
            const char* ua2 = last ? nA : cA; const size_t k2 = last ? 0 : (size_t)(t + 2) * kstep; const size_t k3 = k2 + kstep;
            const char* b2 = last ? nB : cB + (size_t)(t + 2) * kstep; const char* b3 = b2 + kstep;
            unsigned go2[2][2];
#pragma unroll
            for (int h = 0; h < 2; ++h)
#pragma unroll
                for (int i = 0; i < 2; ++i) go2[h][i] = last ? gofn[h][i] : gofc[h][i];
            PG8_LDB(B0, 0, 0); PG8_LDB(B1, 0, 1); PG8_SCHED; PG8_LDA(At, 0, 0); PG8_STAGE_A(1, 1, cA, k1, gofc);
            PG8_WAIT_V(8); PG8_WAIT_L(0); PG8_BAR; PG8_MMA(0, 0, At, B0); PG8_MMA(0, 1, At, B1); PG8_BAR; PG8_SCHED;
            PG8_LDA(At, 0, 1); PG8_STAGE(PG8_SB(0, 0), b2, voffB); PG8_STAGE(PG8_SB(0, 1), b2 + hstep, voffB); PG8_STAGE_A(0, 0, ua2, k2, go2);
            PG8_WAIT_V(8); PG8_WAIT_L(0); PG8_BAR; PG8_MMA(1, 0, At, B0); PG8_MMA(1, 1, At, B1); PG8_BAR; PG8_SCHED;
            PG8_LDB(B0, 1, 0); PG8_LDB(B1, 1, 1); PG8_SCHED; PG8_LDA(At, 1, 0); PG8_STAGE_A(0, 1, ua2, k2, go2);
            PG8_WAIT_V(8); PG8_WAIT_L(0); PG8_BAR; PG8_MMA(0, 0, At, B0); PG8_MMA(0, 1, At, B1); PG8_BAR; PG8_SCHED;
            PG8_LDA(At, 1, 1); PG8_STAGE(PG8_SB(1, 0), b3, voffB); PG8_STAGE(PG8_SB(1, 1), b3 + hstep, voffB); PG8_STAGE_A(1, 0, ua2, k3, go2);
            PG8_WAIT_V(8); PG8_WAIT_L(0); PG8_BAR; PG8_MMA(1, 0, At, B0); PG8_MMA(1, 1, At, B1); PG8_BAR; PG8_SCHED;
        }
        if (wr == 0) PG8_BAR;
        E(acc, cur, wr, wc, fr, fq);
        if (!has_next) break;
#pragma unroll
        for (int a = 0; a < 2; ++a)
#pragma unroll
            for (int b = 0; b < 2; ++b)
#pragma unroll
                for (int m = 0; m < 4; ++m)
#pragma unroll
                    for (int n = 0; n < 2; ++n) acc[a][b][m][n] = (f32x4){0.f, 0.f, 0.f, 0.f};
        cur = nxt; cA = nA; cB = nB; ++ui;
#pragma unroll
        for (int h = 0; h < 2; ++h)
#pragma unroll
            for (int i = 0; i < 2; ++i) gofc[h][i] = gofn[h][i];
        if (wr == 1) PG8_BAR;
    }
    PG8_WAIT_V(0);
    PG8_BAR;
#undef PG8_SA
#undef PG8_SB
#undef PG8_STAGE
#undef PG8_STAGE_A
#undef PG8_LDA
#undef PG8_LDB
#undef PG8_MMA
#undef PG8_WAIT_V
#undef PG8_WAIT_L
#undef PG8_BAR
#undef PG8_SCHED
#undef PG8_GOFF
}
}

#define XB_TMO      128
#define XB_XCNT(j)  (256  + 64 * (j))
#define XB_XSUB(j)  (1280 + 64 * (j))
#define XB_XGEN(j)  (2304 + 64 * (j))
#define XB_TOP      3328
#define XB_TOPGEN   3392
#define XCD_BAR_WORDS 3456
#define XB_SPIN_CAP (1u << 18)
__device__ __forceinline__ unsigned xb_ld(unsigned* p)              { return __hip_atomic_load(p, __ATOMIC_RELAXED, __HIP_MEMORY_SCOPE_AGENT); }
__device__ __forceinline__ unsigned xb_add(unsigned* p, unsigned v) { return __hip_atomic_fetch_add(p, v, __ATOMIC_RELAXED, __HIP_MEMORY_SCOPE_AGENT); }
__device__ __forceinline__ unsigned xb_xcc_id() { return (unsigned)__builtin_amdgcn_s_getreg((3 << 11) | 20) & 0xFu; }
#define XB_SPIN(cond, bar) do { unsigned _sp = 0; while (cond) { __builtin_amdgcn_s_sleep(1); \
    if ((++_sp & 255u) == 0u) { if (xb_ld(&(bar)[XB_TMO])) break; if (_sp > XB_SPIN_CAP) { atomicAdd(&(bar)[XB_TMO], 1u); break; } } } } while (0)
struct XcdBarrier { unsigned* bar; unsigned x; volatile LAS unsigned* st; };
__device__ __forceinline__ XcdBarrier xcd_barrier_post(unsigned* bar, volatile LAS unsigned* st) {
    XcdBarrier b; b.bar = bar; b.x = xb_xcc_id(); b.st = st;
    if (threadIdx.x == 0) (void)xb_add(&bar[XB_XCNT(b.x)], 1u);
    return b;
}
__device__ __forceinline__ void xcd_barrier_complete(unsigned* bar, unsigned x, unsigned& nloc, unsigned& nx) {
    const unsigned G = gridDim.x * gridDim.y * gridDim.z;
    unsigned sum, cnt, mine, sp = 0u;
    for (;;) {
        sum = 0u; cnt = 0u; mine = 0u;
#pragma unroll
        for (unsigned j = 0; j < 16; ++j) { const unsigned c = xb_ld(&bar[XB_XCNT(j)]); sum += c; cnt += (c > 0u) ? 1u : 0u; mine = (j == x) ? c : mine; }
        if (sum == G) break;
        __builtin_amdgcn_s_sleep(1);
        if ((++sp & 255u) == 0u) { if (xb_ld(&bar[XB_TMO])) break; if (sp > XB_SPIN_CAP) { atomicAdd(&bar[XB_TMO], 1u); break; } }
    }
    nloc = mine > 0u ? mine : 1u; nx = cnt > 0u ? cnt : 1u;
}
__device__ __forceinline__ void xcd_barrier(const XcdBarrier& b) {
    asm volatile("s_waitcnt vmcnt(0)" ::: "memory");
    __syncthreads();
    if (threadIdx.x == 0) {
        unsigned* bar = b.bar;
        __builtin_amdgcn_s_waitcnt(0);
        unsigned nloc = b.st[0], nx = b.st[1];
        if (nloc == 0u) { xcd_barrier_complete(bar, b.x, nloc, nx); b.st[0] = nloc; b.st[1] = nx; }
        const unsigned old = xb_add(&bar[XB_XSUB(b.x)], 1u);
        const unsigned gen = old / nloc;
        if (old + 1u == (gen + 1u) * nloc) {
            __builtin_amdgcn_fence(__ATOMIC_RELEASE, "agent");
            asm volatile("s_waitcnt vmcnt(0)" ::: "memory");
            const unsigned og = xb_add(&bar[XB_TOP], 1u);
            const unsigned tg = og / nx;
            if (og + 1u == (tg + 1u) * nx) xb_add(&bar[XB_TOPGEN], 1u);
            else XB_SPIN(xb_ld(&bar[XB_TOPGEN]) == tg, bar);
            __builtin_amdgcn_fence(__ATOMIC_ACQUIRE, "agent");
            xb_add(&bar[XB_XGEN(b.x)], 1u);
            asm volatile("s_waitcnt vmcnt(0)" ::: "memory");
        } else {
            XB_SPIN(xb_ld(&bar[XB_XGEN(b.x)]) == gen, bar);
            __builtin_amdgcn_fence(__ATOMIC_ACQUIRE, "agent");
            asm volatile("s_waitcnt vmcnt(0)" ::: "memory");
        }
    }
    __syncthreads();
}


struct Frame {
    LAS unsigned char* lds;
    volatile LAS unsigned* MISC;
    unsigned* ctl;
    int tid, lane, wave, G, bid;
    const float* const* in;
    float* out; unsigned char* ws;
};

template <class P> __device__ __forceinline__ P lptr(P p) { unsigned long long v = (unsigned long long)p; unsigned lo = (unsigned)v, hi = (unsigned)(v >> 32); asm volatile("" : "+v"(lo), "+v"(hi));
    lo = __builtin_amdgcn_readfirstlane(lo); hi = __builtin_amdgcn_readfirstlane(hi); return (P)(((unsigned long long)hi << 32) | lo); }
__device__ __forceinline__ Frame opq(Frame F) { asm volatile("" : "+v"(F.tid));  F.lane = F.tid & 63; F.wave = __builtin_amdgcn_readfirstlane(F.tid >> 6); return F; }

template <bool TA, bool TB>
__device__ __forceinline__ f32x4 mm16(const LAS float* A, int lda, const LAS float* B, int ldb, int i0, int j0, int K, f32x4 acc, int lane) {
    const int lr = lane & 15, lg = lane >> 4;
    for (int ks = 0; ks < K; ks += 4) {
        const int k = ks + lg;
        const float a = TA ? A[k * lda + i0 + lr] : A[(i0 + lr) * lda + k];
        const float b = TB ? B[(j0 + lr) * ldb + k] : B[k * ldb + j0 + lr];
        acc = __builtin_amdgcn_mfma_f32_16x16x4f32(a, b, acc, 0, 0, 0);
    }
    asm volatile("s_nop 15\n\ts_nop 7" : "+v"(acc));
    return acc;
}

__device__ __forceinline__ void tr_item(const float* src, int ld, int scol, bf16* WT, int K, int r0, int k0, LAS float* scr, int lane) {
#pragma unroll 8
    for (int i = 0; i < 32; ++i) { const int kk = 2 * i + (lane >> 5); const float v = scol >= 0 ? src[(size_t)(k0 + kk) * ld + scol] : 0.f; scr[kk * 33 + (lane & 31)] = v; }
    LDS_WAIT(); asm volatile("" ::: "memory");
    const int c = lane & 7;
#pragma unroll
    for (int j = 0; j < 4; ++j) { const int n = (lane >> 3) + 8 * j; const LAS float* s = scr + (8 * c) * 33 + n;
        u32x4 o; o.x = pk2(s[0 * 33], s[1 * 33]); o.y = pk2(s[2 * 33], s[3 * 33]); o.z = pk2(s[4 * 33], s[5 * 33]); o.w = pk2(s[6 * 33], s[7 * 33]);
        *(u32x4*)(WT + (size_t)(r0 + n) * K + k0 + 8 * c) = o; }
    LDS_WAIT(); asm volatile("" ::: "memory");
}

__device__ __forceinline__ void norm_row(const float* xrow, const f32x4 (&g)[4], bf16* orow, f32x4 (&v)[4], int lane) {
    const f32x4* xr = (const f32x4*)xrow + lane; float s = 0.f;
#pragma unroll
    for (int j = 0; j < 4; ++j) { v[j] = xr[64 * j]; s += (v[j].x * v[j].x + v[j].y * v[j].y) + (v[j].z * v[j].z + v[j].w * v[j].w); }
    const float r = 1.0f / sqrtf(wave_sum(s) * (1.f / D) + EPS);
    unsigned long long* o8 = (unsigned long long*)orow + lane;
#pragma unroll
    for (int j = 0; j < 4; ++j) { v[j] = v[j] * r * g[j]; o8[64 * j] = (unsigned long long)pk2(v[j].x, v[j].y) | ((unsigned long long)pk2(v[j].z, v[j].w) << 32); }
}

__device__ __forceinline__ void p0_prologue(const Frame& F0) { Frame F = opq(F0);
    LAS float* scr = (LAS float*)(F.lds + F.wave * 16384);
    const int gw = F.bid * NWAVES + F.wave, NGW = F.G * NWAVES;
    const float* w_in = F.in[2]; const float* w_out = F.in[20]; const float* fg = F.in[22]; const float* fu = F.in[23]; const float* fd = F.in[24];
    bf16* Win = (bf16*)(F.ws + WS_WIN); bf16* Wout = (bf16*)(F.ws + WS_WOUT); bf16* Wgu = (bf16*)(F.ws + WS_WGU); bf16* Wd = (bf16*)(F.ws + WS_WD);
    constexpr int I_IN = 2 * 16 * 104, I_OUT = 2 * 16 * 32, I_GU = 16 * 176, I_D = 44 * 32;
    const int j = F.lane & 31;
    for (int it = gw; it < I_IN + I_OUT + I_GU + I_D; it += NGW) {
        int r = it;
        if (r < I_IN) { const int l = r / (16 * 104), q = r % (16 * 104), kb = q / 104, nb = q % 104, n = 32 * nb + j;
            const int scol = n < 1024 ? n : n < 3072 ? n + 8 : n < 3080 ? n - 2048 : n < 3096 ? n : -1;
            tr_item(w_in + (size_t)l * D * 3096, 3096, scol, Win + (size_t)l * NIN * D, D, 32 * nb, 64 * kb, scr, F.lane); continue; }
        r -= I_IN;
        if (r < I_OUT) { const int l = r / 512, q = r % 512, kb = q / 32, nb = q % 32;
            tr_item(w_out + (size_t)l * D * D, D, 32 * nb + j, Wout + (size_t)l * D * D, D, 32 * nb, 64 * kb, scr, F.lane); continue; }
        r -= I_OUT;
        if (r < I_GU) { const int kb = r / 176, nb = r % 176, r0 = 32 * nb, pn = r0 >> 8, j0 = r0 & 255;
            tr_item(j0 < 128 ? fg : fu, DFF, pn * 128 + (j0 & 127) + j, Wgu, D, r0, 64 * kb, scr, F.lane); continue; }
        r -= I_GU;
        { const int kb = r / 32, nb = r % 32; tr_item(fd, D, 32 * nb + j, Wd, DFF, 32 * nb, 64 * kb, scr, F.lane); }
    }
    f32x4 g[4];
#pragma unroll
    for (int q = 0; q < 4; ++q) g[q] = ((const f32x4*)F.in[1])[F.lane + 64 * q];
    bf16* H = (bf16*)(F.ws + WS_HM);
    for (int m = gw; m < T; m += NGW) { f32x4 v[4]; norm_row(F.in[0] + (size_t)m * D, g, H + (size_t)m * D, v, F.lane); }
}
__device__ __forceinline__ void moe_convert(const Frame& F0) { Frame F = opq(F0);
    LAS float* scr = (LAS float*)(F.lds + F.wave * 16384);
    const int gw = F.bid * NWAVES + F.wave, NGW = F.G * NWAVES;
    const float* mg = F.in[26]; const float* mu = F.in[27]; const float* md = F.in[28];
    bf16* Wgu = (bf16*)(F.ws + WS_MOEW_GU); bf16* Wd = (bf16*)(F.ws + WS_MOEW_D);
    constexpr int I_GU = 16 * 224, I_D = 56 * 32;
    const int j = F.lane & 31;
    for (int it = gw; it < NE * (I_GU + I_D); it += NGW) {
        const int e = it / (I_GU + I_D); int r = it % (I_GU + I_D);
        if (r < I_GU) { const int kb = r / 224, nb = r % 224, r0 = 32 * nb, pn = r0 >> 8, j0 = r0 & 255;
            tr_item((j0 < 128 ? mg : mu) + (size_t)e * D * DFE, DFE, pn * 128 + (j0 & 127) + j, Wgu + (size_t)e * 7168 * D, D, r0, 64 * kb, scr, F.lane); continue; }
        r -= I_GU;
        { const int kb = r / 32, nb = r % 32; tr_item(md + (size_t)e * DFE * D, D, 32 * nb + j, Wd + (size_t)e * D * DFE, DFE, 32 * nb, 64 * kb, scr, F.lane); }
    }
}

__device__ __forceinline__ void norm_phase(const Frame& F0, const float* x, const float* gain) { Frame F = opq(F0);
    const int gw = F.bid * NWAVES + F.wave, NGW = F.G * NWAVES;
    f32x4 g[4];
#pragma unroll
    for (int q = 0; q < 4; ++q) g[q] = ((const f32x4*)gain)[F.lane + 64 * q];
    bf16* H = (bf16*)(F.ws + WS_HM);
    for (int m = gw; m < T; m += NGW) { f32x4 v[4]; norm_row(x + (size_t)m * D, g, H + (size_t)m * D, v, F.lane); }
}
__device__ __forceinline__ void norm_router_phase(const Frame& F0, const float* x, const float* gain, const float* wr) { Frame F = opq(F0);
    LAS float* WR = (LAS float*)F.lds;
    LAS int* lcnt = (LAS int*)(F.lds + 32768);
    LAS int* lbase = lcnt + 16;
    LAS int* rE = lbase + 16;
    LAS int* rP1 = rE + 128; LAS int* rP2 = rP1 + 128;
    LAS float* rW = (LAS float*)(rP2 + 128);
    f32x4 g[4];
#pragma unroll
    for (int q = 0; q < 4; ++q) g[q] = ((const f32x4*)gain)[F.lane + 64 * q];
    for (int i = F.tid; i < 2048; i += NTHR) ((LAS f32x4*)WR)[i] = ((const f32x4*)wr)[i];
    bf16* H = (bf16*)(F.ws + WS_HM);
    int* stok = (int*)(F.ws + WS_STOK); float* sw = (float*)(F.ws + WS_SW);
    unsigned* gcnt = F.ctl + CW_MOECNT;
    for (int blk = F.bid; blk < T / 128; blk += F.G) {
        if (F.tid < 16) lcnt[F.tid] = 0;
        __syncthreads();
        for (int rr = 0; rr < 16; ++rr) {
            const int rl = F.wave * 16 + rr, m = blk * 128 + rl;
            f32x4 v[4]; norm_row(x + (size_t)m * D, g, H + (size_t)m * D, v, F.lane);
            float lg[8];
#pragma unroll
            for (int e = 0; e < 8; ++e) lg[e] = 0.f;
#pragma unroll
            for (int q = 0; q < 4; ++q)
#pragma unroll
                for (int c = 0; c < 4; ++c) { const int k = 4 * (F.lane + 64 * q) + c; const f32x4 w0 = *(const LAS f32x4*)(WR + k * 8), w1 = *(const LAS f32x4*)(WR + k * 8 + 4); const float hv = v[q][c];
                    lg[0] += hv * w0.x; lg[1] += hv * w0.y; lg[2] += hv * w0.z; lg[3] += hv * w0.w; lg[4] += hv * w1.x; lg[5] += hv * w1.y; lg[6] += hv * w1.z; lg[7] += hv * w1.w; }
#pragma unroll
            for (int e = 0; e < 8; ++e) lg[e] = wave_sum(lg[e]);
            if (F.lane == 0) {
                int e1 = 0; float l1 = lg[0];
#pragma unroll
                for (int e = 1; e < 8; ++e) if (lg[e] > l1) { l1 = lg[e]; e1 = e; }
                int e2 = -1; float l2 = -3.0e38f;
#pragma unroll
                for (int e = 0; e < 8; ++e) if (e != e1 && lg[e] > l2) { l2 = lg[e]; e2 = e; }
                const float w1 = 1.0f / (1.0f + __expf(l2 - l1));
                rE[rl] = e1 | (e2 << 8); rW[rl] = w1;
                rP1[rl] = __hip_atomic_fetch_add(lcnt + e1, 1, __ATOMIC_RELAXED, __HIP_MEMORY_SCOPE_WORKGROUP);
                rP2[rl] = __hip_atomic_fetch_add(lcnt + 8 + e2, 1, __ATOMIC_RELAXED, __HIP_MEMORY_SCOPE_WORKGROUP);
            }
        }
        __syncthreads();
        if (F.tid < 16) lbase[F.tid] = (int)__hip_atomic_fetch_add(gcnt + F.tid, (unsigned)lcnt[F.tid], __ATOMIC_RELAXED, __HIP_MEMORY_SCOPE_AGENT);
        __syncthreads();
        if (F.tid < 128) { const int m = blk * 128 + F.tid, e1 = rE[F.tid] & 255, e2 = rE[F.tid] >> 8; const float w1 = rW[F.tid];
            const int s1 = e1 * T + lbase[e1] + rP1[F.tid], s2 = (8 + e2) * T + lbase[8 + e2] + rP2[F.tid];
            stok[s1] = m; sw[s1] = w1; stok[s2] = m; sw[s2] = 1.0f - w1; }
        __syncthreads();
    }
}
__device__ __forceinline__ void final_norm_phase(const Frame& F0, float* x, const float* gain) { Frame F = opq(F0);
    const int gw = F.bid * NWAVES + F.wave, NGW = F.G * NWAVES;
    f32x4 g[4];
#pragma unroll
    for (int q = 0; q < 4; ++q) g[q] = ((const f32x4*)gain)[F.lane + 64 * q];
    for (int m = gw; m < T; m += NGW) {
        f32x4* xr = (f32x4*)(x + (size_t)m * D) + F.lane; f32x4 v[4]; float s = 0.f;
#pragma unroll
        for (int j = 0; j < 4; ++j) { v[j] = xr[64 * j]; s += (v[j].x * v[j].x + v[j].y * v[j].y) + (v[j].z * v[j].z + v[j].w * v[j].w); }
        const float r = 1.0f / sqrtf(wave_sum(s) * (1.f / D) + EPS);
#pragma unroll
        for (int j = 0; j < 4; ++j) xr[64 * j] = v[j] * r * g[j];
    }
}

constexpr int LD = 68;
constexpr int MATF = 64 * LD;

__device__ __forceinline__ void ld8(const bf16* p, float (&o)[8]) { const u32x4 w = *(const u32x4*)p; o[0] = bflo(w.x); o[1] = bfhi(w.x); o[2] = bflo(w.y); o[3] = bfhi(w.y); o[4] = bflo(w.z); o[5] = bfhi(w.z); o[6] = bflo(w.w); o[7] = bfhi(w.w); }

__device__ __forceinline__ void conv8(const bf16* PROJ, int b, int tpos  , int col, const float* cw, int cwld, int c0, float (&y)[8]) {
#pragma unroll
    for (int e = 0; e < 8; ++e) y[e] = 0.f;
#pragma unroll
    for (int j = 0; j < 4; ++j) { const int tp = tpos - 3 + j;
        if (tp >= 0) { float xv[8]; ld8(PROJ + (size_t)(b * SEQ + tp) * PP + col, xv);
            const f32x4 w0 = *(const f32x4*)(cw + j * cwld + c0), w1 = *(const f32x4*)(cw + j * cwld + c0 + 4);
            y[0] += xv[0] * w0.x; y[1] += xv[1] * w0.y; y[2] += xv[2] * w0.z; y[3] += xv[3] * w0.w; y[4] += xv[4] * w1.x; y[5] += xv[5] * w1.y; y[6] += xv[6] * w1.z; y[7] += xv[7] * w1.w; } }
}

__device__ __forceinline__ void gdn_prep(const Frame& F0, int l, int b, int n, int h) { Frame F = opq(F0);
    LAS float* Q = (LAS float*)F.lds; LAS float* Kk = Q + MATF; LAS float* U = Kk + MATF; LAS float* W = U + MATF; LAS float* A = W + MATF; LAS float* AQ = A + MATF;
    LAS float* sBeta = AQ + MATF; LAS float* sG = sBeta + 64;
    const bf16* PROJ = (const bf16*)(F.ws + WS_PROJ); const float* SM = (const float*)(F.ws + WS_SMALL);
    const float* cw = F.in[3] + (size_t)l * 4 * 768;
    const int tok0 = b * SEQ + n * CH, ch = ((b * NCH + n) * 4 + h);
    for (int u = F.tid; u < 64 * 24; u += NTHR) { const int grp = u % 24, t = u / 24, which = grp >> 3, d0 = (grp & 7) * 8, c0 = which * 256 + h * 64 + d0;
        float y[8]; conv8(PROJ, b, n * CH + t, c0, cw, 768, c0, y);
        LAS float* dst = (which == 0 ? Q : which == 1 ? Kk : U) + t * LD + d0;
        *(LAS f32x4*)dst = (f32x4){siluf_(y[0]), siluf_(y[1]), siluf_(y[2]), siluf_(y[3])}; *(LAS f32x4*)(dst + 4) = (f32x4){siluf_(y[4]), siluf_(y[5]), siluf_(y[6]), siluf_(y[7])}; }
    if (F.wave == 0) { const int t = F.lane; const float bl = SM[(size_t)(tok0 + t) * 32 + h], al = SM[(size_t)(tok0 + t) * 32 + 4 + h];
        float g = -__expf(F.in[4][l * 4 + h]) * softplusf_(al + F.in[5][l * 4 + h]);
#pragma unroll
        for (int o = 1; o < 64; o <<= 1) { const float up = __shfl_up(g, o); if (t >= o) g += up; }
        sBeta[t] = sigmoidf_(bl); sG[t] = g; }
    __syncthreads();
    { const int t = F.tid >> 3, p = F.tid & 7; LAS float* qp = Q + t * LD + 8 * p; LAS float* kp = Kk + t * LD + 8 * p; LAS float* up = U + t * LD + 8 * p; LAS float* wp = W + t * LD + 8 * p;
        f32x4 q0 = *(LAS f32x4*)qp, q1 = *(LAS f32x4*)(qp + 4), k0 = *(LAS f32x4*)kp, k1 = *(LAS f32x4*)(kp + 4);
        float sq = (q0.x * q0.x + q0.y * q0.y) + (q0.z * q0.z + q0.w * q0.w) + (q1.x * q1.x + q1.y * q1.y) + (q1.z * q1.z + q1.w * q1.w);
        float sk = (k0.x * k0.x + k0.y * k0.y) + (k0.z * k0.z + k0.w * k0.w) + (k1.x * k1.x + k1.y * k1.y) + (k1.z * k1.z + k1.w * k1.w);
#pragma unroll
        for (int o = 1; o < 8; o <<= 1) { sq += __shfl_xor(sq, o); sk += __shfl_xor(sk, o); }
        const float rq = 0.125f / sqrtf(sq + EPS), rk = 1.0f / sqrtf(sk + EPS), be = sBeta[t], eg = __expf(sG[t]);
        q0 = q0 * rq; q1 = q1 * rq; k0 = k0 * rk; k1 = k1 * rk;
        *(LAS f32x4*)qp = q0; *(LAS f32x4*)(qp + 4) = q1; *(LAS f32x4*)kp = k0; *(LAS f32x4*)(kp + 4) = k1;
        *(LAS f32x4*)wp = k0 * (be * eg); *(LAS f32x4*)(wp + 4) = k1 * (be * eg);
        *(LAS f32x4*)up = *(LAS f32x4*)up * be; *(LAS f32x4*)(up + 4) = *(LAS f32x4*)(up + 4) * be; }
    __syncthreads();
    if ((DUMPS & 1) && (ABL & 4096) && b == 0 && n == 0 && h == ((ABL >> 16) & 3) && l == ((ABL >> 15) & 1)) { float* dq = (float*)(F.ctl + 8192);
        for (int i = F.tid; i < 4096; i += NTHR) { dq[i] = Q[(i >> 6) * LD + (i & 63)]; dq[4096 + i] = Kk[(i >> 6) * LD + (i & 63)]; dq[8192 + i] = U[(i >> 6) * LD + (i & 63)]; } }
    { const int lr = F.lane & 15, lg = F.lane >> 4;
        for (int tl = F.wave; tl < 32; tl += NWAVES) { const int mat = tl >> 4, mi = (tl >> 2) & 3, ni = tl & 3; LAS float* dst = mat ? AQ : A;
            f32x4 acc = (f32x4){0.f, 0.f, 0.f, 0.f};
            if (mi >= ni) acc = mm16<false, true>(mat ? Q : Kk, LD, Kk, LD, 16 * mi, 16 * ni, 64, acc, F.lane);
#pragma unroll
            for (int r = 0; r < 4; ++r) { const int i = 16 * mi + 4 * lg + r, j = 16 * ni + lr; float v = 0.f;
                if (mat ? (i >= j) : (i > j)) v = acc[r] * __expf(sG[i] - sG[j]) * (mat ? 1.0f : sBeta[i]);
                dst[i * LD + j] = v; } } }
    __syncthreads();
    if ((DUMPS & 2) && (ABL & 4096) && b == 0 && n == 0 && h == ((ABL >> 16) & 3) && l == ((ABL >> 15) & 1)) { float* dq = (float*)(F.ctl + 8192 + 3 * 4096);
        for (int i = F.tid; i < 4096; i += NTHR) { dq[i] = A[(i >> 6) * LD + (i & 63)]; dq[4096 + i] = AQ[(i >> 6) * LD + (i & 63)]; } }
    for (int bi = 0; bi < ((ABL & 256) ? 0 : 4); ++bi) {
        if (bi > 0) { LAS float* X = F.wave < 4 ? U : W; const int j0 = 16 * (F.wave & 3); const int lr = F.lane & 15, lg = F.lane >> 4;
            f32x4 acc = mm16<false, false>(A, LD, X, LD, 16 * bi, j0, 16 * bi, (f32x4){0.f, 0.f, 0.f, 0.f}, F.lane);
            __syncthreads();
#pragma unroll
            for (int r = 0; r < 4; ++r) X[(16 * bi + 4 * lg + r) * LD + j0 + lr] -= acc[r];
            __syncthreads(); }
        if (F.tid < 128) { LAS float* X = F.tid < 64 ? U : W; const int c = F.tid & 63; float xr[16];
#pragma unroll
            for (int r = 0; r < 16; ++r) { float v = X[(16 * bi + r) * LD + c];
#pragma unroll
                for (int c2 = 0; c2 < r; ++c2) v -= A[(16 * bi + r) * LD + 16 * bi + c2] * xr[c2];
                xr[r] = v; X[(16 * bi + r) * LD + c] = v; } }
        __syncthreads();
    }
    if (ABL & 256) { if (F.tid < 128) { LAS float* X = F.tid < 64 ? U : W; const int c = F.tid & 63;
            for (int r = 1; r < 64; ++r) { float v = X[r * LD + c]; for (int c2 = 0; c2 < r; ++c2) v -= A[r * LD + c2] * X[c2 * LD + c]; X[r * LD + c] = v; } }
        __syncthreads(); }
    if ((DUMPS & 4) && (ABL & 4096) && b == 0 && n == 0 && h == ((ABL >> 16) & 3) && l == ((ABL >> 15) & 1)) { float* dq = (float*)(F.ctl + 8192 + 5 * 4096);
        for (int i = F.tid; i < 4096; i += NTHR) { dq[i] = U[(i >> 6) * LD + (i & 63)]; } }
    { const int t = F.tid >> 3, p = F.tid & 7; const float gl = sG[63], gt = sG[t], e1 = __expf(gl - gt), e2 = __expf(gt);
        LAS float* qp = Q + t * LD + 8 * p; LAS float* kp = Kk + t * LD + 8 * p;
        *(LAS f32x4*)qp = *(LAS f32x4*)qp * e2; *(LAS f32x4*)(qp + 4) = *(LAS f32x4*)(qp + 4) * e2; *(LAS f32x4*)kp = *(LAS f32x4*)kp * e1; *(LAS f32x4*)(kp + 4) = *(LAS f32x4*)(kp + 4) * e1; }
    __syncthreads();
    { const int lr = F.lane & 15, lg = F.lane >> 4; const float dl = __expf(sG[63]);
        float* GM = (float*)(F.ws + WS_GM) + (size_t)ch * 4096; float* GN = (float*)(F.ws + WS_GN) + (size_t)ch * 4096;
        float* GQ = (float*)(F.ws + WS_GQ) + (size_t)ch * 4096; float* GO = (float*)(F.ws + WS_GO) + (size_t)ch * 4096;
        for (int tl = F.wave; tl < 16; tl += NWAVES) { const int mi = tl >> 2, ni = tl & 3;
            const f32x4 acc = mm16<true, false>(Kk, LD, W, LD, 16 * mi, 16 * ni, 64, (f32x4){0.f, 0.f, 0.f, 0.f}, F.lane);
#pragma unroll
            for (int r = 0; r < 4; ++r) { const int i = 16 * mi + 4 * lg + r, j = 16 * ni + lr, ks = j >> 2; const float v = (i == j ? dl : 0.f) - acc[r];
                GM[((mi * 4 + (ks >> 2)) * 64 + (i & 15) + 16 * (j & 3)) * 4 + (ks & 3)] = v; } }
        for (int tl = F.wave; tl < 16; tl += NWAVES) { const int mi = tl >> 2, ni = tl & 3;
            const f32x4 acc = mm16<true, false>(Kk, LD, U, LD, 16 * mi, 16 * ni, 64, (f32x4){0.f, 0.f, 0.f, 0.f}, F.lane);
#pragma unroll
            for (int r = 0; r < 4; ++r) GN[(16 * mi + 4 * lg + r) * 64 + 16 * ni + lr] = acc[r]; }
        for (int tl = F.wave; tl < 16; tl += NWAVES) { const int mi = tl >> 2, ni = tl & 3;
            const f32x4 acc = mm16<false, false>(AQ, LD, W, LD, 16 * mi, 16 * ni, 64, (f32x4){0.f, 0.f, 0.f, 0.f}, F.lane);
#pragma unroll
            for (int r = 0; r < 4; ++r) { const int i = 16 * mi + 4 * lg + r, j = 16 * ni + lr; GQ[i * 64 + j] = Q[i * LD + j] - acc[r]; } }
        for (int tl = F.wave; tl < 16; tl += NWAVES) { const int mi = tl >> 2, ni = tl & 3;
            const f32x4 acc = mm16<false, false>(AQ, LD, U, LD, 16 * mi, 16 * ni, 64, (f32x4){0.f, 0.f, 0.f, 0.f}, F.lane);
#pragma unroll
            for (int r = 0; r < 4; ++r) GO[(16 * mi + 4 * lg + r) * 64 + 16 * ni + lr] = acc[r]; } }
    __syncthreads();
}

__device__ __forceinline__ void gla_prep(const Frame& F0, int l, int b, int n, int h) { Frame F = opq(F0);
    constexpr int L3 = 36;
    LAS float* QE = (LAS float*)F.lds; LAS float* KE = QE + 64 * L3; LAS float* KDm = KE + 64 * L3; LAS float* Gm = KDm + 64 * L3; LAS float* V = Gm + 64 * L3; LAS float* AIN = V + MATF;
    LAS float* LR = AIN + MATF; LAS float* WL = LR + 64 * 16; LAS float* Qr = WL + 16 * 32; LAS float* Kr = Qr + 64 * L3;
    const bf16* PROJ = (const bf16*)(F.ws + WS_PROJ); const float* SM = (const float*)(F.ws + WS_SMALL);
    const int tok0 = b * SEQ + n * CH, ch = ((b * NCH + n) * 4 + h);
    { const int t = F.tid >> 3, p = F.tid & 7; float xv[8];
        ld8(PROJ + (size_t)(tok0 + t) * PP + VD + h * 64 + 8 * p, xv);
        *(LAS f32x4*)(V + t * LD + 8 * p) = (f32x4){xv[0], xv[1], xv[2], xv[3]}; *(LAS f32x4*)(V + t * LD + 8 * p + 4) = (f32x4){xv[4], xv[5], xv[6], xv[7]};
        if (p < 4) { ld8(PROJ + (size_t)(tok0 + t) * PP + QD + h * 32 + 8 * p, xv);
            *(LAS f32x4*)(Qr + t * L3 + 8 * p) = (f32x4){xv[0], xv[1], xv[2], xv[3]}; *(LAS f32x4*)(Qr + t * L3 + 8 * p + 4) = (f32x4){xv[4], xv[5], xv[6], xv[7]}; }
        else { const int p2 = p - 4; ld8(PROJ + (size_t)(tok0 + t) * PP + KD + h * 32 + 8 * p2, xv);
            *(LAS f32x4*)(Kr + t * L3 + 8 * p2) = (f32x4){xv[0], xv[1], xv[2], xv[3]}; *(LAS f32x4*)(Kr + t * L3 + 8 * p2 + 4) = (f32x4){xv[4], xv[5], xv[6], xv[7]}; }
        if (F.tid < 256) { const int t2 = F.tid >> 2, q4 = F.tid & 3; *(LAS f32x4*)(LR + t2 * 16 + 4 * q4) = *(const f32x4*)(SM + (size_t)(tok0 + t2) * 32 + 8 + 4 * q4); }
        { const int r = F.tid >> 5, d = F.tid & 31; WL[r * 32 + d] = F.in[17][(size_t)l * 16 * 128 + r * 128 + h * 32 + d]; } }
    __syncthreads();
    { const int t = F.lane;
#pragma unroll
        for (int c = 0; c < 4; ++c) { const int d = F.wave * 4 + c; float s = F.in[18][l * 128 + h * 32 + d];
#pragma unroll
            for (int r = 0; r < 16; ++r) s += LR[t * 16 + r] * WL[r * 32 + d];
            float la = -softplusf_(-s) * (1.0f / 16.0f);
#pragma unroll
            for (int o = 1; o < 64; o <<= 1) { const float up = __shfl_up(la, o); if (t >= o) la += up; }
            Gm[t * L3 + d] = la; } }
    __syncthreads();
    { float* LQG = (float*)(F.ws + WS_LQG) + (size_t)ch * 2048; float* LDL = (float*)(F.ws + WS_LDL) + (size_t)ch * 32;
        const float sc = 0.17677669529663687f;
        for (int u = F.tid; u < 2048; u += NTHR) { const int t = u >> 5, d = u & 31; const float G = Gm[t * L3 + d], Gr = Gm[32 * L3 + d], Gl = Gm[63 * L3 + d];
            const float q = Qr[t * L3 + d] * sc, k = Kr[t * L3 + d];
            QE[t * L3 + d] = q * __expf(G - Gr); KE[t * L3 + d] = k * __expf(Gr - G); KDm[t * L3 + d] = k * __expf(Gl - G);
            LQG[t * 32 + d] = q * __expf(G); if (t == 63) LDL[d] = __expf(Gl); } }
    __syncthreads();
    { const int lr = F.lane & 15, lg = F.lane >> 4;
        for (int tl = F.wave; tl < 16; tl += NWAVES) { const int mi = tl >> 2, ni = tl & 3; f32x4 acc = (f32x4){0.f, 0.f, 0.f, 0.f};
            if (mi >= ni) acc = mm16<false, true>(QE, L3, KE, L3, 16 * mi, 16 * ni, 32, acc, F.lane);
#pragma unroll
            for (int r = 0; r < 4; ++r) { const int i = 16 * mi + 4 * lg + r, j = 16 * ni + lr; AIN[i * LD + j] = (i >= j) ? acc[r] : 0.f; } } }
    __syncthreads();
    { const int lr = F.lane & 15, lg = F.lane >> 4; float* LOI = (float*)(F.ws + WS_LOI) + (size_t)ch * 4096; float* LKV = (float*)(F.ws + WS_LKV) + (size_t)ch * 2048;
        for (int tl = F.wave; tl < 16; tl += NWAVES) { const int mi = tl >> 2, ni = tl & 3;
            const f32x4 acc = mm16<false, false>(AIN, LD, V, LD, 16 * mi, 16 * ni, 64, (f32x4){0.f, 0.f, 0.f, 0.f}, F.lane);
#pragma unroll
            for (int r = 0; r < 4; ++r) LOI[(16 * mi + 4 * lg + r) * 64 + 16 * ni + lr] = acc[r]; }
        { const int mi = F.wave >> 2, ni = F.wave & 3;
            const f32x4 acc = mm16<true, false>(KDm, L3, V, LD, 16 * mi, 16 * ni, 64, (f32x4){0.f, 0.f, 0.f, 0.f}, F.lane);
#pragma unroll
            for (int r = 0; r < 4; ++r) LKV[(16 * mi + 4 * lg + r) * 64 + 16 * ni + lr] = acc[r]; } }
    __syncthreads();
}

__device__ __forceinline__ void rg_prep(const Frame& F0, int l, int b, int n, int nb) { Frame F = opq(F0);
    LAS float* XCm = (LAS float*)F.lds; LAS float* WA = XCm + MATF; LAS float* WX = WA + MATF; LAS float* AA = WX + MATF; LAS float* segA = AA + MATF; LAS float* segH = segA + 512;
    const bf16* PROJ = (const bf16*)(F.ws + WS_PROJ);
    const int tok0 = b * SEQ + n * CH;
    { const int t = F.tid >> 3, p = F.tid & 7, c0 = nb * 64 + 8 * p; float y[8];
        conv8(PROJ, b, n * CH + t, XC + c0, F.in[10] + (size_t)l * 4 * 256, 256, c0, y);
        const float* cb = F.in[11] + l * 256 + c0;
        *(LAS f32x4*)(XCm + t * LD + 8 * p) = (f32x4){y[0] + cb[0], y[1] + cb[1], y[2] + cb[2], y[3] + cb[3]}; *(LAS f32x4*)(XCm + t * LD + 8 * p + 4) = (f32x4){y[4] + cb[4], y[5] + cb[5], y[6] + cb[6], y[7] + cb[7]};
        const float* wa = F.in[12] + ((size_t)l * 4 + nb) * 4096; const float* wx = F.in[14] + ((size_t)l * 4 + nb) * 4096;
#pragma unroll
        for (int i = 0; i < 2; ++i) { const int e = F.tid + NTHR * i, r = e >> 4, c4 = (e & 15) * 4;
            *(LAS f32x4*)(WA + r * LD + c4) = *(const f32x4*)(wa + r * 64 + c4); *(LAS f32x4*)(WX + r * LD + c4) = *(const f32x4*)(wx + r * 64 + c4); } }
    __syncthreads();
    { const int lr = F.lane & 15, lg = F.lane >> 4; f32x4 ga[2], gx[2];
#pragma unroll
        for (int q = 0; q < 2; ++q) { const int tl = F.wave + 8 * q, mi = tl >> 2, ni = tl & 3;
            ga[q] = mm16<false, false>(XCm, LD, WA, LD, 16 * mi, 16 * ni, 64, (f32x4){0.f, 0.f, 0.f, 0.f}, F.lane);
            gx[q] = mm16<false, false>(XCm, LD, WX, LD, 16 * mi, 16 * ni, 64, (f32x4){0.f, 0.f, 0.f, 0.f}, F.lane); }
        __syncthreads();
#pragma unroll
        for (int q = 0; q < 2; ++q) { const int tl = F.wave + 8 * q, mi = tl >> 2, ni = tl & 3, j = 16 * ni + lr, cg = nb * 64 + j;
            const float ba = F.in[13][l * 256 + cg], bx = F.in[15][l * 256 + cg], sp = softplusf_(F.in[16][l * 256 + cg]);
#pragma unroll
            for (int r = 0; r < 4; ++r) { const int i = 16 * mi + 4 * lg + r; const float la = -8.0f * sigmoidf_(ga[q][r] + ba) * sp, a = __expf(la);
                const float mult = sqrtf(fmaxf(-expm1f(2.0f * la), 0.f)); const float xc = XCm[i * LD + j];
                AA[i * LD + j] = a; XCm[i * LD + j] = xc * sigmoidf_(gx[q][r] + bx) * mult; } } }
    __syncthreads();
    { const int c = F.tid & 63, sg = F.tid >> 6; float hh = 0.f, pp = 1.f; float hl[8], pl[8];
#pragma unroll
        for (int tt = 0; tt < 8; ++tt) { const int t = 8 * sg + tt; const float a = AA[t * LD + c], u = XCm[t * LD + c]; hh = a * hh + u; pp = pp * a; hl[tt] = hh; pl[tt] = pp; }
        segA[sg * 64 + c] = pp; segH[sg * 64 + c] = hh;
        __syncthreads();
        float hin = 0.f, pin = 1.f;
        for (int s2 = 0; s2 < sg; ++s2) { const float a = segA[s2 * 64 + c]; hin = a * hin + segH[s2 * 64 + c]; pin *= a; }
        bf16* RHL = (bf16*)(F.ws + WS_RHL); bf16* RP = (bf16*)(F.ws + WS_RP);
#pragma unroll
        for (int tt = 0; tt < 8; ++tt) { const int t = 8 * sg + tt; const float hv = hl[tt] + pl[tt] * hin, pv = pl[tt] * pin;
            RHL[(size_t)(tok0 + t) * 256 + nb * 64 + c] = (bf16)f2bf(hv); RP[(size_t)(tok0 + t) * 256 + nb * 64 + c] = (bf16)f2bf(pv);
            if (t == 63) { ((float*)(F.ws + WS_RAT))[(b * NCH + n) * 256 + nb * 64 + c] = pv; ((float*)(F.ws + WS_RHE))[(b * NCH + n) * 256 + nb * 64 + c] = hv; } } }
    __syncthreads();
}
__device__ __forceinline__ void prep_phase(Frame& F, int l) {
    for (int it = F.bid; it < 512 * 12; it += F.G) { const int ci = it / 12, job = it % 12, b = ci >> 6, n = ci & 63;
        if (job < 4) gdn_prep(F, l, b, n, job); else if (job < 8) gla_prep(F, l, b, n, job - 4); else rg_prep(F, l, b, n, job - 8); }
}

__device__ __forceinline__ f32x16 mfma32(bf16x8 a, bf16x8 b, f32x16 c) { return __builtin_amdgcn_mfma_f32_32x32x16_bf16(a, b, c, 0, 0, 0); }
typedef short v4i16_t __attribute__((ext_vector_type(4)));
__device__ __forceinline__ s16x4 vtr(const LAS unsigned char* p) { return __builtin_bit_cast(s16x4, __builtin_amdgcn_ds_read_tr16_b64_v4i16((LAS v4i16_t*)p)); }

__device__ __forceinline__ void attn_item(const Frame& F0, int l, int b, int h, int qb) { Frame F = opq(F0);
    constexpr int KP = 144, KT_BYTES = 64 * KP;
    LAS unsigned char* Kt = F.lds; LAS unsigned char* Vt = F.lds + 2 * KT_BYTES;
    LAS float* LUT = (LAS float*)(F.lds + 4 * KT_BYTES); LAS float* sLam = LUT + 256;
    const bf16* PROJ = (const bf16*)(F.ws + WS_PROJ); bf16* MIX = (bf16*)(F.ws + WS_HM);
    const float lam_init = l == 0 ? 0.2f : 0.35550906759096926f;
    if (F.tid < 256) { const int delta = F.tid - 191, na = delta < 0 ? -delta : delta;
        int bk = na < 8 ? na : na < 12 ? 8 : na < 16 ? 9 : na < 23 ? 10 : na < 32 ? 11 : na < 46 ? 12 : na < 64 ? 13 : na < 91 ? 14 : 15;
        if (delta > 0) bk += 16;
        LUT[F.tid] = F.in[9][bk * 4 + h] * LOG2E; }
    if (F.wave == 4) { const float* lv = F.in[7] + l * 128; const int i = F.lane & 31;
        float p = F.lane < 32 ? lv[i] * lv[32 + i] : lv[64 + i] * lv[96 + i];
#pragma unroll
        for (int o = 1; o < 32; o <<= 1) p += __shfl_xor(p, o);
        const float e = __expf(p), e2 = __shfl_xor(e, 32);
        if (F.lane == 0) sLam[0] = e - e2 + lam_init; }
    __syncthreads();
    const float lam = sLam[0];
    const int w = F.wave, cq = qb * 4 + (w >> 1), r32 = F.lane & 31, hh = F.lane >> 5, qoff = 32 * (w & 1) + r32;
    const size_t t0 = (size_t)b * SEQ + qb * 256 + 32 * w + r32;
    bf16x8 qf[2][2];
#pragma unroll
    for (int c = 0; c < 2; ++c)
#pragma unroll
        for (int s = 0; s < 2; ++s) qf[c][s] = *(const bf16x8*)(PROJ + t0 * PP + QB + h * 64 + c * 32 + 16 * s + 8 * hh);
    f32x16 O[2][2]; float mrun[2], lrun[2];
#pragma unroll
    for (int c = 0; c < 2; ++c) { mrun[c] = -1.0e30f; lrun[c] = 0.f;
#pragma unroll
        for (int mt = 0; mt < 2; ++mt)
#pragma unroll
            for (int i = 0; i < 16; ++i) O[c][mt][i] = 0.f; }
    const int skey = F.tid >> 3, sseg = F.tid & 7, ntile = 4 * qb + 4;
    const bf16* kg = PROJ + ((size_t)b * SEQ + skey) * PP + KB + h * 64 + sseg * 8; const bf16* vg = PROJ + ((size_t)b * SEQ + skey) * PP + VB + h * 64 + sseg * 8;
    u32x4 kreg = *(const u32x4*)kg, vreg = *(const u32x4*)vg;
    const float SC = 0.17677669529663687f * LOG2E;
    for (int kt = 0; kt < ntile; ++kt) {
        const int buf = kt & 1;
        *(LAS u32x4*)(Kt + buf * KT_BYTES + skey * KP + sseg * 16) = kreg; *(LAS u32x4*)(Vt + buf * KT_BYTES + skey * KP + sseg * 16) = vreg;
        __syncthreads();
        if (kt + 1 < ntile) { kreg = *(const u32x4*)(kg + (size_t)(kt + 1) * 64 * PP); vreg = *(const u32x4*)(vg + (size_t)(kt + 1) * 64 * PP); }
        if (kt <= cq) {
            const bool far = kt + 3 <= cq; const float c15 = LUT[0];
            const LAS unsigned char* Kb = Kt + buf * KT_BYTES; const LAS unsigned char* Vb = Vt + buf * KT_BYTES;
#pragma unroll
            for (int kb = 0; kb < 2; ++kb) {
                f32x16 S[2];
#pragma unroll
                for (int c = 0; c < 2; ++c) { f32x16 z;
#pragma unroll
                    for (int i = 0; i < 16; ++i) z[i] = 0.f;
                    const bf16x8 k0 = *(const LAS bf16x8*)(Kb + (32 * kb + r32) * KP + (c * 32 + 8 * hh) * 2), k1 = *(const LAS bf16x8*)(Kb + (32 * kb + r32) * KP + (c * 32 + 16 + 8 * hh) * 2);
                    z = mfma32(k0, qf[c][0], z); S[c] = mfma32(k1, qf[c][1], z); }
                float bias[16];
#pragma unroll
                for (int i = 0; i < 16; ++i) { if (far) bias[i] = c15; else { const int krow = 32 * kb + (i & 3) + 8 * (i >> 2) + 4 * hh; bias[i] = LUT[(kt - cq) * 64 + krow - qoff + 191]; } }
                bf16x8 pb[2][2];
#pragma unroll
                for (int c = 0; c < 2; ++c) {
                    float mx = -1.0e30f;
#pragma unroll
                    for (int i = 0; i < 16; ++i) { S[c][i] = S[c][i] * SC + bias[i]; mx = fmaxf(mx, S[c][i]); }
                    mx = fmaxf(mx, __shfl_xor(mx, 32));
                    const float mn = fmaxf(mrun[c], mx), alpha = __builtin_amdgcn_exp2f(mrun[c] - mn); mrun[c] = mn;
                    float ps = 0.f;
#pragma unroll
                    for (int i = 0; i < 16; ++i) { S[c][i] = __builtin_amdgcn_exp2f(S[c][i] - mn); ps += S[c][i]; }
                    lrun[c] = lrun[c] * alpha + ps;
#pragma unroll
                    for (int mt = 0; mt < 2; ++mt)
#pragma unroll
                        for (int i = 0; i < 16; ++i) O[c][mt][i] *= alpha;
#pragma unroll
                    for (int s = 0; s < 2; ++s) { u32x4 pw; pw.x = pk2(S[c][8 * s + 0], S[c][8 * s + 1]); pw.y = pk2(S[c][8 * s + 2], S[c][8 * s + 3]); pw.z = pk2(S[c][8 * s + 4], S[c][8 * s + 5]); pw.w = pk2(S[c][8 * s + 6], S[c][8 * s + 7]);
                        pb[c][s] = __builtin_bit_cast(bf16x8, pw); }
                }
#pragma unroll
                for (int mt = 0; mt < 2; ++mt)
#pragma unroll
                    for (int s = 0; s < 2; ++s) {
                        const LAS unsigned char* vp = Vb + (32 * kb + 16 * s + 4 * hh + ((F.lane & 15) >> 2)) * KP + (32 * mt + 16 * ((F.lane >> 4) & 1) + 4 * (F.lane & 3)) * 2;
                        const s16x4 v0 = vtr(vp), v1 = vtr(vp + 8 * KP);
                        bf16x8 vf; vf[0] = v0[0]; vf[1] = v0[1]; vf[2] = v0[2]; vf[3] = v0[3]; vf[4] = v1[0]; vf[5] = v1[1]; vf[6] = v1[2]; vf[7] = v1[3];
                        O[0][mt] = mfma32(vf, pb[0][s], O[0][mt]); O[1][mt] = mfma32(vf, pb[1][s], O[1][mt]); }
            }
        }
    }
    { const float i0 = 1.0f / (lrun[0] + __shfl_xor(lrun[0], 32)), i1 = lam / (lrun[1] + __shfl_xor(lrun[1], 32));
        float ss = 0.f;
#pragma unroll
        for (int mt = 0; mt < 2; ++mt)
#pragma unroll
            for (int i = 0; i < 16; ++i) { const float a = O[0][mt][i] * i0 - O[1][mt][i] * i1; O[0][mt][i] = a; ss += a * a; }
        ss += __shfl_xor(ss, 32);
        const float rs = (1.0f - lam_init) / sqrtf(ss * (1.0f / 64.0f) + EPS);
        const float* bn = F.in[8] + l * 64;
#pragma unroll
        for (int mt = 0; mt < 2; ++mt)
#pragma unroll
            for (int g4 = 0; g4 < 4; ++g4) { const int dv0 = 32 * mt + 8 * g4 + 4 * hh; const f32x4 gn = *(const f32x4*)(bn + dv0);
                u32x2 o; o.x = pk2(O[0][mt][4 * g4 + 0] * rs * gn.x, O[0][mt][4 * g4 + 1] * rs * gn.y); o.y = pk2(O[0][mt][4 * g4 + 2] * rs * gn.z, O[0][mt][4 * g4 + 3] * rs * gn.w);
                if (ABL & 8) { o.x = 0u; o.y = 0u; }
                *(u32x2*)(MIX + t0 * D + 256 + h * 64 + dv0) = o; } }
    __syncthreads();
}

__device__ __forceinline__ void gdn_chain_item(const Frame& F0, int b, int h, int pair) { Frame F = opq(F0);
    const int w = F.wave, chain = w >> 2, cg = 2 * pair + chain, mi = w & 3, lr = F.lane & 15, lg = F.lane >> 4;
    LAS float* Sb = (LAS float*)F.lds + chain * 2048;
    const f32x4* GMv = (const f32x4*)(F.ws + WS_GM); float* GN = (float*)(F.ws + WS_GN);
    f32x4 s_cur = (f32x4){0.f, 0.f, 0.f, 0.f};
#pragma unroll
    for (int r = 0; r < 4; ++r) Sb[(16 * mi + 4 * lg + r) * 16 + lr] = 0.f;
    __syncthreads();
    f32x4 mq[4][4], nq[4];
#define GDN_LOAD(slot, n_) do { const size_t _ch = (size_t)((b * NCH + (n_)) * 4 + h); \
        _Pragma("unroll") for (int _q = 0; _q < 4; ++_q) mq[slot][_q] = GMv[_ch * 1024 + (mi * 4 + _q) * 64 + F.lane]; \
        _Pragma("unroll") for (int _r = 0; _r < 4; ++_r) nq[slot][_r] = GN[_ch * 4096 + (16 * mi + 4 * lg + _r) * 64 + 16 * cg + lr]; } while (0)
    GDN_LOAD(0, 0); GDN_LOAD(1, 1); GDN_LOAD(2, 2); GDN_LOAD(3, 3);
    for (int n0 = 0; n0 < NCH; n0 += 4) {
#pragma unroll
        for (int u = 0; u < 4; ++u) { const int n = n0 + u, buf = u & 1; const size_t ch = (size_t)((b * NCH + n) * 4 + h);
            f32x4 acc = nq[u];
#pragma unroll
            for (int r = 0; r < 4; ++r) GN[ch * 4096 + (16 * mi + 4 * lg + r) * 64 + 16 * cg + lr] = s_cur[r];
#pragma unroll
            for (int ks = 0; ks < 16; ++ks) { const float a = mq[u][ks >> 2][ks & 3], bv = Sb[buf * 1024 + (4 * ks + lg) * 16 + lr]; acc = __builtin_amdgcn_mfma_f32_16x16x4f32(a, bv, acc, 0, 0, 0); }
            asm volatile("s_nop 15\n\ts_nop 7" : "+v"(acc));
            s_cur = acc;
#pragma unroll
            for (int r = 0; r < 4; ++r) Sb[(buf ^ 1) * 1024 + (16 * mi + 4 * lg + r) * 16 + lr] = acc[r];
            if (n + 4 < NCH) GDN_LOAD(u, n + 4);
            __syncthreads(); }
    }
#undef GDN_LOAD
}
__device__ __forceinline__ void gla_prefix_item(const Frame& F0, int b, int h) { Frame F = opq(F0);
    f32x4* LKV = (f32x4*)(F.ws + WS_LKV); const float* LDL = (const float*)(F.ws + WS_LDL); const int dk = F.tid >> 4;
    f32x4 s = (f32x4){0.f, 0.f, 0.f, 0.f}, kvq[8]; float dq[8];
#pragma unroll
    for (int u = 0; u < 8; ++u) { const size_t ch = (size_t)((b * NCH + u) * 4 + h); kvq[u] = LKV[ch * 512 + F.tid]; dq[u] = LDL[ch * 32 + dk]; }
    for (int n0 = 0; n0 < NCH; n0 += 8) {
#pragma unroll
        for (int u = 0; u < 8; ++u) { const int n = n0 + u; const size_t ch = (size_t)((b * NCH + n) * 4 + h);
            const f32x4 kv = kvq[u]; const float d = dq[u];
            LKV[ch * 512 + F.tid] = s; s = s * d + kv;
            if (n + 8 < NCH) { const size_t c2 = (size_t)((b * NCH + n + 8) * 4 + h); kvq[u] = LKV[c2 * 512 + F.tid]; dq[u] = LDL[c2 * 32 + dk]; } }
    }
}
__device__ __forceinline__ void rg_carry_item(const Frame& F0, int j) { Frame F = opq(F0);
    const int gid = j * NTHR + F.tid, b = gid >> 8, c = gid & 255;
    const float* RAT = (const float*)(F.ws + WS_RAT); const float* RHE = (const float*)(F.ws + WS_RHE); float* RCA = (float*)(F.ws + WS_RCA);
    float carry = 0.f;
#pragma unroll 8
    for (int n = 0; n < NCH; ++n) { const int ci = (b * NCH + n) * 256 + c; const float a = RAT[ci], hn = RHE[ci]; RCA[ci] = carry; carry = a * carry + hn; }
}
constexpr int Q_GDN = 64, Q_GLA = 32, Q_RG = 4, Q_ATT = 512, Q_ITEMS = Q_GDN + Q_GLA + Q_RG + Q_ATT;
__device__ __forceinline__ void scan_attn_phase(Frame& F, int l) {
    for (;;) {
        __syncthreads();
        if (F.tid == 0) F.MISC[16] = __hip_atomic_fetch_add(F.ctl + CW_QUEUE + 64 * l, 1u, __ATOMIC_RELAXED, __HIP_MEMORY_SCOPE_AGENT);
        __syncthreads();
        const int it = (int)F.MISC[16];
        if (it >= Q_ITEMS) break;
        if (it < Q_GDN) gdn_chain_item(F, it >> 3, (it >> 1) & 3, it & 1);
        else if (it < Q_GDN + Q_GLA) { const int q = it - Q_GDN; gla_prefix_item(F, q >> 2, q & 3); }
        else if (it < Q_GDN + Q_GLA + Q_RG) rg_carry_item(F, it - Q_GDN - Q_GLA);
        else { const int a = it - (Q_GDN + Q_GLA + Q_RG), qb = 15 - (a >> 5), bh = a & 31; attn_item(F, l, bh >> 2, bh & 3, qb); }
    }
}

__device__ __forceinline__ void norm_gate_store(Frame& F, const LAS float* OUT, const float* gain, const bf16* gate  , bf16* dst, bool silu_gate) {
    const int t = F.tid >> 3, p = F.tid & 7; const f32x4 a = *(const LAS f32x4*)(OUT + t * LD + 8 * p), c = *(const LAS f32x4*)(OUT + t * LD + 8 * p + 4);
    float ss = (a.x * a.x + a.y * a.y) + (a.z * a.z + a.w * a.w) + (c.x * c.x + c.y * c.y) + (c.z * c.z + c.w * c.w);
#pragma unroll
    for (int o = 1; o < 8; o <<= 1) ss += __shfl_xor(ss, o);
    const float rs = 1.0f / sqrtf(ss * (1.0f / 64.0f) + EPS);
    float gv[8]; ld8(gate + (size_t)t * PP + 8 * p, gv);
    const f32x4 g0 = *(const f32x4*)(gain + 8 * p), g1 = *(const f32x4*)(gain + 8 * p + 4);
    float o[8] = {a.x * rs * g0.x, a.y * rs * g0.y, a.z * rs * g0.z, a.w * rs * g0.w, c.x * rs * g1.x, c.y * rs * g1.y, c.z * rs * g1.z, c.w * rs * g1.w};
#pragma unroll
    for (int e = 0; e < 8; ++e) o[e] *= siluf_(gv[e]) * (((ABL & 512) && gain == F.in[6] + 0) ? 2.0f : 1.0f);
    u32x4 w; w.x = pk2(o[0], o[1]); w.y = pk2(o[2], o[3]); w.z = pk2(o[4], o[5]); w.w = pk2(o[6], o[7]);
    if (!silu_gate) w = (u32x4){0u, 0u, 0u, 0u};
    *(u32x4*)(dst + (size_t)t * D + 8 * p) = w;
}
__device__ __forceinline__ void finalize_phase(const Frame& F0, int l) { Frame F = opq(F0);
    LAS float* QP = (LAS float*)F.lds; LAS float* SPm = QP + MATF; LAS float* OUT = SPm + MATF;
    const bf16* PROJ = (const bf16*)(F.ws + WS_PROJ); bf16* MIX = (bf16*)(F.ws + WS_HM);
    const int lr = F.lane & 15, lg = F.lane >> 4;
    for (int it = F.bid; it < NB * NCH; it += F.G) { const int b = it >> 6, n = it & 63; const size_t tok0 = (size_t)b * SEQ + n * CH;
        for (int h = 0; h < ((FINPARTS & 1) ? 4 : 0); ++h) {
            const size_t ch = (size_t)((b * NCH + n) * 4 + h);
            const f32x4* GQ = (const f32x4*)(F.ws + WS_GQ) + ch * 1024; const f32x4* GS = (const f32x4*)(F.ws + WS_GN) + ch * 1024; const float* GO = (const float*)(F.ws + WS_GO) + ch * 4096;
#pragma unroll
            for (int i = 0; i < 2; ++i) { const int e = F.tid + NTHR * i, r = e >> 4, c4 = (e & 15) * 4; *(LAS f32x4*)(QP + r * LD + c4) = GQ[e]; *(LAS f32x4*)(SPm + r * LD + c4) = GS[e]; }
            __syncthreads();
#pragma unroll
            for (int q = 0; q < 2; ++q) { const int tl = F.wave + 8 * q, mi = tl >> 2, ni = tl & 3; f32x4 acc;
#pragma unroll
                for (int r = 0; r < 4; ++r) acc[r] = GO[(16 * mi + 4 * lg + r) * 64 + 16 * ni + lr];
                if (!(ABL & 128)) acc = mm16<false, false>(QP, LD, SPm, LD, 16 * mi, 16 * ni, 64, acc, F.lane);
#pragma unroll
                for (int r = 0; r < 4; ++r) OUT[(16 * mi + 4 * lg + r) * LD + 16 * ni + lr] = acc[r]; }
            __syncthreads();
            norm_gate_store(F, OUT, F.in[6] + l * 64, PROJ + tok0 * PP + GA + h * 64, MIX + tok0 * D + h * 64, !((ABL & 16) || ((ABL & 1024) && l == 1) || ((ABL & 2048) && l == 0)));
        }
        for (int h = 0; h < ((FINPARTS & 2) ? 4 : 0); ++h) {
            const size_t ch = (size_t)((b * NCH + n) * 4 + h);
            const f32x4* LQG = (const f32x4*)(F.ws + WS_LQG) + ch * 512; const f32x4* LS = (const f32x4*)(F.ws + WS_LKV) + ch * 512; const float* LOI = (const float*)(F.ws + WS_LOI) + ch * 4096;
            { const int r = F.tid >> 3, c4 = (F.tid & 7) * 4; *(LAS f32x4*)(QP + r * 36 + c4) = LQG[F.tid]; const int r2 = F.tid >> 4, c42 = (F.tid & 15) * 4; *(LAS f32x4*)(SPm + r2 * LD + c42) = LS[F.tid]; }
            __syncthreads();
#pragma unroll
            for (int q = 0; q < 2; ++q) { const int tl = F.wave + 8 * q, mi = tl >> 2, ni = tl & 3; f32x4 acc;
#pragma unroll
                for (int r = 0; r < 4; ++r) acc[r] = LOI[(16 * mi + 4 * lg + r) * 64 + 16 * ni + lr];
                acc = mm16<false, false>(QP, 36, SPm, LD, 16 * mi, 16 * ni, 32, acc, F.lane);
#pragma unroll
                for (int r = 0; r < 4; ++r) OUT[(16 * mi + 4 * lg + r) * LD + 16 * ni + lr] = acc[r]; }
            __syncthreads();
            norm_gate_store(F, OUT, F.in[19] + l * 64, PROJ + tok0 * PP + RD + h * 64, MIX + tok0 * D + 768 + h * 64, !(ABL & 32));
        }
        if (FINPARTS & 4) { const int t = F.tid >> 3, c0 = (F.tid & 7) * 32; const size_t tok = tok0 + t;
            const bf16* RHL = (const bf16*)(F.ws + WS_RHL) + tok * 256; const bf16* RP = (const bf16*)(F.ws + WS_RP) + tok * 256; const float* RCA = (const float*)(F.ws + WS_RCA) + (b * NCH + n) * 256;
#pragma unroll
            for (int q = 0; q < 4; ++q) { const int c = c0 + 8 * q; float hl[8], pv[8], gc[8]; ld8(RHL + c, hl); ld8(RP + c, pv); ld8(PROJ + tok * PP + GC + c, gc);
                const f32x4 ca0 = *(const f32x4*)(RCA + c), ca1 = *(const f32x4*)(RCA + c + 4); const float ca[8] = {ca0.x, ca0.y, ca0.z, ca0.w, ca1.x, ca1.y, ca1.z, ca1.w};
                float o[8];
#pragma unroll
                for (int e = 0; e < 8; ++e) o[e] = (hl[e] + pv[e] * ca[e]) * gelu_tanh(gc[e]);
                u32x4 w; w.x = pk2(o[0], o[1]); w.y = pk2(o[2], o[3]); w.z = pk2(o[4], o[5]); w.w = pk2(o[6], o[7]);
                if (ABL & 64) w = (u32x4){0u, 0u, 0u, 0u};
                *(u32x4*)(MIX + tok * D + 512 + c) = w; } }
        __syncthreads();
    }
}


__device__ __forceinline__ void dbg_gdn_check(const Frame& F0, int l, int bsel, int hsel, int msel, float* dbgout) { Frame F = opq(F0);
    if (F.bid != 0) return;
    constexpr int NT = 512;
    LAS float* S = (LAS float*)F.lds;
    LAS float* qv = S + 4096; LAS float* kv = qv + 64; LAS float* vv = kv + 64; LAS float* tmp = vv + 64; LAS float* ov = tmp + 64; LAS float* sc = ov + 64;
    const bf16* PROJ = (const bf16*)(F.ws + WS_PROJ); const float* SM = (const float*)(F.ws + WS_SMALL); const bf16* MIX = (const bf16*)(F.ws + WS_HM);
    const float* cw = F.in[3] + (size_t)l * 4 * 768;
    for (int i = F.tid; i < 4096; i += NTHR) S[i] = 0.f;
    float errsum = 0.f, refsum = 0.f;
    __syncthreads();
    for (int t = 0; t < NT; ++t) {
        const size_t tok = (size_t)bsel * SEQ + t;
        if (F.tid < 192) { const int which = F.tid >> 6, d = F.tid & 63, c = which * 256 + hsel * 64 + d; float y = 0.f;
            for (int j = 0; j < 4; ++j) { const int tp = t - 3 + j; if (tp >= 0) y += bf2f(PROJ[((size_t)bsel * SEQ + tp) * PP + c]) * cw[j * 768 + c]; }
            y = y / (1.0f + expf(-y)); (which == 0 ? qv : which == 1 ? kv : vv)[d] = y; }
        __syncthreads();
        if (F.tid == 0) { float sq = 0.f, sk = 0.f; for (int d = 0; d < 64; ++d) { sq += qv[d] * qv[d]; sk += kv[d] * kv[d]; }
            sc[0] = 0.125f / sqrtf(sq + EPS); sc[1] = 1.0f / sqrtf(sk + EPS);
            sc[2] = 1.0f / (1.0f + expf(-SM[tok * 32 + hsel]));
            const float x = SM[tok * 32 + 4 + hsel] + F.in[5][l * 4 + hsel]; const float sp = fmaxf(x, 0.f) + log1pf(expf(-fabsf(x)));
            sc[3] = expf(-expf(F.in[4][l * 4 + hsel]) * sp); }
        __syncthreads();
        if (F.tid < 64) { qv[F.tid] *= sc[0]; kv[F.tid] *= sc[1]; }
        for (int i = F.tid; i < 4096; i += NTHR) S[i] *= sc[3];
        __syncthreads();
        if ((ABL & (1 << 21)) && t < 64 && F.tid < 64) { const float* dq = (const float*)(F.ctl + 8192); const int which = msel; if (which < 3) { const float r = which == 0 ? qv[F.tid] : which == 1 ? kv[F.tid] : vv[F.tid] * sc[2];
            const float m = dq[which * 4096 + t * 64 + F.tid]; errsum += (m - r) * (m - r); refsum += r * r; } }
        if ((ABL & (1 << 22)) && t < 64) { LAS float* KH = sc + 16; LAS float* GH = KH + 4096;
            if (F.tid < 64) KH[t * 64 + F.tid] = kv[F.tid];
            if (F.tid == 0) GH[t] = (t ? GH[t - 1] : 0.f) + logf(sc[3]);
            __syncthreads();
            if (F.tid <= t && msel < 2) { const int j = F.tid; float d = 0.f; for (int dk = 0; dk < 64; ++dk) d += (msel == 0 ? qv[dk] : kv[dk]) * KH[j * 64 + dk];
                float r = d * expf(GH[t] - GH[j]) * (msel == 0 ? 1.0f : sc[2]); if (msel == 1 && j == t) r = 0.f;
                const float m = ((const float*)(F.ctl + 8192 + 3 * 4096))[(msel == 0 ? 4096 : 0) + t * 64 + j]; errsum += (m - r) * (m - r); refsum += r * r; }
            __syncthreads(); }
        if (F.tid < 64) { float a = 0.f; for (int dk = 0; dk < 64; ++dk) a += S[dk * 64 + F.tid] * kv[dk]; tmp[F.tid] = sc[2] * (vv[F.tid] - a); }
        __syncthreads();
        if ((ABL & (1 << 22)) && msel == 2 && t < 64 && F.tid < 64) { const float m = ((const float*)(F.ctl + 8192 + 5 * 4096))[t * 64 + F.tid], r = tmp[F.tid]; errsum += (m - r) * (m - r); refsum += r * r; }
        for (int i = F.tid; i < 4096; i += NTHR) S[i] += kv[i >> 6] * tmp[i & 63];
        __syncthreads();
        if (F.tid < 64) { float a = 0.f; for (int dk = 0; dk < 64; ++dk) a += S[dk * 64 + F.tid] * qv[dk]; ov[F.tid] = a; }
        __syncthreads();
        if ((ABL & (1 << 21)) && msel == 3 && t < 64 && F.tid < 64) { const float* GO = (const float*)(F.ws + WS_GO) + (size_t)((bsel * NCH + 0) * 4 + hsel) * 4096;
            const float m = (ABL & (1 << 23)) ? ((const float*)(F.ctl + 8192 + 6 * 4096))[t * 64 + F.tid] : GO[t * 64 + F.tid], r = ov[F.tid]; errsum += (m - r) * (m - r); refsum += r * r; }
        if (F.tid == 0) { float ss = 0.f; for (int d = 0; d < 64; ++d) ss += ov[d] * ov[d]; sc[4] = 1.0f / sqrtf(ss / 64.0f + EPS); }
        __syncthreads();
        if (F.tid < 64) { const float gt = bf2f(PROJ[tok * PP + GA + hsel * 64 + F.tid]); const float r = ov[F.tid] * sc[4] * F.in[6][l * 64 + F.tid] * (gt / (1.0f + expf(-gt)));
            const float m = bf2f(MIX[tok * D + hsel * 64 + F.tid]);
            const bool use = msel == 0 ? true : msel == 1 ? ((t & 63) < 16) : msel == 2 ? (t < 64) : (t >= 64);
            if (use && !(ABL & (3 << 21))) { errsum += (m - r) * (m - r); refsum += r * r; } }
        __syncthreads();
    }
    if (F.tid < 64) { errsum = wave_sum(errsum); refsum = wave_sum(refsum); if (F.tid == 0) dbgout[0] = 1000.0f * sqrtf(errsum / fmaxf(refsum, 1e-30f)); }
}
#define IN_PH (lo <= ph && ph < hi)
#define END_PH do { if (IN_PH && ph + 1 < hi) xcd_barrier(bar); ++ph; } while (0)
template <int l>
__device__ __forceinline__ void layer_phases(Frame& F, const XcdBarrier& bar, const int lo, const int hi, int& ph) {
    LAS unsigned char* ring = F.lds;
    bf16* HM = (bf16*)(F.ws + WS_HM); bf16* PROJ = (bf16*)(F.ws + WS_PROJ); float* X = F.out;
        if (PHON(1) && IN_PH) {
            pg8::StaticOrder S; S.init(T, NIN, F.G, F.bid); pg8::EpiProj E{PROJ, (float*)(F.ws + WS_SMALL)};
            pg8::gemm_phase<pg8::EpiProj, pg8::StaticOrder, false>(ring, HM, (const bf16*)(F.ws + WS_WIN) + (size_t)l * NIN * D, D, S, E, nullptr); }
        END_PH;
        if (PHON(2) && IN_PH) prep_phase(F, l);
        END_PH;
        if ((ABL & 4096) && (ABL & (1 << 24)) && l == ((ABL >> 15) & 1)) { if (IN_PH) dbg_gdn_check(F, l, (ABL >> 18) & 7, (ABL >> 16) & 3, (ABL >> 13) & 3, (float*)(F.ctl + 2048)); END_PH; }
        if (PHON(3) && IN_PH) scan_attn_phase(F, l);
        END_PH;
        if ((ABL & 4096) && (ABL & (1 << 25)) && l == ((ABL >> 15) & 1)) { if (IN_PH) dbg_gdn_check(F, l, (ABL >> 18) & 7, (ABL >> 16) & 3, (ABL >> 13) & 3, (float*)(F.ctl + 2048)); END_PH; }
        if (PHON(4) && IN_PH) finalize_phase(F, l);
        END_PH;
        if ((ABL & 4096) && !(ABL & (3 << 24)) && l == ((ABL >> 15) & 1)) { if (IN_PH) dbg_gdn_check(F, l, (ABL >> 18) & 7, (ABL >> 16) & 3, (ABL >> 13) & 3, (float*)(F.ctl + 2048)); END_PH; }
        if (PHON(5) && IN_PH) {
            pg8::StaticOrder S; S.init(T, D, F.G, F.bid); pg8::EpiResid E{l == 0 ? F.in[0] : (const float*)X, X};
            pg8::gemm_phase<pg8::EpiResid, pg8::StaticOrder, false>(ring, HM, (const bf16*)(F.ws + WS_WOUT) + (size_t)l * D * D, D, S, E, nullptr); }
        END_PH;
        if (l == 0) {
            if (PHON(6) && IN_PH) norm_phase(F, X, F.in[21]);
            END_PH;
            if (PHON(7) && !(ABL & 4) && IN_PH) { pg8::StaticOrder S; S.init(T, 2 * DFF, F.G, F.bid); pg8::EpiSwiglu E{PROJ, DFF, 22};
                pg8::gemm_phase<pg8::EpiSwiglu, pg8::StaticOrder, false>(ring, HM, (const bf16*)(F.ws + WS_WGU), D, S, E, nullptr); }
            END_PH;
            if (PHON(8) && !(ABL & 4) && IN_PH) { pg8::StaticOrder S; S.init(T, D, F.G, F.bid); pg8::EpiResid E{X, X};
                pg8::gemm_phase<pg8::EpiResid, pg8::StaticOrder, false>(ring, PROJ, (const bf16*)(F.ws + WS_WD), DFF, S, E, nullptr); }
            END_PH;
            if (PHON(6) && IN_PH) norm_phase(F, X, F.in[1] + D);
            END_PH;
        } else {
            if (PHON(9) && IN_PH) { norm_router_phase(F, X, F.in[21] + D, F.in[25]); __syncthreads(); moe_convert(F); }
            END_PH;
            for (int k = 0; k < ((ABL & 1) ? 0 : 2); ++k) {
                const int* stok = (const int*)(F.ws + WS_STOK) + (size_t)k * NE * T; const float* sw = (const float*)(F.ws + WS_SW) + (size_t)k * NE * T;
                if (PHON(10) && IN_PH) { pg8::MoeOrder S; S.init(F.ctl + CW_MOECNT + 8 * k, 28, F.G, F.bid); pg8::EpiSwiglu E{PROJ, DFE, 28};
                    pg8::gemm_phase<pg8::EpiSwiglu, pg8::MoeOrder, true>(ring, HM, (const bf16*)(F.ws + WS_MOEW_GU), D, S, E, stok); }
                END_PH;
                if (PHON(11) && IN_PH) { pg8::MoeOrder S; S.init(F.ctl + CW_MOECNT + 8 * k, 4, F.G, F.bid); pg8::EpiScatter E{X, stok, sw, 4};
                    pg8::gemm_phase<pg8::EpiScatter, pg8::MoeOrder, false>(ring, PROJ, (const bf16*)(F.ws + WS_MOEW_D), DFE, S, E, nullptr); }
                END_PH;
            }
            if (PHON(12) && IN_PH) final_norm_phase(F, X, F.in[29]);
            END_PH;
            if (ABL & 4096) { if (IN_PH) { for (size_t i = (size_t)F.bid * NTHR + F.tid; i < (size_t)T * D; i += (size_t)F.G * NTHR) X[i] = (i == 0) ? ((const float*)(F.ctl + 2048))[0] : 0.f; } END_PH; }
        }
}
#undef IN_PH
#undef END_PH
struct Args { const float* in[30]; float* out; unsigned char* ws; int ph_lo, ph_hi; };
constexpr int N_PHASES = 21 + ((ABL & 4096) ? 2 : 0);
__global__ void __launch_bounds__(NTHR, 2) fwd(Args args) {
    extern __shared__ __attribute__((aligned(16))) unsigned char lds[];
    Frame F;
    F.lds = (LAS unsigned char*)lds; F.MISC = (volatile LAS unsigned*)(F.lds + MISC_OFF);
    F.tid = threadIdx.x; F.lane = F.tid & 63; F.wave = __builtin_amdgcn_readfirstlane(F.tid >> 6);
    F.G = gridDim.x; F.bid = blockIdx.x; F.in = args.in; F.out = args.out; F.ws = args.ws; F.ctl = (unsigned*)(args.ws + WS_CTL);
    for (int u = F.tid; u < 64; u += NTHR) F.MISC[u] = 0u;
    __syncthreads();
    const int lo = args.ph_lo, hi = args.ph_hi;
    XcdBarrier bar; bar.bar = F.ctl + CW_BAR; bar.x = 0; bar.st = nullptr;
    if (hi - lo > 1) bar = xcd_barrier_post(F.ctl + CW_BAR, F.MISC + 8);
    int ph = 0;
#define IN_PH (lo <= ph && ph < hi)
#define END_PH do { if (IN_PH && ph + 1 < hi) xcd_barrier(bar); ++ph; } while (0)
    LAS unsigned char* ring = F.lds;
    bf16* HM = (bf16*)(F.ws + WS_HM); bf16* PROJ = (bf16*)(F.ws + WS_PROJ); float* X = F.out;

    if (PHON(0) && IN_PH) p0_prologue(F);
    END_PH;
    layer_phases<0>(F, bar, lo, hi, ph);
    layer_phases<1>(F, bar, lo, hi, ph);
#undef IN_PH
#undef END_PH
}

extern "C" void kernel_launch(void* const* d_in, const int* in_sizes, int n_in, void* d_out, int out_size, void* d_ws, size_t ws_size, hipStream_t stream) {
    static int grid = 0;
    if (grid == 0) {
        if (n_in != 30 || in_sizes[0] != T * D || out_size != T * D || ws_size < WS_NEED) { fprintf(stderr, "kernel_launch: unexpected shapes (n_in %d, in0 %d, out %d, ws %zu < %zu); nothing launched\n", n_in, n_in > 0 ? in_sizes[0] : -1, out_size, ws_size, (size_t)WS_NEED); grid = -1; return; }
        int dev = 0, cus = 0, per_cu = 0;
        if (hipGetDevice(&dev) != hipSuccess || hipDeviceGetAttribute(&cus, hipDeviceAttributeMultiprocessorCount, dev) != hipSuccess) { grid = -1; return; }
        if (hipFuncSetAttribute((const void*)fwd, hipFuncAttributeMaxDynamicSharedMemorySize, LDS_BYTES) != hipSuccess) { fprintf(stderr, "kernel_launch: hipFuncSetAttribute failed\n"); grid = -1; return; }
        if (hipOccupancyMaxActiveBlocksPerMultiprocessor(&per_cu, (const void*)fwd, NTHR, LDS_BYTES) != hipSuccess || per_cu < 1) fprintf(stderr, "kernel_launch: occupancy query says %d\n", per_cu);
        (void)hipGetLastError();
        grid = cus;
    }
    if (grid < 0) return;
    if (hipMemsetAsync((char*)d_ws + WS_CTL, 0, CTL_ZERO_BYTES, stream) != hipSuccess) return;
    Args a{};
    for (int i = 0; i < 30; ++i) a.in[i] = (const float*)d_in[i];
    a.out = (float*)d_out; a.ws = (unsigned char*)d_ws;
#if MK_ONE_LAUNCH
    a.ph_lo = 0; a.ph_hi = N_PHASES;
    hipLaunchKernelGGL(fwd, dim3(grid), dim3(NTHR), LDS_BYTES, stream, a);
#else
    for (int p = 0; p < N_PHASES; ++p) { a.ph_lo = p; a.ph_hi = p + 1; hipLaunchKernelGGL(fwd, dim3(grid), dim3(NTHR), LDS_BYTES, stream, a); }
#endif
}
```

```cpp
#include <hip/hip_runtime.h>
#include <cstdio>
#include <cstdint>

#ifndef PHMASK
#define PHMASK 0xffff
#endif
#define PHON(k) ((PHMASK >> (k)) & 1)
#ifndef REPEAT
#define REPEAT 0
#endif
#ifndef DUMPS
#define DUMPS 0
#endif
#ifndef FINPARTS
#define FINPARTS 7
#endif
#ifndef ABL
#define ABL 0
#endif
#ifndef MK_ONE_LAUNCH
#define MK_ONE_LAUNCH 1
#endif

#define LAS __attribute__((address_space(3)))
#define GAS __attribute__((address_space(1)))
typedef unsigned short bf16;
typedef short bf16x8 __attribute__((ext_vector_type(8)));
typedef short s16x4 __attribute__((ext_vector_type(4)));
typedef float f32x4 __attribute__((ext_vector_type(4)));
typedef float f32x16 __attribute__((ext_vector_type(16)));
typedef unsigned u32x4 __attribute__((ext_vector_type(4)));
typedef unsigned u32x2 __attribute__((ext_vector_type(2)));

constexpr int T = 32768, D = 1024, SEQ = 4096, NB = 8, NCH = 64, CH = 64;
constexpr int PP = 3072;
constexpr int QA = 0, KA = 256, VA = 512, GA = 768, QB = 1024, KB = 1280, VB = 1536, XC = 1792, GC = 2048, QD = 2304, KD = 2432, VD = 2560, RD = 2816;
constexpr int NIN = 3328;
constexpr int DFF = 2816, DFE = 3584, NE = 8;
constexpr float EPS = 1e-6f;
constexpr float LOG2E = 1.4426950408889634f;

constexpr size_t MiB = 1u << 20;
constexpr size_t WS_CTL = 0, CTL_ZERO_BYTES = 1 * MiB;
constexpr size_t WS_STOK = 1 * MiB;
constexpr size_t WS_SW = 3 * MiB;
constexpr size_t WS_WIN = 5 * MiB;
constexpr size_t WS_WOUT = 18 * MiB;
constexpr size_t WS_WGU = 22 * MiB;
constexpr size_t WS_WD = 33 * MiB;
constexpr size_t WS_HM = 39 * MiB;
constexpr size_t WS_SMALL = 103 * MiB;
constexpr size_t WS_PROJ = 107 * MiB;
constexpr size_t WS_TMP = 299 * MiB;
constexpr size_t WS_GM = WS_TMP;
constexpr size_t WS_GN = WS_GM + 32 * MiB;
constexpr size_t WS_GQ = WS_GN + 32 * MiB;
constexpr size_t WS_GO = WS_GQ + 32 * MiB;
constexpr size_t WS_LOI = WS_GO + 32 * MiB;
constexpr size_t WS_LQG = WS_LOI + 32 * MiB;
constexpr size_t WS_LKV = WS_LQG + 16 * MiB;
constexpr size_t WS_RHL = WS_LKV + 16 * MiB;
constexpr size_t WS_RP = WS_RHL + 16 * MiB;
constexpr size_t WS_MISC = WS_RP + 16 * MiB;
constexpr size_t WS_LDL = WS_MISC;
constexpr size_t WS_RAT = WS_MISC + 512 * 1024;
constexpr size_t WS_RHE = WS_RAT + 512 * 1024;
constexpr size_t WS_RCA = WS_RHE + 512 * 1024;
constexpr size_t WS_TMP_END = WS_MISC + 2 * MiB;
constexpr size_t WS_MOEW_GU = 345 * MiB;
constexpr size_t WS_MOEW_D = 457 * MiB;
constexpr size_t WS_END = 513 * MiB;
constexpr size_t WS_NEED = 525 * MiB;
static_assert(WS_TMP_END <= WS_NEED && WS_END <= WS_NEED, "ws map");
static_assert(WS_PROJ + (size_t)34816 * DFE * 2 <= WS_MOEW_GU, "moe act fits under moe weights");
constexpr int CW_TMO = 0;
constexpr int CW_QUEUE = 64;
constexpr int CW_MOECNT = 1024;
constexpr int CW_BAR = 4096;

constexpr int RING_BYTES = 131072;
constexpr int MISC_OFF = RING_BYTES;
constexpr int LDS_BYTES = RING_BYTES + 4096;
constexpr int NWAVES = 8, NTHR = 512;

__device__ __forceinline__ unsigned f2bf(float f) { unsigned u = __builtin_bit_cast(unsigned, f); return (u + 0x7fffu + ((u >> 16) & 1u)) >> 16; }
__device__ __forceinline__ unsigned pk2(float lo, float hi) { return f2bf(lo) | (f2bf(hi) << 16); }
__device__ __forceinline__ float bflo(unsigned w) { return __builtin_bit_cast(float, w << 16); }
__device__ __forceinline__ float bfhi(unsigned w) { return __builtin_bit_cast(float, w & 0xffff0000u); }
__device__ __forceinline__ float bf2f(bf16 b) { return __builtin_bit_cast(float, ((unsigned)b) << 16); }
__device__ __forceinline__ float wave_sum(float v) {
#pragma unroll
    for (int o = 1; o < 64; o <<= 1) v += __shfl_xor(v, o);
    return v;
}
__device__ __forceinline__ float fexp(float x) { return __builtin_amdgcn_exp2f(x * LOG2E); }
__device__ __forceinline__ float sigmoidf_(float x) { return 1.0f / (1.0f + __expf(-x)); }
__device__ __forceinline__ float siluf_(float x) { return x / (1.0f + __expf(-x)); }
__device__ __forceinline__ float softplusf_(float x) { return fmaxf(x, 0.f) + log1pf(__expf(-fabsf(x))); }
__device__ __forceinline__ float gelu_tanh(float x) { const float u = 0.7978845608028654f * (x + 0.044715f * x * x * x); return 0.5f * x * (1.0f + tanhf(u)); }
#define LDS_WAIT() asm volatile("s_waitcnt lgkmcnt(0)" ::: "memory")
#define VM_WAIT() asm volatile("s_waitcnt vmcnt(0)" ::: "memory")

namespace pg8 {
constexpr int BM = 256, BK = 64, HALF = 128, HTB = HALF * BK * 2, STAGE_BYTES = 8 * HTB, NXCD = 8, WGM = 8;
__host__ __device__ __forceinline__ int lds_byte(int r, int c) { const int st = (r >> 4) * 2 + (c >> 5), rr = r & 15, cc = c & 31, ob = rr * 64 + cc * 2; return st * 1024 + (ob ^ (((ob >> 9) & 1) << 5)); }
__host__ __device__ __forceinline__ void stage_rc(int b, int& R, int& C) { const int st = b / 1024, sb = b % 1024, swz = sb ^ (((sb >> 9) & 1) << 5); R = (st >> 1) * 16 + swz / 64; C = (st & 1) * 32 + (swz % 64) / 2; }
__host__ __device__ __forceinline__ int perm32(int rho) { const int n = rho >> 4, i = rho & 15; return 8 * (i >> 2) + 4 * n + (i & 3); }

struct Unit { int pm, pn, e, vr, lbase; };

struct StaticOrder {
    int nM, nN, nwg, G, c;
    __device__ void init(int M, int N, int G_, int c_) { nM = M / BM; nN = N / BM; nwg = nM * nN; G = G_; c = c_; }
    __device__ bool next(int i, Unit& u) const {
        const long L = (long)i * G + c; if (L >= nwg) return false;
        int wgid = (int)L; { const int q = nwg / NXCD, r = nwg % NXCD, xcd = wgid % NXCD, off = wgid / NXCD; wgid = (xcd < r ? xcd * (q + 1) : r * (q + 1) + (xcd - r) * q) + off; }
        const int nig = WGM * nN, gid = wgid / nig, fm = gid * WGM, gsz = (nM - fm) < WGM ? (nM - fm) : WGM;
        u.pm = fm + ((wgid % nig) % gsz); u.pn = (wgid % nig) / gsz; u.e = 0; u.vr = 256; u.lbase = 0; return true;
    }
};
struct MoeOrder {
    int pre[9], cnt[8], nN, G, c, total;
    __device__ void init(const unsigned* gcnt, int nN_, int G_, int c_) {
        int p = 0;
#pragma unroll
        for (int e = 0; e < 8; ++e) { cnt[e] = (int)__hip_atomic_load(gcnt + e, __ATOMIC_RELAXED, __HIP_MEMORY_SCOPE_AGENT); pre[e] = p; p += (cnt[e] + 255) >> 8; }
        pre[8] = p; nN = nN_; G = G_; c = c_; total = p * nN_;
    }
    __device__ bool next(int i, Unit& u) const {
        const long L = (long)i * G + c; if (L >= total) return false;
        const int pm = (int)(L / nN), pl = (int)(L % nN); int e = 0;
#pragma unroll
        for (int j = 1; j < 8; ++j) if (pm >= pre[j]) e = j;
        int pe = 0, ce = 0;
#pragma unroll
        for (int j = 0; j < 8; ++j) if (j == e) { pe = pre[j]; ce = cnt[j]; }
        const int lt = pm - pe, rem = ce - lt * 256;
        u.pm = pm; u.pn = e * nN + pl; u.e = e; u.vr = rem < 256 ? rem : 256; u.lbase = e * T + lt * 256; return true;
    }
};

__device__ __forceinline__ unsigned cvt_pk_bf16(float lo, float hi) { unsigned r; asm volatile("v_cvt_pk_bf16_f32 %0, %1, %2" : "=v"(r) : "v"(lo), "v"(hi)); return r; }

struct EpiProj {
    static constexpr bool PERM = true;
    bf16* P; float* SM;
    __device__ __forceinline__ void operator()(const f32x4 (&acc)[2][2][4][2], const Unit& u, int wr, int wc, int fr, int fq) const {
        const int row0 = u.pm * BM + wr * 64 + fr;
        if (u.pn < 12) {
            const int col0 = u.pn * BM + wc * 32 + 8 * fq;
#pragma unroll
            for (int ai = 0; ai < 2; ++ai)
#pragma unroll
                for (int m = 0; m < 4; ++m) { bf16* rowp = P + (size_t)(row0 + ai * HALF + m * 16) * PP + col0;
#pragma unroll
                    for (int bj = 0; bj < 2; ++bj) { const f32x4 v0 = acc[ai][bj][m][0], v1 = acc[ai][bj][m][1];
                        u32x4 w; w.x = cvt_pk_bf16(v0[0], v0[1]); w.y = cvt_pk_bf16(v0[2], v0[3]); w.z = cvt_pk_bf16(v1[0], v1[1]); w.w = cvt_pk_bf16(v1[2], v1[3]);
                        *(u32x4*)(rowp + bj * HALF) = w; } }
        } else if (wc == 0) {
#pragma unroll
            for (int ai = 0; ai < 2; ++ai)
#pragma unroll
                for (int m = 0; m < 4; ++m) { float* sp = SM + (size_t)(row0 + ai * HALF + m * 16) * 32 + 8 * fq;
                    *(f32x4*)sp = acc[ai][0][m][0]; *(f32x4*)(sp + 4) = acc[ai][0][m][1]; }
        }
    }
};
struct EpiResid {
    static constexpr bool PERM = false;
    const float* res; float* out;
    __device__ __forceinline__ void operator()(const f32x4 (&acc)[2][2][4][2], const Unit& u, int wr, int wc, int fr, int fq) const {
        const int row0 = u.pm * BM + wr * 64 + fr, col0 = u.pn * BM + wc * 32 + 4 * fq;
#pragma unroll
        for (int ai = 0; ai < 2; ++ai)
#pragma unroll
            for (int m = 0; m < 4; ++m) { const size_t off = (size_t)(row0 + ai * HALF + m * 16) * D + col0;
#pragma unroll
                for (int bj = 0; bj < 2; ++bj)
#pragma unroll
                    for (int n = 0; n < 2; ++n) { const size_t o = off + bj * HALF + n * 16; *(f32x4*)(out + o) = *(const f32x4*)(res + o) + acc[ai][bj][m][n]; }
                asm volatile("" ::: "memory"); }
    }
};
struct EpiSwiglu {
    static constexpr bool PERM = true;
    bf16* act; int ldc, nN;
    __device__ __forceinline__ void operator()(const f32x4 (&acc)[2][2][4][2], const Unit& u, int wr, int wc, int fr, int fq) const {
        const int pl = u.pn % nN;
        const int row0 = u.pm * BM + wr * 64 + fr, col0 = pl * HALF + wc * 32 + 8 * fq;
#pragma unroll
        for (int ai = 0; ai < 2; ++ai)
#pragma unroll
            for (int m = 0; m < 4; ++m) { bf16* rowp = act + (size_t)(row0 + ai * HALF + m * 16) * ldc + col0;
                float o[8];
#pragma unroll
                for (int n = 0; n < 2; ++n)
#pragma unroll
                    for (int j = 0; j < 4; ++j) { const float g = acc[ai][0][m][n][j], up = acc[ai][1][m][n][j];
                        o[4 * n + j] = g * up * __builtin_amdgcn_rcpf(1.0f + __builtin_amdgcn_exp2f(-g * LOG2E)); }
                u32x4 w; w.x = cvt_pk_bf16(o[0], o[1]); w.y = cvt_pk_bf16(o[2], o[3]); w.z = cvt_pk_bf16(o[4], o[5]); w.w = cvt_pk_bf16(o[6], o[7]);
                *(u32x4*)rowp = w; asm volatile("" ::: "memory"); }
    }
};
struct EpiScatter {
    static constexpr bool PERM = false;
    float* x; const int* tok; const float* wgt; int nN;
    __device__ __forceinline__ void operator()(const f32x4 (&acc)[2][2][4][2], const Unit& u, int wr, int wc, int fr, int fq) const {
        const int pl = u.pn % nN;
        const int rl0 = wr * 64 + fr, col0 = pl * BM + wc * 32 + 4 * fq;
#pragma unroll
        for (int ai = 0; ai < 2; ++ai)
#pragma unroll
            for (int m = 0; m < 4; ++m) { const int rl = rl0 + ai * HALF + m * 16;
                if (rl < u.vr) { const int t = tok[u.lbase + rl]; const float w = wgt[u.lbase + rl]; float* xp = x + (size_t)t * D + col0;
#pragma unroll
                    for (int bj = 0; bj < 2; ++bj)
#pragma unroll
                        for (int n = 0; n < 2; ++n) { f32x4* p = (f32x4*)(xp + bj * HALF + n * 16); *p = *p + acc[ai][bj][m][n] * w; } }
                asm volatile("" ::: "memory"); }
    }
};

template <class Epi, class Sched, bool GATHER>
__device__ __forceinline__ void gemm_phase(LAS unsigned char* lds, const bf16* A, const bf16* Bt, const int K, const Sched& S, const Epi& E, const int* glist) {
    int tid_ = threadIdx.x; asm volatile("" : "+v"(tid_));
    const int tid = tid_, wid = __builtin_amdgcn_readfirstlane(tid >> 6), lane = tid & 63, wr = wid >> 2, wc = wid & 3, fr = lane & 15, fq = lane >> 4;
    const int nt = K / BK;
    unsigned voffA[2], voffB[2]; int gR[2], gC[2];
#pragma unroll
    for (int i = 0; i < 2; ++i) { int R, C; stage_rc(tid * 16 + i * 8192, R, C); const int Rb = Epi::PERM ? ((R & ~31) + perm32(R & 31)) : R;
        voffA[i] = (unsigned)(R * K + C) * 2u; voffB[i] = (unsigned)(Rb * K + C) * 2u; gR[i] = R; gC[i] = C; }
    const size_t kstep = (size_t)(BK * 2);
    const size_t hstep = (size_t)HALF * K * 2;
    const size_t tstep = 2 * hstep;
    const unsigned ldsw = (unsigned)wid * 1024u;
    const int aoff = lds_byte(wr * 64 + fr, fq * 8), boff = lds_byte(wc * 32 + fr, fq * 8);
#define PG8_SA(b, h) (((b) * 2 + (h)) * HTB)
#define PG8_SB(b, h) ((4 + (b) * 2 + (h)) * HTB)
#define PG8_STAGE(bufoff, gbase, voff) do { _Pragma("unroll") for (int _i = 0; _i < 2; ++_i) \
        __builtin_amdgcn_global_load_lds((const unsigned*)((const char*)(gbase) + (voff)[_i]), (LAS unsigned*)(lds + (bufoff) + ldsw + _i * 8192), 16, 0, 0); } while (0)
#define PG8_STAGE_A(b, h, ubase, koff, OFFS) do { if constexpr (GATHER) { PG8_STAGE(PG8_SA(b, h), (const char*)A + (koff), (OFFS)[h]); } \
        else { PG8_STAGE(PG8_SA(b, h), (ubase) + (size_t)(h) * hstep + (koff), voffA); } } while (0)
#define PG8_LDA(dst, b, h) do { _Pragma("unroll") for (int m = 0; m < 4; ++m) _Pragma("unroll") for (int k = 0; k < 2; ++k) dst[m][k] = *(const LAS bf16x8*)(lds + PG8_SA(b, h) + aoff + m * 2048 + k * 1024); } while (0)
#define PG8_LDB(dst, b, h) do { _Pragma("unroll") for (int n = 0; n < 2; ++n) _Pragma("unroll") for (int k = 0; k < 2; ++k) dst[n][k] = *(const LAS bf16x8*)(lds + PG8_SB(b, h) + boff + n * 2048 + k * 1024); } while (0)
#define PG8_MMA(ai, bj, At, Bt_) do { __builtin_amdgcn_s_setprio(1); _Pragma("unroll") for (int m = 0; m < 4; ++m) _Pragma("unroll") for (int n = 0; n < 2; ++n) _Pragma("unroll") for (int k = 0; k < 2; ++k) \
        acc[ai][bj][m][n] = __builtin_amdgcn_mfma_f32_16x16x32_bf16(Bt_[n][k], At[m][k], acc[ai][bj][m][n], 0, 0, 0); __builtin_amdgcn_s_setprio(0); } while (0)
#define PG8_WAIT_V(n) asm volatile("s_waitcnt vmcnt(" #n ")" ::: "memory")
#define PG8_WAIT_L(n) asm volatile("s_waitcnt lgkmcnt(" #n ")" ::: "memory")
#define PG8_BAR __builtin_amdgcn_s_barrier()
#define PG8_SCHED __builtin_amdgcn_sched_barrier(0)
#define PG8_GOFF(dst, U) do { _Pragma("unroll") for (int _h = 0; _h < 2; ++_h) _Pragma("unroll") for (int _i = 0; _i < 2; ++_i) { const int _row = _h * HALF + gR[_i]; \
        const int _tk = (_row < (U).vr) ? glist[(U).lbase + _row] : 0; dst[_h][_i] = (unsigned)(_tk * K + gC[_i]) * 2u; } } while (0)
    Unit cur, nxt; int ui = 0;
    if (!S.next(0, cur)) return;
    f32x4 acc[2][2][4][2];
#pragma unroll
    for (int a = 0; a < 2; ++a)
#pragma unroll
        for (int b = 0; b < 2; ++b)
#pragma unroll
            for (int m = 0; m < 4; ++m)
#pragma unroll
                for (int n = 0; n < 2; ++n) acc[a][b][m][n] = (f32x4){0.f, 0.f, 0.f, 0.f};
    bf16x8 At[4][2], B0[2][2], B1[2][2];
    unsigned gofc[2][2] = {{0u, 0u}, {0u, 0u}}, gofn[2][2] = {{0u, 0u}, {0u, 0u}};
    if constexpr (GATHER) { PG8_GOFF(gofc, cur); }
    const char* cA = (const char*)A + (size_t)cur.pm * tstep; const char* cB = (const char*)Bt + (size_t)cur.pn * tstep;
    PG8_STAGE(PG8_SB(0, 0), cB, voffB); PG8_STAGE(PG8_SB(0, 1), cB + hstep, voffB); PG8_STAGE_A(0, 0, cA, 0, gofc); PG8_STAGE_A(0, 1, cA, 0, gofc);
    if (wr == 1) PG8_BAR;
    PG8_WAIT_V(2); PG8_BAR;
    PG8_STAGE(PG8_SB(1, 0), cB + kstep, voffB); PG8_STAGE_A(1, 0, cA, kstep, gofc); PG8_STAGE(PG8_SB(1, 1), cB + hstep + kstep, voffB);
    PG8_WAIT_V(6); PG8_BAR;
    for (;;) {
        const bool has_next = S.next(ui + 1, nxt);
        const char* nA = has_next ? (const char*)A + (size_t)nxt.pm * tstep : cA; const char* nB = has_next ? (const char*)Bt + (size_t)nxt.pn * tstep : cB;
        if constexpr (GATHER) { if (has_next) { PG8_GOFF(gofn, nxt); } else {
#pragma unroll
            for (int h = 0; h < 2; ++h)
#pragma unroll
                for (int i = 0; i < 2; ++i) gofn[h][i] = gofc[h][i]; } }
        for (int t = 0; t < nt; t += 2) {
            const bool last = (t == nt - 2);
            const size_t k1 = (size_t)(t + 1) * kstep;
            const char* ua2 = last ? nA : cA; const size_t k2 = last ? 0 : (size_t)(t + 2) * kstep; const size_t k3 = k2 + kstep;
            const char* b2 = last ? nB : cB + (size_t)(t + 2) * kstep; const char* b3 = b2 + kstep;
            unsigned go2[2][2];
#pragma unroll
            for (int h = 0; h < 2; ++h)
#pragma unroll
                for (int i = 0; i < 2; ++i) go2[h][i] = last ? gofn[h][i] : gofc[h][i];
            PG8_LDB(B0, 0, 0); PG8_LDB(B1, 0, 1); PG8_SCHED; PG8_LDA(At, 0, 0); PG8_STAGE_A(1, 1, cA, k1, gofc);
            PG8_WAIT_V(8); PG8_WAIT_L(0); PG8_BAR; PG8_MMA(0, 0, At, B0); PG8_MMA(0, 1, At, B1); PG8_BAR; PG8_SCHED;
            PG8_LDA(At, 0, 1); PG8_STAGE(PG8_SB(0, 0), b2, voffB); PG8_STAGE(PG8_SB(0, 1), b2 + hstep, voffB); PG8_STAGE_A(0, 0, ua2, k2, go2);
            PG8_WAIT_V(8); PG8_WAIT_L(0); PG8_BAR; PG8_MMA(1, 0, At, B0); PG8_MMA(1, 1, At, B1); PG8_BAR; PG8_SCHED;
            PG8_LDB(B0, 1, 0); PG8_LDB(B1, 1, 1); PG8_SCHED; PG8_LDA(At, 1, 0); PG8_STAGE_A(0, 1, ua2, k2, go2);
            PG8_WAIT_V(8); PG8_WAIT_L(0); PG8_BAR; PG8_MMA(0, 0, At, B0); PG8_MMA(0, 1, At, B1); PG8_BAR; PG8_SCHED;
            PG8_LDA(At, 1, 1); PG8_STAGE(PG8_SB(1, 0), b3, voffB); PG8_STAGE(PG8_SB(1, 1), b3 + hstep, voffB); PG8_STAGE_A(1, 0, ua2, k3, go2);
            PG8_WAIT_V(8); PG8_WAIT_L(0); PG8_BAR; PG8_MMA(1, 0, At, B0); PG8_MMA(1, 1, At, B1); PG8_BAR; PG8_SCHED;
        }
        if (wr == 0) PG8_BAR;
        E(acc, cur, wr, wc, fr, fq);
        if (!has_next) break;
#pragma unroll
        for (int a = 0; a < 2; ++a)
#pragma unroll
            for (int b = 0; b < 2; ++b)
#pragma unroll
                for (int m = 0; m < 4; ++m)
#pragma unroll
                    for (int n = 0; n < 2; ++n) acc[a][b][m][n] = (f32x4){0.f, 0.f, 0.f, 0.f};
        cur = nxt; cA = nA; cB = nB; ++ui;
#pragma unroll
        for (int h = 0; h < 2; ++h)
#pragma unroll
            for (int i = 0; i < 2; ++i) gofc[h][i] = gofn[h][i];
        if (wr == 1) PG8_BAR;
    }
    PG8_WAIT_V(0);
    PG8_BAR;
#undef PG8_SA
#undef PG8_SB
#undef PG8_STAGE
#undef PG8_STAGE_A
#undef PG8_LDA
#undef PG8_LDB
#undef PG8_MMA
#undef PG8_WAIT_V
#undef PG8_WAIT_L
#undef PG8_BAR
#undef PG8_SCHED
#undef PG8_GOFF
}
}

#define XB_TMO      128
#define XB_XCNT(j)  (256  + 64 * (j))
#define XB_XSUB(j)  (1280 + 64 * (j))
#define XB_XGEN(j)  (2304 + 64 * (j))
#define XB_TOP      3328
#define XB_TOPGEN   3392
#define XCD_BAR_WORDS 3456
#define XB_SPIN_CAP (1u << 18)
__device__ __forceinline__ unsigned xb_ld(unsigned* p)              { return __hip_atomic_load(p, __ATOMIC_RELAXED, __HIP_MEMORY_SCOPE_AGENT); }
__device__ __forceinline__ unsigned xb_add(unsigned* p, unsigned v) { return __hip_atomic_fetch_add(p, v, __ATOMIC_RELAXED, __HIP_MEMORY_SCOPE_AGENT); }
__device__ __forceinline__ unsigned xb_xcc_id() { return (unsigned)__builtin_amdgcn_s_getreg((3 << 11) | 20) & 0xFu; }
#define XB_SPIN(cond, bar) do { unsigned _sp = 0; while (cond) { __builtin_amdgcn_s_sleep(1); \
    if ((++_sp & 255u) == 0u) { if (xb_ld(&(bar)[XB_TMO])) break; if (_sp > XB_SPIN_CAP) { atomicAdd(&(bar)[XB_TMO], 1u); break; } } } } while (0)
struct XcdBarrier { unsigned* bar; unsigned x; volatile LAS unsigned* st; };
__device__ __forceinline__ XcdBarrier xcd_barrier_post(unsigned* bar, volatile LAS unsigned* st) {
    XcdBarrier b; b.bar = bar; b.x = xb_xcc_id(); b.st = st;
    if (threadIdx.x == 0) (void)xb_add(&bar[XB_XCNT(b.x)], 1u);
    return b;
}
__device__ __forceinline__ void xcd_barrier_complete(unsigned* bar, unsigned x, unsigned& nloc, unsigned& nx) {
    const unsigned G = gridDim.x * gridDim.y * gridDim.z;
    unsigned sum, cnt, mine, sp = 0u;
    for (;;) {
        sum = 0u; cnt = 0u; mine = 0u;
#pragma unroll
        for (unsigned j = 0; j < 16; ++j) { const unsigned c = xb_ld(&bar[XB_XCNT(j)]); sum += c; cnt += (c > 0u) ? 1u : 0u; mine = (j == x) ? c : mine; }
        if (sum == G) break;
        __builtin_amdgcn_s_sleep(1);
        if ((++sp & 255u) == 0u) { if (xb_ld(&bar[XB_TMO])) break; if (sp > XB_SPIN_CAP) { atomicAdd(&bar[XB_TMO], 1u); break; } }
    }
    nloc = mine > 0u ? mine : 1u; nx = cnt > 0u ? cnt : 1u;
}
__device__ __forceinline__ void xcd_barrier(const XcdBarrier& b) {
    asm volatile("s_waitcnt vmcnt(0)" ::: "memory");
    __syncthreads();
    if (threadIdx.x == 0) {
        unsigned* bar = b.bar;
        __builtin_amdgcn_s_waitcnt(0);
        unsigned nloc = b.st[0], nx = b.st[1];
        if (nloc == 0u) { xcd_barrier_complete(bar, b.x, nloc, nx); b.st[0] = nloc; b.st[1] = nx; }
        const unsigned old = xb_add(&bar[XB_XSUB(b.x)], 1u);
        const unsigned gen = old / nloc;
        if (old + 1u == (gen + 1u) * nloc) {
            __builtin_amdgcn_fence(__ATOMIC_RELEASE, "agent");
            asm volatile("s_waitcnt vmcnt(0)" ::: "memory");
            const unsigned og = xb_add(&bar[XB_TOP], 1u);
            const unsigned tg = og / nx;
            if (og + 1u == (tg + 1u) * nx) xb_add(&bar[XB_TOPGEN], 1u);
            else XB_SPIN(xb_ld(&bar[XB_TOPGEN]) == tg, bar);
            __builtin_amdgcn_fence(__ATOMIC_ACQUIRE, "agent");
            xb_add(&bar[XB_XGEN(b.x)], 1u);
            asm volatile("s_waitcnt vmcnt(0)" ::: "memory");
        } else {
            XB_SPIN(xb_ld(&bar[XB_XGEN(b.x)]) == gen, bar);
            __builtin_amdgcn_fence(__ATOMIC_ACQUIRE, "agent");
            asm volatile("s_waitcnt vmcnt(0)" ::: "memory");
        }
    }
    __syncthreads();
}


struct Frame {
    LAS unsigned char* lds;
    volatile LAS unsigned* MISC;
    unsigned* ctl;
    int tid, lane, wave, G, bid;
    const float* const* in;
    float* out; unsigned char* ws;
};

template <class P> __device__ __forceinline__ P lptr(P p) { unsigned long long v = (unsigned long long)p; unsigned lo = (unsigned)v, hi = (unsigned)(v >> 32); asm volatile("" : "+v"(lo), "+v"(hi));
    lo = __builtin_amdgcn_readfirstlane(lo); hi = __builtin_amdgcn_readfirstlane(hi); return (P)(((unsigned long long)hi << 32) | lo); }
__device__ __forceinline__ Frame opq(Frame F) { asm volatile("" : "+v"(F.tid));  F.lane = F.tid & 63; F.wave = __builtin_amdgcn_readfirstlane(F.tid >> 6); return F; }

template <bool TA, bool TB>
__device__ __forceinline__ f32x4 mm16(const LAS float* A, int lda, const LAS float* B, int ldb, int i0, int j0, int K, f32x4 acc, int lane) {
    const int lr = lane & 15, lg = lane >> 4;
    for (int ks = 0; ks < K; ks += 4) {
        const int k = ks + lg;
        const float a = TA ? A[k * lda + i0 + lr] : A[(i0 + lr) * lda + k];
        const float b = TB ? B[(j0 + lr) * ldb + k] : B[k * ldb + j0 + lr];
        acc = __builtin_amdgcn_mfma_f32_16x16x4f32(a, b, acc, 0, 0, 0);
    }
    asm volatile("s_nop 15\n\ts_nop 7" : "+v"(acc));
    return acc;
}

__device__ __forceinline__ void tr_item(const float* src, int ld, int scol, bf16* WT, int K, int r0, int k0, LAS float* scr, int lane) {
#pragma unroll 8
    for (int i = 0; i < 32; ++i) { const int kk = 2 * i + (lane >> 5); const float v = scol >= 0 ? src[(size_t)(k0 + kk) * ld + scol] : 0.f; scr[kk * 33 + (lane & 31)] = v; }
    LDS_WAIT(); asm volatile("" ::: "memory");
    const int c = lane & 7;
#pragma unroll
    for (int j = 0; j < 4; ++j) { const int n = (lane >> 3) + 8 * j; const LAS float* s = scr + (8 * c) * 33 + n;
        u32x4 o; o.x = pk2(s[0 * 33], s[1 * 33]); o.y = pk2(s[2 * 33], s[3 * 33]); o.z = pk2(s[4 * 33], s[5 * 33]); o.w = pk2(s[6 * 33], s[7 * 33]);
        *(u32x4*)(WT + (size_t)(r0 + n) * K + k0 + 8 * c) = o; }
    LDS_WAIT(); asm volatile("" ::: "memory");
}

__device__ __forceinline__ void norm_row(const float* xrow, const f32x4 (&g)[4], bf16* orow, f32x4 (&v)[4], int lane) {
    const f32x4* xr = (const f32x4*)xrow + lane; float s = 0.f;
#pragma unroll
    for (int j = 0; j < 4; ++j) { v[j] = xr[64 * j]; s += (v[j].x * v[j].x + v[j].y * v[j].y) + (v[j].z * v[j].z + v[j].w * v[j].w); }
    const float r = 1.0f / sqrtf(wave_sum(s) * (1.f / D) + EPS);
    unsigned long long* o8 = (unsigned long long*)orow + lane;
#pragma unroll
    for (int j = 0; j < 4; ++j) { v[j] = v[j] * r * g[j]; o8[64 * j] = (unsigned long long)pk2(v[j].x, v[j].y) | ((unsigned long long)pk2(v[j].z, v[j].w) << 32); }
}

__device__ __forceinline__ void p0_prologue(const Frame& F0) { Frame F = opq(F0);
    LAS float* scr = (LAS float*)(F.lds + F.wave * 16384);
    const int gw = F.bid * NWAVES + F.wave, NGW = F.G * NWAVES;
    const float* w_in = F.in[2]; const float* w_out = F.in[20]; const float* fg = F.in[22]; const float* fu = F.in[23]; const float* fd = F.in[24];
    bf16* Win = (bf16*)(F.ws + WS_WIN); bf16* Wout = (bf16*)(F.ws + WS_WOUT); bf16* Wgu = (bf16*)(F.ws + WS_WGU); bf16* Wd = (bf16*)(F.ws + WS_WD);
    constexpr int I_IN = 2 * 16 * 104, I_OUT = 2 * 16 * 32, I_GU = 16 * 176, I_D = 44 * 32;
    const int j = F.lane & 31;
    for (int it = gw; it < I_IN + I_OUT + I_GU + I_D; it += NGW) {
        int r = it;
        if (r < I_IN) { const int l = r / (16 * 104), q = r % (16 * 104), kb = q / 104, nb = q % 104, n = 32 * nb + j;
            const int scol = n < 1024 ? n : n < 3072 ? n + 8 : n < 3080 ? n - 2048 : n < 3096 ? n : -1;
            tr_item(w_in + (size_t)l * D * 3096, 3096, scol, Win + (size_t)l * NIN * D, D, 32 * nb, 64 * kb, scr, F.lane); continue; }
        r -= I_IN;
        if (r < I_OUT) { const int l = r / 512, q = r % 512, kb = q / 32, nb = q % 32;
            tr_item(w_out + (size_t)l * D * D, D, 32 * nb + j, Wout + (size_t)l * D * D, D, 32 * nb, 64 * kb, scr, F.lane); continue; }
        r -= I_OUT;
        if (r < I_GU) { const int kb = r / 176, nb = r % 176, r0 = 32 * nb, pn = r0 >> 8, j0 = r0 & 255;
            tr_item(j0 < 128 ? fg : fu, DFF, pn * 128 + (j0 & 127) + j, Wgu, D, r0, 64 * kb, scr, F.lane); continue; }
        r -= I_GU;
        { const int kb = r / 32, nb = r % 32; tr_item(fd, D, 32 * nb + j, Wd, DFF, 32 * nb, 64 * kb, scr, F.lane); }
    }
    f32x4 g[4];
#pragma unroll
    for (int q = 0; q < 4; ++q) g[q] = ((const f32x4*)F.in[1])[F.lane + 64 * q];
    bf16* H = (bf16*)(F.ws + WS_HM);
    for (int m = gw; m < T; m += NGW) { f32x4 v[4]; norm_row(F.in[0] + (size_t)m * D, g, H + (size_t)m * D, v, F.lane); }
}
__device__ __forceinline__ void moe_convert(const Frame& F0) { Frame F = opq(F0);
    LAS float* scr = (LAS float*)(F.lds + F.wave * 16384);
    const int gw = F.bid * NWAVES + F.wave, NGW = F.G * NWAVES;
    const float* mg = F.in[26]; const float* mu = F.in[27]; const float* md = F.in[28];
    bf16* Wgu = (bf16*)(F.ws + WS_MOEW_GU); bf16* Wd = (bf16*)(F.ws + WS_MOEW_D);
    constexpr int I_GU = 16 * 224, I_D = 56 * 32;
    const int j = F.lane & 31;
    for (int it = gw; it < NE * (I_GU + I_D); it += NGW) {
        const int e = it / (I_GU + I_D); int r = it % (I_GU + I_D);
        if (r < I_GU) { const int kb = r / 224, nb = r % 224, r0 = 32 * nb, pn = r0 >> 8, j0 = r0 & 255;
            tr_item((j0 < 128 ? mg : mu) + (size_t)e * D * DFE, DFE, pn * 128 + (j0 & 127) + j, Wgu + (size_t)e * 7168 * D, D, r0, 64 * kb, scr, F.lane); continue; }
        r -= I_GU;
        { const int kb = r / 32, nb = r % 32; tr_item(md + (size_t)e * DFE * D, D, 32 * nb + j, Wd + (size_t)e * D * DFE, DFE, 32 * nb, 64 * kb, scr, F.lane); }
    }
}

__device__ __forceinline__ void norm_phase(const Frame& F0, const float* x, const float* gain) { Frame F = opq(F0);
    const int gw = F.bid * NWAVES + F.wave, NGW = F.G * NWAVES;
    f32x4 g[4];
#pragma unroll
    for (int q = 0; q < 4; ++q) g[q] = ((const f32x4*)gain)[F.lane + 64 * q];
    bf16* H = (bf16*)(F.ws + WS_HM);
    for (int m = gw; m < T; m += NGW) { f32x4 v[4]; norm_row(x + (size_t)m * D, g, H + (size_t)m * D, v, F.lane); }
}
__device__ __forceinline__ void norm_router_phase(const Frame& F0, const float* x, const float* gain, const float* wr) { Frame F = opq(F0);
    LAS float* WR = (LAS float*)F.lds;
    LAS int* lcnt = (LAS int*)(F.lds + 32768);
    LAS int* lbase = lcnt + 16;
    LAS int* rE = lbase + 16;
    LAS int* rP1 = rE + 128; LAS int* rP2 = rP1 + 128;
    LAS float* rW = (LAS float*)(rP2 + 128);
    f32x4 g[4];
#pragma unroll
    for (int q = 0; q < 4; ++q) g[q] = ((const f32x4*)gain)[F.lane + 64 * q];
    for (int i = F.tid; i < 2048; i += NTHR) ((LAS f32x4*)WR)[i] = ((const f32x4*)wr)[i];
    bf16* H = (bf16*)(F.ws + WS_HM);
    int* stok = (int*)(F.ws + WS_STOK); float* sw = (float*)(F.ws + WS_SW);
    unsigned* gcnt = F.ctl + CW_MOECNT;
    for (int blk = F.bid; blk < T / 128; blk += F.G) {
        if (F.tid < 16) lcnt[F.tid] = 0;
        __syncthreads();
        for (int rr = 0; rr < 16; ++rr) {
            const int rl = F.wave * 16 + rr, m = blk * 128 + rl;
            f32x4 v[4]; norm_row(x + (size_t)m * D, g, H + (size_t)m * D, v, F.lane);
            float lg[8];
#pragma unroll
            for (int e = 0; e < 8; ++e) lg[e] = 0.f;
#pragma unroll
            for (int q = 0; q < 4; ++q)
#pragma unroll
                for (int c = 0; c < 4; ++c) { const int k = 4 * (F.lane + 64 * q) + c; const f32x4 w0 = *(const LAS f32x4*)(WR + k * 8), w1 = *(const LAS f32x4*)(WR + k * 8 + 4); const float hv = v[q][c];
                    lg[0] += hv * w0.x; lg[1] += hv * w0.y; lg[2] += hv * w0.z; lg[3] += hv * w0.w; lg[4] += hv * w1.x; lg[5] += hv * w1.y; lg[6] += hv * w1.z; lg[7] += hv * w1.w; }
#pragma unroll
            for (int e = 0; e < 8; ++e) lg[e] = wave_sum(lg[e]);
            if (F.lane == 0) {
                int e1 = 0; float l1 = lg[0];
#pragma unroll
                for (int e = 1; e < 8; ++e) if (lg[e] > l1) { l1 = lg[e]; e1 = e; }
                int e2 = -1; float l2 = -3.0e38f;
#pragma unroll
                for (int e = 0; e < 8; ++e) if (e != e1 && lg[e] > l2) { l2 = lg[e]; e2 = e; }
                const float w1 = 1.0f / (1.0f + __expf(l2 - l1));
                rE[rl] = e1 | (e2 << 8); rW[rl] = w1;
                rP1[rl] = __hip_atomic_fetch_add(lcnt + e1, 1, __ATOMIC_RELAXED, __HIP_MEMORY_SCOPE_WORKGROUP);
                rP2[rl] = __hip_atomic_fetch_add(lcnt + 8 + e2, 1, __ATOMIC_RELAXED, __HIP_MEMORY_SCOPE_WORKGROUP);
            }
        }
        __syncthreads();
        if (F.tid < 16) lbase[F.tid] = (int)__hip_atomic_fetch_add(gcnt + F.tid, (unsigned)lcnt[F.tid], __ATOMIC_RELAXED, __HIP_MEMORY_SCOPE_AGENT);
        __syncthreads();
        if (F.tid < 128) { const int m = blk * 128 + F.tid, e1 = rE[F.tid] & 255, e2 = rE[F.tid] >> 8; const float w1 = rW[F.tid];
            const int s1 = e1 * T + lbase[e1] + rP1[F.tid], s2 = (8 + e2) * T + lbase[8 + e2] + rP2[F.tid];
            stok[s1] = m; sw[s1] = w1; stok[s2] = m; sw[s2] = 1.0f - w1; }
        __syncthreads();
    }
}
__device__ __forceinline__ void final_norm_phase(const Frame& F0, float* x, const float* gain) { Frame F = opq(F0);
    const int gw = F.bid * NWAVES + F.wave, NGW = F.G * NWAVES;
    f32x4 g[4];
#pragma unroll
    for (int q = 0; q < 4; ++q) g[q] = ((const f32x4*)gain)[F.lane + 64 * q];
    for (int m = gw; m < T; m += NGW) {
        f32x4* xr = (f32x4*)(x + (size_t)m * D) + F.lane; f32x4 v[4]; float s = 0.f;
#pragma unroll
        for (int j = 0; j < 4; ++j) { v[j] = xr[64 * j]; s += (v[j].x * v[j].x + v[j].y * v[j].y) + (v[j].z * v[j].z + v[j].w * v[j].w); }
        const float r = 1.0f / sqrtf(wave_sum(s) * (1.f / D) + EPS);
#pragma unroll
        for (int j = 0; j < 4; ++j) xr[64 * j] = v[j] * r * g[j];
    }
}

constexpr int LD = 68;
constexpr int MATF = 64 * LD;

__device__ __forceinline__ void ld8(const bf16* p, float (&o)[8]) { const u32x4 w = *(const u32x4*)p; o[0] = bflo(w.x); o[1] = bfhi(w.x); o[2] = bflo(w.y); o[3] = bfhi(w.y); o[4] = bflo(w.z); o[5] = bfhi(w.z); o[6] = bflo(w.w); o[7] = bfhi(w.w); }

__device__ __forceinline__ void conv8(const bf16* PROJ, int b, int tpos  , int col, const float* cw, int cwld, int c0, float (&y)[8]) {
#pragma unroll
    for (int e = 0; e < 8; ++e) y[e] = 0.f;
#pragma unroll
    for (int j = 0; j < 4; ++j) { const int tp = tpos - 3 + j;
        if (tp >= 0) { float xv[8]; ld8(PROJ + (size_t)(b * SEQ + tp) * PP + col, xv);
            const f32x4 w0 = *(const f32x4*)(cw + j * cwld + c0), w1 = *(const f32x4*)(cw + j * cwld + c0 + 4);
            y[0] += xv[0] * w0.x; y[1] += xv[1] * w0.y; y[2] += xv[2] * w0.z; y[3] += xv[3] * w0.w; y[4] += xv[4] * w1.x; y[5] += xv[5] * w1.y; y[6] += xv[6] * w1.z; y[7] += xv[7] * w1.w; } }
}

__device__ __forceinline__ void conv8r(const u32x4 (&r)[4], const float* cw, int cwld, int c0, float (&y)[8]) {
#pragma unroll
    for (int e = 0; e < 8; ++e) y[e] = 0.f;
#pragma unroll
    for (int j = 0; j < 4; ++j) { const u32x4 w = r[j]; const float xv[8] = {bflo(w.x), bfhi(w.x), bflo(w.y), bfhi(w.y), bflo(w.z), bfhi(w.z), bflo(w.w), bfhi(w.w)};
        const f32x4 w0 = *(const f32x4*)(cw + j * cwld + c0), w1 = *(const f32x4*)(cw + j * cwld + c0 + 4);
        y[0] += xv[0] * w0.x; y[1] += xv[1] * w0.y; y[2] += xv[2] * w0.z; y[3] += xv[3] * w0.w; y[4] += xv[4] * w1.x; y[5] += xv[5] * w1.y; y[6] += xv[6] * w1.z; y[7] += xv[7] * w1.w; }
}
__device__ __forceinline__ void fetch_rows(const bf16* PROJ, int b, int tpos, int col, u32x4 (&r)[4]) {
#pragma unroll
    for (int j = 0; j < 4; ++j) { const int tp = tpos - 3 + j; r[j] = tp >= 0 ? *(const u32x4*)(PROJ + (size_t)(b * SEQ + tp) * PP + col) : (u32x4){0u, 0u, 0u, 0u}; }
}
__device__ __forceinline__ void gdn_fetch(const Frame& F, int b, int n, int h, u32x4 (&rows)[3][4]) {
    const bf16* PROJ = (const bf16*)(F.ws + WS_PROJ);
#pragma unroll
    for (int i = 0; i < 3; ++i) { const int u = F.tid + NTHR * i, grp = u % 24, t = u / 24; fetch_rows(PROJ, b, n * CH + t, (grp >> 3) * 256 + h * 64 + (grp & 7) * 8, rows[i]); }
}
__device__ __forceinline__ void rg_fetch(const Frame& F, int b, int n, int nb, u32x4 (&rows)[4]) {
    fetch_rows((const bf16*)(F.ws + WS_PROJ), b, n * CH + (F.tid >> 3), XC + nb * 64 + 8 * (F.tid & 7), rows);
}
struct GlaIn { u32x4 v, qk; f32x4 lr; };
__device__ __forceinline__ void gla_fetch(const Frame& F, int b, int n, int h, GlaIn& g) {
    const bf16* PROJ = (const bf16*)(F.ws + WS_PROJ); const float* SM = (const float*)(F.ws + WS_SMALL);
    const int tok0 = b * SEQ + n * CH, t = F.tid >> 3, p = F.tid & 7;
    g.v = *(const u32x4*)(PROJ + (size_t)(tok0 + t) * PP + VD + h * 64 + 8 * p);
    g.qk = *(const u32x4*)(PROJ + (size_t)(tok0 + t) * PP + (p < 4 ? QD + h * 32 + 8 * p : KD + h * 32 + 8 * (p - 4)));
    g.lr = F.tid < 256 ? *(const f32x4*)(SM + (size_t)(tok0 + (F.tid >> 2)) * 32 + 8 + 4 * (F.tid & 3)) : (f32x4){0.f, 0.f, 0.f, 0.f};
}
__device__ __forceinline__ void unpack8(const u32x4 w, float (&o)[8]) { o[0] = bflo(w.x); o[1] = bfhi(w.x); o[2] = bflo(w.y); o[3] = bfhi(w.y); o[4] = bflo(w.z); o[5] = bfhi(w.z); o[6] = bflo(w.w); o[7] = bfhi(w.w); }

__device__ __forceinline__ void gdn_prep(const Frame& F0, int l, int b, int n, int h, const u32x4 (&rows)[3][4]) { Frame F = opq(F0);
    LAS float* Q = (LAS float*)F.lds; LAS float* Kk = Q + MATF; LAS float* U = Kk + MATF; LAS float* W = U + MATF; LAS float* A = W + MATF; LAS float* AQ = A + MATF;
    LAS float* sBeta = AQ + MATF; LAS float* sG = sBeta + 64;
    const bf16* PROJ = (const bf16*)(F.ws + WS_PROJ); const float* SM = (const float*)(F.ws + WS_SMALL);
    const float* cw = F.in[3] + (size_t)l * 4 * 768;
    const int tok0 = b * SEQ + n * CH, ch = ((b * NCH + n) * 4 + h);
#pragma unroll
    for (int i = 0; i < 3; ++i) { const int u = F.tid + NTHR * i, grp = u % 24, t = u / 24, which = grp >> 3, d0 = (grp & 7) * 8, c0 = which * 256 + h * 64 + d0;
        float y[8]; conv8r(rows[i], cw, 768, c0, y);
        LAS float* dst = (which == 0 ? Q : which == 1 ? Kk : U) + t * LD + d0;
        *(LAS f32x4*)dst = (f32x4){siluf_(y[0]), siluf_(y[1]), siluf_(y[2]), siluf_(y[3])}; *(LAS f32x4*)(dst + 4) = (f32x4){siluf_(y[4]), siluf_(y[5]), siluf_(y[6]), siluf_(y[7])}; }
    if (F.wave == 0) { const int t = F.lane; const float bl = SM[(size_t)(tok0 + t) * 32 + h], al = SM[(size_t)(tok0 + t) * 32 + 4 + h];
        float g = -__expf(F.in[4][l * 4 + h]) * softplusf_(al + F.in[5][l * 4 + h]);
#pragma unroll
        for (int o = 1; o < 64; o <<= 1) { const float up = __shfl_up(g, o); if (t >= o) g += up; }
        sBeta[t] = sigmoidf_(bl); sG[t] = g; }
    __syncthreads();
    { const int t = F.tid >> 3, p = F.tid & 7; LAS float* qp = Q + t * LD + 8 * p; LAS float* kp = Kk + t * LD + 8 * p; LAS float* up = U + t * LD + 8 * p; LAS float* wp = W + t * LD + 8 * p;
        f32x4 q0 = *(LAS f32x4*)qp, q1 = *(LAS f32x4*)(qp + 4), k0 = *(LAS f32x4*)kp, k1 = *(LAS f32x4*)(kp + 4);
        float sq = (q0.x * q0.x + q0.y * q0.y) + (q0.z * q0.z + q0.w * q0.w) + (q1.x * q1.x + q1.y * q1.y) + (q1.z * q1.z + q1.w * q1.w);
        float sk = (k0.x * k0.x + k0.y * k0.y) + (k0.z * k0.z + k0.w * k0.w) + (k1.x * k1.x + k1.y * k1.y) + (k1.z * k1.z + k1.w * k1.w);
#pragma unroll
        for (int o = 1; o < 8; o <<= 1) { sq += __shfl_xor(sq, o); sk += __shfl_xor(sk, o); }
        const float rq = 0.125f / sqrtf(sq + EPS), rk = 1.0f / sqrtf(sk + EPS), be = sBeta[t], eg = __expf(sG[t]);
        q0 = q0 * rq; q1 = q1 * rq; k0 = k0 * rk; k1 = k1 * rk;
        *(LAS f32x4*)qp = q0; *(LAS f32x4*)(qp + 4) = q1; *(LAS f32x4*)kp = k0; *(LAS f32x4*)(kp + 4) = k1;
        *(LAS f32x4*)wp = k0 * (be * eg); *(LAS f32x4*)(wp + 4) = k1 * (be * eg);
        *(LAS f32x4*)up = *(LAS f32x4*)up * be; *(LAS f32x4*)(up + 4) = *(LAS f32x4*)(up + 4) * be; }
    __syncthreads();
    if ((DUMPS & 1) && (ABL & 4096) && b == 0 && n == 0 && h == ((ABL >> 16) & 3) && l == ((ABL >> 15) & 1)) { float* dq = (float*)(F.ctl + 8192);
        for (int i = F.tid; i < 4096; i += NTHR) { dq[i] = Q[(i >> 6) * LD + (i & 63)]; dq[4096 + i] = Kk[(i >> 6) * LD + (i & 63)]; dq[8192 + i] = U[(i >> 6) * LD + (i & 63)]; } }
    { const int lr = F.lane & 15, lg = F.lane >> 4;
        for (int tl = F.wave; tl < 32; tl += NWAVES) { const int mat = tl >> 4, mi = (tl >> 2) & 3, ni = tl & 3; LAS float* dst = mat ? AQ : A;
            f32x4 acc = (f32x4){0.f, 0.f, 0.f, 0.f};
            if (mi >= ni) acc = mm16<false, true>(mat ? Q : Kk, LD, Kk, LD, 16 * mi, 16 * ni, 64, acc, F.lane);
#pragma unroll
            for (int r = 0; r < 4; ++r) { const int i = 16 * mi + 4 * lg + r, j = 16 * ni + lr; float v = 0.f;
                if (mat ? (i >= j) : (i > j)) v = acc[r] * __expf(sG[i] - sG[j]) * (mat ? 1.0f : sBeta[i]);
                dst[i * LD + j] = v; } } }
    __syncthreads();
    if ((DUMPS & 2) && (ABL & 4096) && b == 0 && n == 0 && h == ((ABL >> 16) & 3) && l == ((ABL >> 15) & 1)) { float* dq = (float*)(F.ctl + 8192 + 3 * 4096);
        for (int i = F.tid; i < 4096; i += NTHR) { dq[i] = A[(i >> 6) * LD + (i & 63)]; dq[4096 + i] = AQ[(i >> 6) * LD + (i & 63)]; } }
    { LAS float* TI = sG + 64; constexpr int TLD = 20;
        if (F.wave == 0) { const int blk = F.lane >> 4, c = F.lane & 15; float x[16];
#pragma unroll
            for (int r = 0; r < 16; ++r) { float v = (r == c) ? 1.0f : 0.0f;
#pragma unroll
                for (int c2 = 0; c2 < r; ++c2) v -= A[(16 * blk + r) * LD + 16 * blk + c2] * x[c2];
                x[r] = v; TI[(blk * 16 + r) * TLD + c] = v; } }
        __syncthreads();
        LAS float* X = F.wave < 4 ? U : W; const int j0 = 16 * (F.wave & 3), lr = F.lane & 15, lg = F.lane >> 4;
        for (int bi = 0; bi < 4; ++bi) {
            if (bi > 0) { const f32x4 acc = mm16<false, false>(A, LD, X, LD, 16 * bi, j0, 16 * bi, (f32x4){0.f, 0.f, 0.f, 0.f}, F.lane);
#pragma unroll
                for (int r = 0; r < 4; ++r) X[(16 * bi + 4 * lg + r) * LD + j0 + lr] -= acc[r]; }
            const f32x4 xs = mm16<false, false>(TI + bi * 16 * TLD, TLD, X + 16 * bi * LD, LD, 0, j0, 16, (f32x4){0.f, 0.f, 0.f, 0.f}, F.lane);
#pragma unroll
            for (int r = 0; r < 4; ++r) X[(16 * bi + 4 * lg + r) * LD + j0 + lr] = xs[r];
        }
        __syncthreads(); }
    { const int t = F.tid >> 3, p = F.tid & 7; const float gl = sG[63], gt = sG[t], e1 = __expf(gl - gt), e2 = __expf(gt);
        LAS float* qp = Q + t * LD + 8 * p; LAS float* kp = Kk + t * LD + 8 * p;
        *(LAS f32x4*)qp = *(LAS f32x4*)qp * e2; *(LAS f32x4*)(qp + 4) = *(LAS f32x4*)(qp + 4) * e2; *(LAS f32x4*)kp = *(LAS f32x4*)kp * e1; *(LAS f32x4*)(kp + 4) = *(LAS f32x4*)(kp + 4) * e1; }
    __syncthreads();
    { const int lr = F.lane & 15, lg = F.lane >> 4; const float dl = __expf(sG[63]);
        float* GM = (float*)(F.ws + WS_GM) + (size_t)ch * 4096; float* GN = (float*)(F.ws + WS_GN) + (size_t)ch * 4096;
        float* GQ = (float*)(F.ws + WS_GQ) + (size_t)ch * 4096; float* GO = (float*)(F.ws + WS_GO) + (size_t)ch * 4096;
        for (int tl = F.wave; tl < 16; tl += NWAVES) { const int mi = tl >> 2, ni = tl & 3;
            const f32x4 acc = mm16<true, false>(Kk, LD, W, LD, 16 * mi, 16 * ni, 64, (f32x4){0.f, 0.f, 0.f, 0.f}, F.lane);
#pragma unroll
            for (int r = 0; r < 4; ++r) { const int i = 16 * mi + 4 * lg + r, j = 16 * ni + lr, ks = j >> 2; const float v = (i == j ? dl : 0.f) - acc[r];
                GM[((mi * 4 + (ks >> 2)) * 64 + (i & 15) + 16 * (j & 3)) * 4 + (ks & 3)] = v; } }
        for (int tl = F.wave; tl < 16; tl += NWAVES) { const int mi = tl >> 2, ni = tl & 3;
            const f32x4 acc = mm16<true, false>(Kk, LD, U, LD, 16 * mi, 16 * ni, 64, (f32x4){0.f, 0.f, 0.f, 0.f}, F.lane);
#pragma unroll
            for (int r = 0; r < 4; ++r) GN[(16 * mi + 4 * lg + r) * 64 + 16 * ni + lr] = acc[r]; }
        for (int tl = F.wave; tl < 16; tl += NWAVES) { const int mi = tl >> 2, ni = tl & 3;
            const f32x4 acc = mm16<false, false>(AQ, LD, W, LD, 16 * mi, 16 * ni, 64, (f32x4){0.f, 0.f, 0.f, 0.f}, F.lane);
#pragma unroll
            for (int r = 0; r < 4; ++r) { const int i = 16 * mi + 4 * lg + r, j = 16 * ni + lr; GQ[i * 64 + j] = Q[i * LD + j] - acc[r]; } }
        for (int tl = F.wave; tl < 16; tl += NWAVES) { const int mi = tl >> 2, ni = tl & 3;
            const f32x4 acc = mm16<false, false>(AQ, LD, U, LD, 16 * mi, 16 * ni, 64, (f32x4){0.f, 0.f, 0.f, 0.f}, F.lane);
#pragma unroll
            for (int r = 0; r < 4; ++r) GO[(16 * mi + 4 * lg + r) * 64 + 16 * ni + lr] = acc[r]; } }
    __syncthreads();
}

__device__ __forceinline__ void gla_prep(const Frame& F0, int l, int b, int n, int h, const GlaIn& gin, bool load_w) { Frame F = opq(F0);
    constexpr int L3 = 36;
    LAS float* QE = (LAS float*)F.lds; LAS float* KE = QE + 64 * L3; LAS float* KDm = KE + 64 * L3; LAS float* Gm = KDm + 64 * L3; LAS float* V = Gm + 64 * L3; LAS float* AIN = V + MATF;
    LAS float* LR = AIN + MATF; LAS float* WL = LR + 64 * 16; LAS float* Qr = WL + 16 * 32; LAS float* Kr = Qr + 64 * L3;
    const bf16* PROJ = (const bf16*)(F.ws + WS_PROJ); const float* SM = (const float*)(F.ws + WS_SMALL);
    const int tok0 = b * SEQ + n * CH, ch = ((b * NCH + n) * 4 + h);
    { const int t = F.tid >> 3, p = F.tid & 7; float xv[8];
        unpack8(gin.v, xv);
        *(LAS f32x4*)(V + t * LD + 8 * p) = (f32x4){xv[0], xv[1], xv[2], xv[3]}; *(LAS f32x4*)(V + t * LD + 8 * p + 4) = (f32x4){xv[4], xv[5], xv[6], xv[7]};
        unpack8(gin.qk, xv);
        { LAS float* dst = (p < 4 ? Qr : Kr) + t * L3 + 8 * (p & 3); *(LAS f32x4*)dst = (f32x4){xv[0], xv[1], xv[2], xv[3]}; *(LAS f32x4*)(dst + 4) = (f32x4){xv[4], xv[5], xv[6], xv[7]}; }
        if (F.tid < 256) { const int t2 = F.tid >> 2, q4 = F.tid & 3; *(LAS f32x4*)(LR + t2 * 16 + 4 * q4) = gin.lr; }
        if (load_w) { const int r = F.tid >> 5, d = F.tid & 31; WL[r * 32 + d] = F.in[17][(size_t)l * 16 * 128 + r * 128 + h * 32 + d]; } }
    __syncthreads();
    { const int t = F.lane;
#pragma unroll
        for (int c = 0; c < 4; ++c) { const int d = F.wave * 4 + c; float s = F.in[18][l * 128 + h * 32 + d];
#pragma unroll
            for (int r = 0; r < 16; ++r) s += LR[t * 16 + r] * WL[r * 32 + d];
            float la = -softplusf_(-s) * (1.0f / 16.0f);
#pragma unroll
            for (int o = 1; o < 64; o <<= 1) { const float up = __shfl_up(la, o); if (t >= o) la += up; }
            Gm[t * L3 + d] = la; } }
    __syncthreads();
    { float* LQG = (float*)(F.ws + WS_LQG) + (size_t)ch * 2048; float* LDL = (float*)(F.ws + WS_LDL) + (size_t)ch * 32;
        const float sc = 0.17677669529663687f;
        for (int u = F.tid; u < 2048; u += NTHR) { const int t = u >> 5, d = u & 31; const float G = Gm[t * L3 + d], Gr = Gm[32 * L3 + d], Gl = Gm[63 * L3 + d];
            const float q = Qr[t * L3 + d] * sc, k = Kr[t * L3 + d];
            QE[t * L3 + d] = q * __expf(G - Gr); KE[t * L3 + d] = k * __expf(Gr - G); KDm[t * L3 + d] = k * __expf(Gl - G);
            LQG[t * 32 + d] = q * __expf(G); if (t == 63) LDL[d] = __expf(Gl); } }
    __syncthreads();
    { const int lr = F.lane & 15, lg = F.lane >> 4;
        for (int tl = F.wave; tl < 16; tl += NWAVES) { const int mi = tl >> 2, ni = tl & 3; f32x4 acc = (f32x4){0.f, 0.f, 0.f, 0.f};
            if (mi >= ni) acc = mm16<false, true>(QE, L3, KE, L3, 16 * mi, 16 * ni, 32, acc, F.lane);
#pragma unroll
            for (int r = 0; r < 4; ++r) { const int i = 16 * mi + 4 * lg + r, j = 16 * ni + lr; AIN[i * LD + j] = (i >= j) ? acc[r] : 0.f; } } }
    __syncthreads();
    { const int lr = F.lane & 15, lg = F.lane >> 4; float* LOI = (float*)(F.ws + WS_LOI) + (size_t)ch * 4096; float* LKV = (float*)(F.ws + WS_LKV) + (size_t)ch * 2048;
        for (int tl = F.wave; tl < 16; tl += NWAVES) { const int mi = tl >> 2, ni = tl & 3;
            const f32x4 acc = mm16<false, false>(AIN, LD, V, LD, 16 * mi, 16 * ni, 64, (f32x4){0.f, 0.f, 0.f, 0.f}, F.lane);
#pragma unroll
            for (int r = 0; r < 4; ++r) LOI[(16 * mi + 4 * lg + r) * 64 + 16 * ni + lr] = acc[r]; }
        { const int mi = F.wave >> 2, ni = F.wave & 3;
            const f32x4 acc = mm16<true, false>(KDm, L3, V, LD, 16 * mi, 16 * ni, 64, (f32x4){0.f, 0.f, 0.f, 0.f}, F.lane);
#pragma unroll
            for (int r = 0; r < 4; ++r) LKV[(16 * mi + 4 * lg + r) * 64 + 16 * ni + lr] = acc[r]; } }
    __syncthreads();
}

__device__ __forceinline__ void rg_prep(const Frame& F0, int l, int b, int n, int nb, const u32x4 (&rows)[4], bool load_w) { Frame F = opq(F0);
    LAS float* XCm = (LAS float*)F.lds; LAS float* WA = XCm + MATF; LAS float* WX = WA + MATF; LAS float* AA = WX + MATF; LAS float* segA = AA + MATF; LAS float* segH = segA + 512;
    const bf16* PROJ = (const bf16*)(F.ws + WS_PROJ);
    const int tok0 = b * SEQ + n * CH;
    { const int t = F.tid >> 3, p = F.tid & 7, c0 = nb * 64 + 8 * p; float y[8];
        conv8r(rows, F.in[10] + (size_t)l * 4 * 256, 256, c0, y);
        const float* cb = F.in[11] + l * 256 + c0;
        *(LAS f32x4*)(XCm + t * LD + 8 * p) = (f32x4){y[0] + cb[0], y[1] + cb[1], y[2] + cb[2], y[3] + cb[3]}; *(LAS f32x4*)(XCm + t * LD + 8 * p + 4) = (f32x4){y[4] + cb[4], y[5] + cb[5], y[6] + cb[6], y[7] + cb[7]};
        const float* wa = F.in[12] + ((size_t)l * 4 + nb) * 4096; const float* wx = F.in[14] + ((size_t)l * 4 + nb) * 4096;
        if (load_w)
#pragma unroll
        for (int i = 0; i < 2; ++i) { const int e = F.tid + NTHR * i, r = e >> 4, c4 = (e & 15) * 4;
            *(LAS f32x4*)(WA + r * LD + c4) = *(const f32x4*)(wa + r * 64 + c4); *(LAS f32x4*)(WX + r * LD + c4) = *(const f32x4*)(wx + r * 64 + c4); } }
    __syncthreads();
    { const int lr = F.lane & 15, lg = F.lane >> 4; f32x4 ga[2], gx[2];
#pragma unroll
        for (int q = 0; q < 2; ++q) { const int tl = F.wave + 8 * q, mi = tl >> 2, ni = tl & 3;
            ga[q] = mm16<false, false>(XCm, LD, WA, LD, 16 * mi, 16 * ni, 64, (f32x4){0.f, 0.f, 0.f, 0.f}, F.lane);
            gx[q] = mm16<false, false>(XCm, LD, WX, LD, 16 * mi, 16 * ni, 64, (f32x4){0.f, 0.f, 0.f, 0.f}, F.lane); }
        __syncthreads();
#pragma unroll
        for (int q = 0; q < 2; ++q) { const int tl = F.wave + 8 * q, mi = tl >> 2, ni = tl & 3, j = 16 * ni + lr, cg = nb * 64 + j;
            const float ba = F.in[13][l * 256 + cg], bx = F.in[15][l * 256 + cg], sp = softplusf_(F.in[16][l * 256 + cg]);
#pragma unroll
            for (int r = 0; r < 4; ++r) { const int i = 16 * mi + 4 * lg + r; const float la = -8.0f * sigmoidf_(ga[q][r] + ba) * sp, a = __expf(la);
                const float mult = sqrtf(fmaxf(-expm1f(2.0f * la), 0.f)); const float xc = XCm[i * LD + j];
                AA[i * LD + j] = a; XCm[i * LD + j] = xc * sigmoidf_(gx[q][r] + bx) * mult; } } }
    __syncthreads();
    { const int c = F.tid & 63, sg = F.tid >> 6; float hh = 0.f, pp = 1.f; float hl[8], pl[8];
#pragma unroll
        for (int tt = 0; tt < 8; ++tt) { const int t = 8 * sg + tt; const float a = AA[t * LD + c], u = XCm[t * LD + c]; hh = a * hh + u; pp = pp * a; hl[tt] = hh; pl[tt] = pp; }
        segA[sg * 64 + c] = pp; segH[sg * 64 + c] = hh;
        __syncthreads();
        float hin = 0.f, pin = 1.f;
        for (int s2 = 0; s2 < sg; ++s2) { const float a = segA[s2 * 64 + c]; hin = a * hin + segH[s2 * 64 + c]; pin *= a; }
        bf16* RHL = (bf16*)(F.ws + WS_RHL); bf16* RP = (bf16*)(F.ws + WS_RP);
#pragma unroll
        for (int tt = 0; tt < 8; ++tt) { const int t = 8 * sg + tt; const float hv = hl[tt] + pl[tt] * hin, pv = pl[tt] * pin;
            RHL[(size_t)(tok0 + t) * 256 + nb * 64 + c] = (bf16)f2bf(hv); RP[(size_t)(tok0 + t) * 256 + nb * 64 + c] = (bf16)f2bf(pv);
            if (t == 63) { ((float*)(F.ws + WS_RAT))[(b * NCH + n) * 256 + nb * 64 + c] = pv; ((float*)(F.ws + WS_RHE))[(b * NCH + n) * 256 + nb * 64 + c] = hv; } } }
    __syncthreads();
}
__device__ __forceinline__ void prep_phase(Frame& F, int l) {
    { u32x4 nx[3][4]; int idx = F.bid;
        if (idx < 2048) gdn_fetch(F, (idx >> 2) >> 6, (idx >> 2) & 63, idx & 3, nx);
        for (; idx < 2048; idx += F.G) { u32x4 cur[3][4];
#pragma unroll
            for (int i = 0; i < 3; ++i)
#pragma unroll
                for (int j = 0; j < 4; ++j) cur[i][j] = nx[i][j];
            const int ni = idx + F.G; if (ni < 2048) gdn_fetch(F, (ni >> 2) >> 6, (ni >> 2) & 63, ni & 3, nx);
            gdn_prep(F, l, (idx >> 2) >> 6, (idx >> 2) & 63, idx & 3, cur); } }
    { GlaIn nx; int idx = F.bid, hw = -1;
        if (idx < 2048) gla_fetch(F, (idx >> 2) >> 6, (idx >> 2) & 63, idx & 3, nx);
        for (; idx < 2048; idx += F.G) { const GlaIn cur = nx;
            const int ni = idx + F.G; if (ni < 2048) gla_fetch(F, (ni >> 2) >> 6, (ni >> 2) & 63, ni & 3, nx);
            gla_prep(F, l, (idx >> 2) >> 6, (idx >> 2) & 63, idx & 3, cur, (idx & 3) != hw); hw = idx & 3; } }
    { u32x4 nx[4]; int idx = F.bid, bw = -1;
        if (idx < 2048) rg_fetch(F, (idx >> 2) >> 6, (idx >> 2) & 63, idx & 3, nx);
        for (; idx < 2048; idx += F.G) { u32x4 cur[4];
#pragma unroll
            for (int j = 0; j < 4; ++j) cur[j] = nx[j];
            const int ni = idx + F.G; if (ni < 2048) rg_fetch(F, (ni >> 2) >> 6, (ni >> 2) & 63, ni & 3, nx);
            rg_prep(F, l, (idx >> 2) >> 6, (idx >> 2) & 63, idx & 3, cur, (idx & 3) != bw); bw = idx & 3; } }
}

__device__ __forceinline__ f32x16 mfma32(bf16x8 a, bf16x8 b, f32x16 c) { return __builtin_amdgcn_mfma_f32_32x32x16_bf16(a, b, c, 0, 0, 0); }
typedef short v4i16_t __attribute__((ext_vector_type(4)));
__device__ __forceinline__ s16x4 vtr(const LAS unsigned char* p) { return __builtin_bit_cast(s16x4, __builtin_amdgcn_ds_read_tr16_b64_v4i16((LAS v4i16_t*)p)); }

__device__ __forceinline__ void attn_item(const Frame& F0, int l, int b, int h, int qb) { Frame F = opq(F0);
    constexpr int KP = 144, KT_BYTES = 64 * KP;
    LAS unsigned char* Kt = F.lds; LAS unsigned char* Vt = F.lds + 2 * KT_BYTES;
    LAS float* LUT = (LAS float*)(F.lds + 4 * KT_BYTES); LAS float* sLam = LUT + 256;
    const bf16* PROJ = (const bf16*)(F.ws + WS_PROJ); bf16* MIX = (bf16*)(F.ws + WS_HM);
    const float lam_init = l == 0 ? 0.2f : 0.35550906759096926f;
    if (F.tid < 256) { const int delta = F.tid - 191, na = delta < 0 ? -delta : delta;
        int bk = na < 8 ? na : na < 12 ? 8 : na < 16 ? 9 : na < 23 ? 10 : na < 32 ? 11 : na < 46 ? 12 : na < 64 ? 13 : na < 91 ? 14 : 15;
        if (delta > 0) bk += 16;
        LUT[F.tid] = F.in[9][bk * 4 + h] * LOG2E; }
    if (F.wave == 4) { const float* lv = F.in[7] + l * 128; const int i = F.lane & 31;
        float p = F.lane < 32 ? lv[i] * lv[32 + i] : lv[64 + i] * lv[96 + i];
#pragma unroll
        for (int o = 1; o < 32; o <<= 1) p += __shfl_xor(p, o);
        const float e = __expf(p), e2 = __shfl_xor(e, 32);
        if (F.lane == 0) sLam[0] = e - e2 + lam_init; }
    __syncthreads();
    const float lam = sLam[0];
    const int w = F.wave, cq = qb * 4 + (w >> 1), r32 = F.lane & 31, hh = F.lane >> 5, qoff = 32 * (w & 1) + r32;
    const size_t t0 = (size_t)b * SEQ + qb * 256 + 32 * w + r32;
    bf16x8 qf[2][2];
#pragma unroll
    for (int c = 0; c < 2; ++c)
#pragma unroll
        for (int s = 0; s < 2; ++s) qf[c][s] = *(const bf16x8*)(PROJ + t0 * PP + QB + h * 64 + c * 32 + 16 * s + 8 * hh);
    f32x16 O[2][2]; float mrun[2], lrun[2];
#pragma unroll
    for (int c = 0; c < 2; ++c) { mrun[c] = -1.0e30f; lrun[c] = 0.f;
#pragma unroll
        for (int mt = 0; mt < 2; ++mt)
#pragma unroll
            for (int i = 0; i < 16; ++i) O[c][mt][i] = 0.f; }
    const int skey = F.tid >> 3, sseg = F.tid & 7, ntile = 4 * qb + 4;
    const bf16* kg = PROJ + ((size_t)b * SEQ + skey) * PP + KB + h * 64 + sseg * 8; const bf16* vg = PROJ + ((size_t)b * SEQ + skey) * PP + VB + h * 64 + sseg * 8;
    u32x4 kreg = *(const u32x4*)kg, vreg = *(const u32x4*)vg;
    const float SC = 0.17677669529663687f * LOG2E;
    for (int kt = 0; kt < ntile; ++kt) {
        const int buf = kt & 1;
        *(LAS u32x4*)(Kt + buf * KT_BYTES + skey * KP + sseg * 16) = kreg; *(LAS u32x4*)(Vt + buf * KT_BYTES + skey * KP + sseg * 16) = vreg;
        __syncthreads();
        if (kt + 1 < ntile) { kreg = *(const u32x4*)(kg + (size_t)(kt + 1) * 64 * PP); vreg = *(const u32x4*)(vg + (size_t)(kt + 1) * 64 * PP); }
        if (kt <= cq) {
            const bool far = kt + 3 <= cq; const float c15 = LUT[0];
            const LAS unsigned char* Kb = Kt + buf * KT_BYTES; const LAS unsigned char* Vb = Vt + buf * KT_BYTES;
#pragma unroll
            for (int kb = 0; kb < 2; ++kb) {
                f32x16 S[2];
#pragma unroll
                for (int c = 0; c < 2; ++c) { f32x16 z;
#pragma unroll
                    for (int i = 0; i < 16; ++i) z[i] = 0.f;
                    const bf16x8 k0 = *(const LAS bf16x8*)(Kb + (32 * kb + r32) * KP + (c * 32 + 8 * hh) * 2), k1 = *(const LAS bf16x8*)(Kb + (32 * kb + r32) * KP + (c * 32 + 16 + 8 * hh) * 2);
                    z = mfma32(k0, qf[c][0], z); S[c] = mfma32(k1, qf[c][1], z); }
                float bias[16];
#pragma unroll
                for (int i = 0; i < 16; ++i) { if (far) bias[i] = c15; else { const int krow = 32 * kb + (i & 3) + 8 * (i >> 2) + 4 * hh; bias[i] = LUT[(kt - cq) * 64 + krow - qoff + 191]; } }
                bf16x8 pb[2][2];
#pragma unroll
                for (int c = 0; c < 2; ++c) {
                    float mx = -1.0e30f;
#pragma unroll
                    for (int i = 0; i < 16; ++i) { S[c][i] = S[c][i] * SC + bias[i]; mx = fmaxf(mx, S[c][i]); }
                    mx = fmaxf(mx, __shfl_xor(mx, 32));
                    if (__any(mx > mrun[c] + 8.0f)) {
                        const float mn = fmaxf(mrun[c], mx), alpha = __builtin_amdgcn_exp2f(mrun[c] - mn); mrun[c] = mn; lrun[c] *= alpha;
#pragma unroll
                        for (int mt = 0; mt < 2; ++mt)
#pragma unroll
                            for (int i = 0; i < 16; ++i) O[c][mt][i] *= alpha; }
                    const float mr = mrun[c]; float ps = 0.f;
#pragma unroll
                    for (int i = 0; i < 16; ++i) { S[c][i] = __builtin_amdgcn_exp2f(S[c][i] - mr); ps += S[c][i]; }
                    lrun[c] += ps;
#pragma unroll
                    for (int s = 0; s < 2; ++s) { u32x4 pw; pw.x = pg8::cvt_pk_bf16(S[c][8 * s + 0], S[c][8 * s + 1]); pw.y = pg8::cvt_pk_bf16(S[c][8 * s + 2], S[c][8 * s + 3]); pw.z = pg8::cvt_pk_bf16(S[c][8 * s + 4], S[c][8 * s + 5]); pw.w = pg8::cvt_pk_bf16(S[c][8 * s + 6], S[c][8 * s + 7]);
                        pb[c][s] = __builtin_bit_cast(bf16x8, pw); }
                }
#pragma unroll
                for (int mt = 0; mt < 2; ++mt)
#pragma unroll
                    for (int s = 0; s < 2; ++s) {
                        const LAS unsigned char* vp = Vb + (32 * kb + 16 * s + 4 * hh + ((F.lane & 15) >> 2)) * KP + (32 * mt + 16 * ((F.lane >> 4) & 1) + 4 * (F.lane & 3)) * 2;
                        const s16x4 v0 = vtr(vp), v1 = vtr(vp + 8 * KP);
                        bf16x8 vf; vf[0] = v0[0]; vf[1] = v0[1]; vf[2] = v0[2]; vf[3] = v0[3]; vf[4] = v1[0]; vf[5] = v1[1]; vf[6] = v1[2]; vf[7] = v1[3];
                        O[0][mt] = mfma32(vf, pb[0][s], O[0][mt]); O[1][mt] = mfma32(vf, pb[1][s], O[1][mt]); }
            }
        }
    }
    { const float i0 = 1.0f / (lrun[0] + __shfl_xor(lrun[0], 32)), i1 = lam / (lrun[1] + __shfl_xor(lrun[1], 32));
        float ss = 0.f;
#pragma unroll
        for (int mt = 0; mt < 2; ++mt)
#pragma unroll
            for (int i = 0; i < 16; ++i) { const float a = O[0][mt][i] * i0 - O[1][mt][i] * i1; O[0][mt][i] = a; ss += a * a; }
        ss += __shfl_xor(ss, 32);
        const float rs = (1.0f - lam_init) / sqrtf(ss * (1.0f / 64.0f) + EPS);
        const float* bn = F.in[8] + l * 64;
#pragma unroll
        for (int mt = 0; mt < 2; ++mt)
#pragma unroll
            for (int g4 = 0; g4 < 4; ++g4) { const int dv0 = 32 * mt + 8 * g4 + 4 * hh; const f32x4 gn = *(const f32x4*)(bn + dv0);
                u32x2 o; o.x = pk2(O[0][mt][4 * g4 + 0] * rs * gn.x, O[0][mt][4 * g4 + 1] * rs * gn.y); o.y = pk2(O[0][mt][4 * g4 + 2] * rs * gn.z, O[0][mt][4 * g4 + 3] * rs * gn.w);
                if (ABL & 8) { o.x = 0u; o.y = 0u; }
                *(u32x2*)(MIX + t0 * D + 256 + h * 64 + dv0) = o; } }
    __syncthreads();
}

__device__ __forceinline__ void gdn_chain_item(const Frame& F0, int b, int h, int pair) { Frame F = opq(F0);
    const int w = F.wave, chain = w >> 2, cg = 2 * pair + chain, mi = w & 3, lr = F.lane & 15, lg = F.lane >> 4;
    LAS float* Sb = (LAS float*)F.lds + chain * 2048;
    const f32x4* GMv = (const f32x4*)(F.ws + WS_GM); float* GN = (float*)(F.ws + WS_GN);
    f32x4 s_cur = (f32x4){0.f, 0.f, 0.f, 0.f};
#pragma unroll
    for (int r = 0; r < 4; ++r) Sb[(16 * mi + 4 * lg + r) * 16 + lr] = 0.f;
    __syncthreads();
    f32x4 mq[4][4], nq[4];
#define GDN_LOAD(slot, n_) do { const size_t _ch = (size_t)((b * NCH + (n_)) * 4 + h); \
        _Pragma("unroll") for (int _q = 0; _q < 4; ++_q) mq[slot][_q] = GMv[_ch * 1024 + (mi * 4 + _q) * 64 + F.lane]; \
        _Pragma("unroll") for (int _r = 0; _r < 4; ++_r) nq[slot][_r] = GN[_ch * 4096 + (16 * mi + 4 * lg + _r) * 64 + 16 * cg + lr]; } while (0)
    GDN_LOAD(0, 0); GDN_LOAD(1, 1); GDN_LOAD(2, 2); GDN_LOAD(3, 3);
    for (int n0 = 0; n0 < NCH; n0 += 4) {
#pragma unroll
        for (int u = 0; u < 4; ++u) { const int n = n0 + u, buf = u & 1; const size_t ch = (size_t)((b * NCH + n) * 4 + h);
            f32x4 acc = nq[u];
#pragma unroll
            for (int r = 0; r < 4; ++r) GN[ch * 4096 + (16 * mi + 4 * lg + r) * 64 + 16 * cg + lr] = s_cur[r];
#pragma unroll
            for (int ks = 0; ks < 16; ++ks) { const float a = mq[u][ks >> 2][ks & 3], bv = Sb[buf * 1024 + (4 * ks + lg) * 16 + lr]; acc = __builtin_amdgcn_mfma_f32_16x16x4f32(a, bv, acc, 0, 0, 0); }
            asm volatile("s_nop 15\n\ts_nop 7" : "+v"(acc));
            s_cur = acc;
#pragma unroll
            for (int r = 0; r < 4; ++r) Sb[(buf ^ 1) * 1024 + (16 * mi + 4 * lg + r) * 16 + lr] = acc[r];
            if (n + 4 < NCH) GDN_LOAD(u, n + 4);
            __syncthreads(); }
    }
#undef GDN_LOAD
}
__device__ __forceinline__ void gla_prefix_item(const Frame& F0, int b, int h) { Frame F = opq(F0);
    f32x4* LKV = (f32x4*)(F.ws + WS_LKV); const float* LDL = (const float*)(F.ws + WS_LDL); const int dk = F.tid >> 4;
    f32x4 s = (f32x4){0.f, 0.f, 0.f, 0.f}, kvq[8]; float dq[8];
#pragma unroll
    for (int u = 0; u < 8; ++u) { const size_t ch = (size_t)((b * NCH + u) * 4 + h); kvq[u] = LKV[ch * 512 + F.tid]; dq[u] = LDL[ch * 32 + dk]; }
    for (int n0 = 0; n0 < NCH; n0 += 8) {
#pragma unroll
        for (int u = 0; u < 8; ++u) { const int n = n0 + u; const size_t ch = (size_t)((b * NCH + n) * 4 + h);
            const f32x4 kv = kvq[u]; const float d = dq[u];
            LKV[ch * 512 + F.tid] = s; s = s * d + kv;
            if (n + 8 < NCH) { const size_t c2 = (size_t)((b * NCH + n + 8) * 4 + h); kvq[u] = LKV[c2 * 512 + F.tid]; dq[u] = LDL[c2 * 32 + dk]; } }
    }
}
__device__ __forceinline__ void rg_carry_item(const Frame& F0, int j) { Frame F = opq(F0);
    const int gid = j * NTHR + F.tid, b = gid >> 8, c = gid & 255;
    const float* RAT = (const float*)(F.ws + WS_RAT); const float* RHE = (const float*)(F.ws + WS_RHE); float* RCA = (float*)(F.ws + WS_RCA);
    float carry = 0.f;
#pragma unroll 8
    for (int n = 0; n < NCH; ++n) { const int ci = (b * NCH + n) * 256 + c; const float a = RAT[ci], hn = RHE[ci]; RCA[ci] = carry; carry = a * carry + hn; }
}
constexpr int Q_GDN = 64, Q_GLA = 32, Q_RG = 4, Q_ATT = 512, Q_ITEMS = Q_GDN + Q_GLA + Q_RG + Q_ATT;
__device__ __forceinline__ void scan_attn_phase(Frame& F, int l) {
    for (;;) {
        __syncthreads();
        if (F.tid == 0) F.MISC[16] = __hip_atomic_fetch_add(F.ctl + CW_QUEUE + 64 * l, 1u, __ATOMIC_RELAXED, __HIP_MEMORY_SCOPE_AGENT);
        __syncthreads();
        const int it = (int)F.MISC[16];
        if (it >= Q_ITEMS) break;
        if (it < Q_GDN) gdn_chain_item(F, it >> 3, (it >> 1) & 3, it & 1);
        else if (it < Q_GDN + Q_GLA) { const int q = it - Q_GDN; gla_prefix_item(F, q >> 2, q & 3); }
        else if (it < Q_GDN + Q_GLA + Q_RG) rg_carry_item(F, it - Q_GDN - Q_GLA);
        else { const int a = it - (Q_GDN + Q_GLA + Q_RG), qb = 15 - (a >> 5), bh = a & 31; attn_item(F, l, bh >> 2, bh & 3, qb); }
    }
    if (REPEAT & 4) for (;;) {
        __syncthreads();
        if (F.tid == 0) F.MISC[16] = __hip_atomic_fetch_add(F.ctl + CW_QUEUE + 64 * (2 + l), 1u, __ATOMIC_RELAXED, __HIP_MEMORY_SCOPE_AGENT);
        __syncthreads();
        const int a = (int)F.MISC[16];
        if (a >= Q_ATT) break;
        const int qb = 15 - (a >> 5), bh = a & 31; attn_item(F, l, bh >> 2, bh & 3, qb);
    }
}

__device__ __forceinline__ void norm_gate_store(Frame& F, const LAS float* OUT, const float* gain, const bf16* gate  , bf16* dst, bool silu_gate) {
    const int t = F.tid >> 3, p = F.tid & 7; const f32x4 a = *(const LAS f32x4*)(OUT + t * LD + 8 * p), c = *(const LAS f32x4*)(OUT + t * LD + 8 * p + 4);
    float ss = (a.x * a.x + a.y * a.y) + (a.z * a.z + a.w * a.w) + (c.x * c.x + c.y * c.y) + (c.z * c.z + c.w * c.w);
#pragma unroll
    for (int o = 1; o < 8; o <<= 1) ss += __shfl_xor(ss, o);
    const float rs = 1.0f / sqrtf(ss * (1.0f / 64.0f) + EPS);
    float gv[8]; ld8(gate + (size_t)t * PP + 8 * p, gv);
    const f32x4 g0 = *(const f32x4*)(gain + 8 * p), g1 = *(const f32x4*)(gain + 8 * p + 4);
    float o[8] = {a.x * rs * g0.x, a.y * rs * g0.y, a.z * rs * g0.z, a.w * rs * g0.w, c.x * rs * g1.x, c.y * rs * g1.y, c.z * rs * g1.z, c.w * rs * g1.w};
#pragma unroll
    for (int e = 0; e < 8; ++e) o[e] *= siluf_(gv[e]) * (((ABL & 512) && gain == F.in[6] + 0) ? 2.0f : 1.0f);
    u32x4 w; w.x = pk2(o[0], o[1]); w.y = pk2(o[2], o[3]); w.z = pk2(o[4], o[5]); w.w = pk2(o[6], o[7]);
    if (!silu_gate) w = (u32x4){0u, 0u, 0u, 0u};
    *(u32x4*)(dst + (size_t)t * D + 8 * p) = w;
}
__device__ __forceinline__ void finalize_phase(const Frame& F0, int l) { Frame F = opq(F0);
    LAS float* QP = (LAS float*)F.lds; LAS float* SPm = QP + MATF; LAS float* OUT = SPm + MATF;
    const bf16* PROJ = (const bf16*)(F.ws + WS_PROJ); bf16* MIX = (bf16*)(F.ws + WS_HM);
    const int lr = F.lane & 15, lg = F.lane >> 4;
    for (int it = F.bid; it < NB * NCH; it += F.G) { const int b = it >> 6, n = it & 63; const size_t tok0 = (size_t)b * SEQ + n * CH;
        for (int h = 0; h < ((FINPARTS & 1) ? 4 : 0); ++h) {
            const size_t ch = (size_t)((b * NCH + n) * 4 + h);
            const f32x4* GQ = (const f32x4*)(F.ws + WS_GQ) + ch * 1024; const f32x4* GS = (const f32x4*)(F.ws + WS_GN) + ch * 1024; const float* GO = (const float*)(F.ws + WS_GO) + ch * 4096;
#pragma unroll
            for (int i = 0; i < 2; ++i) { const int e = F.tid + NTHR * i, r = e >> 4, c4 = (e & 15) * 4; *(LAS f32x4*)(QP + r * LD + c4) = GQ[e]; *(LAS f32x4*)(SPm + r * LD + c4) = GS[e]; }
            __syncthreads();
#pragma unroll
            for (int q = 0; q < 2; ++q) { const int tl = F.wave + 8 * q, mi = tl >> 2, ni = tl & 3; f32x4 acc;
#pragma unroll
                for (int r = 0; r < 4; ++r) acc[r] = GO[(16 * mi + 4 * lg + r) * 64 + 16 * ni + lr];
                if (!(ABL & 128)) acc = mm16<false, false>(QP, LD, SPm, LD, 16 * mi, 16 * ni, 64, acc, F.lane);
#pragma unroll
                for (int r = 0; r < 4; ++r) OUT[(16 * mi + 4 * lg + r) * LD + 16 * ni + lr] = acc[r]; }
            __syncthreads();
            norm_gate_store(F, OUT, F.in[6] + l * 64, PROJ + tok0 * PP + GA + h * 64, MIX + tok0 * D + h * 64, !((ABL & 16) || ((ABL & 1024) && l == 1) || ((ABL & 2048) && l == 0)));
        }
        for (int h = 0; h < ((FINPARTS & 2) ? 4 : 0); ++h) {
            const size_t ch = (size_t)((b * NCH + n) * 4 + h);
            const f32x4* LQG = (const f32x4*)(F.ws + WS_LQG) + ch * 512; const f32x4* LS = (const f32x4*)(F.ws + WS_LKV) + ch * 512; const float* LOI = (const float*)(F.ws + WS_LOI) + ch * 4096;
            { const int r = F.tid >> 3, c4 = (F.tid & 7) * 4; *(LAS f32x4*)(QP + r * 36 + c4) = LQG[F.tid]; const int r2 = F.tid >> 4, c42 = (F.tid & 15) * 4; *(LAS f32x4*)(SPm + r2 * LD + c42) = LS[F.tid]; }
            __syncthreads();
#pragma unroll
            for (int q = 0; q < 2; ++q) { const int tl = F.wave + 8 * q, mi = tl >> 2, ni = tl & 3; f32x4 acc;
#pragma unroll
                for (int r = 0; r < 4; ++r) acc[r] = LOI[(16 * mi + 4 * lg + r) * 64 + 16 * ni + lr];
                acc = mm16<false, false>(QP, 36, SPm, LD, 16 * mi, 16 * ni, 32, acc, F.lane);
#pragma unroll
                for (int r = 0; r < 4; ++r) OUT[(16 * mi + 4 * lg + r) * LD + 16 * ni + lr] = acc[r]; }
            __syncthreads();
            norm_gate_store(F, OUT, F.in[19] + l * 64, PROJ + tok0 * PP + RD + h * 64, MIX + tok0 * D + 768 + h * 64, !(ABL & 32));
        }
        if (FINPARTS & 4) { const int t = F.tid >> 3, c0 = (F.tid & 7) * 32; const size_t tok = tok0 + t;
            const bf16* RHL = (const bf16*)(F.ws + WS_RHL) + tok * 256; const bf16* RP = (const bf16*)(F.ws + WS_RP) + tok * 256; const float* RCA = (const float*)(F.ws + WS_RCA) + (b * NCH + n) * 256;
#pragma unroll
            for (int q = 0; q < 4; ++q) { const int c = c0 + 8 * q; float hl[8], pv[8], gc[8]; ld8(RHL + c, hl); ld8(RP + c, pv); ld8(PROJ + tok * PP + GC + c, gc);
                const f32x4 ca0 = *(const f32x4*)(RCA + c), ca1 = *(const f32x4*)(RCA + c + 4); const float ca[8] = {ca0.x, ca0.y, ca0.z, ca0.w, ca1.x, ca1.y, ca1.z, ca1.w};
                float o[8];
#pragma unroll
                for (int e = 0; e < 8; ++e) o[e] = (hl[e] + pv[e] * ca[e]) * gelu_tanh(gc[e]);
                u32x4 w; w.x = pk2(o[0], o[1]); w.y = pk2(o[2], o[3]); w.z = pk2(o[4], o[5]); w.w = pk2(o[6], o[7]);
                if (ABL & 64) w = (u32x4){0u, 0u, 0u, 0u};
                *(u32x4*)(MIX + tok * D + 512 + c) = w; } }
        __syncthreads();
    }
}


__device__ __forceinline__ void dbg_gdn_check(const Frame& F0, int l, int bsel, int hsel, int msel, float* dbgout) { Frame F = opq(F0);
    if (F.bid != 0) return;
    constexpr int NT = 512;
    LAS float* S = (LAS float*)F.lds;
    LAS float* qv = S + 4096; LAS float* kv = qv + 64; LAS float* vv = kv + 64; LAS float* tmp = vv + 64; LAS float* ov = tmp + 64; LAS float* sc = ov + 64;
    const bf16* PROJ = (const bf16*)(F.ws + WS_PROJ); const float* SM = (const float*)(F.ws + WS_SMALL); const bf16* MIX = (const bf16*)(F.ws + WS_HM);
    const float* cw = F.in[3] + (size_t)l * 4 * 768;
    for (int i = F.tid; i < 4096; i += NTHR) S[i] = 0.f;
    float errsum = 0.f, refsum = 0.f;
    __syncthreads();
    for (int t = 0; t < NT; ++t) {
        const size_t tok = (size_t)bsel * SEQ + t;
        if (F.tid < 192) { const int which = F.tid >> 6, d = F.tid & 63, c = which * 256 + hsel * 64 + d; float y = 0.f;
            for (int j = 0; j < 4; ++j) { const int tp = t - 3 + j; if (tp >= 0) y += bf2f(PROJ[((size_t)bsel * SEQ + tp) * PP + c]) * cw[j * 768 + c]; }
            y = y / (1.0f + expf(-y)); (which == 0 ? qv : which == 1 ? kv : vv)[d] = y; }
        __syncthreads();
        if (F.tid == 0) { float sq = 0.f, sk = 0.f; for (int d = 0; d < 64; ++d) { sq += qv[d] * qv[d]; sk += kv[d] * kv[d]; }
            sc[0] = 0.125f / sqrtf(sq + EPS); sc[1] = 1.0f / sqrtf(sk + EPS);
            sc[2] = 1.0f / (1.0f + expf(-SM[tok * 32 + hsel]));
            const float x = SM[tok * 32 + 4 + hsel] + F.in[5][l * 4 + hsel]; const float sp = fmaxf(x, 0.f) + log1pf(expf(-fabsf(x)));
            sc[3] = expf(-expf(F.in[4][l * 4 + hsel]) * sp); }
        __syncthreads();
        if (F.tid < 64) { qv[F.tid] *= sc[0]; kv[F.tid] *= sc[1]; }
        for (int i = F.tid; i < 4096; i += NTHR) S[i] *= sc[3];
        __syncthreads();
        if ((ABL & (1 << 21)) && t < 64 && F.tid < 64) { const float* dq = (const float*)(F.ctl + 8192); const int which = msel; if (which < 3) { const float r = which == 0 ? qv[F.tid] : which == 1 ? kv[F.tid] : vv[F.tid] * sc[2];
            const float m = dq[which * 4096 + t * 64 + F.tid]; errsum += (m - r) * (m - r); refsum += r * r; } }
        if ((ABL & (1 << 22)) && t < 64) { LAS float* KH = sc + 16; LAS float* GH = KH + 4096;
            if (F.tid < 64) KH[t * 64 + F.tid] = kv[F.tid];
            if (F.tid == 0) GH[t] = (t ? GH[t - 1] : 0.f) + logf(sc[3]);
            __syncthreads();
            if (F.tid <= t && msel < 2) { const int j = F.tid; float d = 0.f; for (int dk = 0; dk < 64; ++dk) d += (msel == 0 ? qv[dk] : kv[dk]) * KH[j * 64 + dk];
                float r = d * expf(GH[t] - GH[j]) * (msel == 0 ? 1.0f : sc[2]); if (msel == 1 && j == t) r = 0.f;
                const float m = ((const float*)(F.ctl + 8192 + 3 * 4096))[(msel == 0 ? 4096 : 0) + t * 64 + j]; errsum += (m - r) * (m - r); refsum += r * r; }
            __syncthreads(); }
        if (F.tid < 64) { float a = 0.f; for (int dk = 0; dk < 64; ++dk) a += S[dk * 64 + F.tid] * kv[dk]; tmp[F.tid] = sc[2] * (vv[F.tid] - a); }
        __syncthreads();
        if ((ABL & (1 << 22)) && msel == 2 && t < 64 && F.tid < 64) { const float m = ((const float*)(F.ctl + 8192 + 5 * 4096))[t * 64 + F.tid], r = tmp[F.tid]; errsum += (m - r) * (m - r); refsum += r * r; }
        for (int i = F.tid; i < 4096; i += NTHR) S[i] += kv[i >> 6] * tmp[i & 63];
        __syncthreads();
        if (F.tid < 64) { float a = 0.f; for (int dk = 0; dk < 64; ++dk) a += S[dk * 64 + F.tid] * qv[dk]; ov[F.tid] = a; }
        __syncthreads();
        if ((ABL & (1 << 21)) && msel == 3 && t < 64 && F.tid < 64) { const float* GO = (const float*)(F.ws + WS_GO) + (size_t)((bsel * NCH + 0) * 4 + hsel) * 4096;
            const float m = (ABL & (1 << 23)) ? ((const float*)(F.ctl + 8192 + 6 * 4096))[t * 64 + F.tid] : GO[t * 64 + F.tid], r = ov[F.tid]; errsum += (m - r) * (m - r); refsum += r * r; }
        if (F.tid == 0) { float ss = 0.f; for (int d = 0; d < 64; ++d) ss += ov[d] * ov[d]; sc[4] = 1.0f / sqrtf(ss / 64.0f + EPS); }
        __syncthreads();
        if (F.tid < 64) { const float gt = bf2f(PROJ[tok * PP + GA + hsel * 64 + F.tid]); const float r = ov[F.tid] * sc[4] * F.in[6][l * 64 + F.tid] * (gt / (1.0f + expf(-gt)));
            const float m = bf2f(MIX[tok * D + hsel * 64 + F.tid]);
            const bool use = msel == 0 ? true : msel == 1 ? ((t & 63) < 16) : msel == 2 ? (t < 64) : (t >= 64);
            if (use && !(ABL & (3 << 21))) { errsum += (m - r) * (m - r); refsum += r * r; } }
        __syncthreads();
    }
    if (F.tid < 64) { errsum = wave_sum(errsum); refsum = wave_sum(refsum); if (F.tid == 0) dbgout[0] = 1000.0f * sqrtf(errsum / fmaxf(refsum, 1e-30f)); }
}
#define IN_PH (lo <= ph && ph < hi)
#define END_PH do { if (IN_PH && ph + 1 < hi) xcd_barrier(bar); ++ph; } while (0)
template <int l>
__device__ __forceinline__ void layer_phases(Frame& F, const XcdBarrier& bar, const int lo, const int hi, int& ph) {
    LAS unsigned char* ring = F.lds;
    bf16* HM = (bf16*)(F.ws + WS_HM); bf16* PROJ = (bf16*)(F.ws + WS_PROJ); float* X = F.out;
        if (PHON(1) && IN_PH) {
            pg8::StaticOrder S; S.init(T, NIN, F.G, F.bid); pg8::EpiProj E{PROJ, (float*)(F.ws + WS_SMALL)};
            pg8::gemm_phase<pg8::EpiProj, pg8::StaticOrder, false>(ring, HM, (const bf16*)(F.ws + WS_WIN) + (size_t)l * NIN * D, D, S, E, nullptr); }
        END_PH;
        if (PHON(2) && IN_PH) { prep_phase(F, l); if (REPEAT & 1) { __syncthreads(); prep_phase(F, l); } }
        END_PH;
        if ((ABL & 4096) && (ABL & (1 << 24)) && l == ((ABL >> 15) & 1)) { if (IN_PH) dbg_gdn_check(F, l, (ABL >> 18) & 7, (ABL >> 16) & 3, (ABL >> 13) & 3, (float*)(F.ctl + 2048)); END_PH; }
        if (PHON(3) && IN_PH) scan_attn_phase(F, l);
        END_PH;
        if ((ABL & 4096) && (ABL & (1 << 25)) && l == ((ABL >> 15) & 1)) { if (IN_PH) dbg_gdn_check(F, l, (ABL >> 18) & 7, (ABL >> 16) & 3, (ABL >> 13) & 3, (float*)(F.ctl + 2048)); END_PH; }
        if (PHON(4) && IN_PH) { finalize_phase(F, l); if (REPEAT & 2) { __syncthreads(); finalize_phase(F, l); } }
        END_PH;
        if ((ABL & 4096) && !(ABL & (3 << 24)) && l == ((ABL >> 15) & 1)) { if (IN_PH) dbg_gdn_check(F, l, (ABL >> 18) & 7, (ABL >> 16) & 3, (ABL >> 13) & 3, (float*)(F.ctl + 2048)); END_PH; }
        if (PHON(5) && IN_PH) {
            pg8::StaticOrder S; S.init(T, D, F.G, F.bid); pg8::EpiResid E{l == 0 ? F.in[0] : (const float*)X, X};
            pg8::gemm_phase<pg8::EpiResid, pg8::StaticOrder, false>(ring, HM, (const bf16*)(F.ws + WS_WOUT) + (size_t)l * D * D, D, S, E, nullptr); }
        END_PH;
        if (l == 0) {
            if (PHON(6) && IN_PH) norm_phase(F, X, F.in[21]);
            END_PH;
            if (PHON(7) && !(ABL & 4) && IN_PH) { pg8::StaticOrder S; S.init(T, 2 * DFF, F.G, F.bid); pg8::EpiSwiglu E{PROJ, DFF, 22};
                pg8::gemm_phase<pg8::EpiSwiglu, pg8::StaticOrder, false>(ring, HM, (const bf16*)(F.ws + WS_WGU), D, S, E, nullptr); }
            END_PH;
            if (PHON(8) && !(ABL & 4) && IN_PH) { pg8::StaticOrder S; S.init(T, D, F.G, F.bid); pg8::EpiResid E{X, X};
                pg8::gemm_phase<pg8::EpiResid, pg8::StaticOrder, false>(ring, PROJ, (const bf16*)(F.ws + WS_WD), DFF, S, E, nullptr); }
            END_PH;
            if (PHON(6) && IN_PH) norm_phase(F, X, F.in[1] + D);
            END_PH;
        } else {
            if (PHON(9) && IN_PH) { norm_router_phase(F, X, F.in[21] + D, F.in[25]); __syncthreads(); moe_convert(F); }
            END_PH;
            for (int k = 0; k < ((ABL & 1) ? 0 : 2); ++k) {
                const int* stok = (const int*)(F.ws + WS_STOK) + (size_t)k * NE * T; const float* sw = (const float*)(F.ws + WS_SW) + (size_t)k * NE * T;
                if (PHON(10) && IN_PH) { pg8::MoeOrder S; S.init(F.ctl + CW_MOECNT + 8 * k, 28, F.G, F.bid); pg8::EpiSwiglu E{PROJ, DFE, 28};
                    pg8::gemm_phase<pg8::EpiSwiglu, pg8::MoeOrder, true>(ring, HM, (const bf16*)(F.ws + WS_MOEW_GU), D, S, E, stok); }
                END_PH;
                if (PHON(11) && IN_PH) { pg8::MoeOrder S; S.init(F.ctl + CW_MOECNT + 8 * k, 4, F.G, F.bid); pg8::EpiScatter E{X, stok, sw, 4};
                    pg8::gemm_phase<pg8::EpiScatter, pg8::MoeOrder, false>(ring, PROJ, (const bf16*)(F.ws + WS_MOEW_D), DFE, S, E, nullptr); }
                END_PH;
            }
            if (PHON(12) && IN_PH) final_norm_phase(F, X, F.in[29]);
            END_PH;
            if (ABL & 4096) { if (IN_PH) { for (size_t i = (size_t)F.bid * NTHR + F.tid; i < (size_t)T * D; i += (size_t)F.G * NTHR) X[i] = (i == 0) ? ((const float*)(F.ctl + 2048))[0] : 0.f; } END_PH; }
        }
}
#undef IN_PH
#undef END_PH
struct Args { const float* in[30]; float* out; unsigned char* ws; int ph_lo, ph_hi; };
constexpr int N_PHASES = 21 + ((ABL & 4096) ? 2 : 0);
__global__ void __launch_bounds__(NTHR, 2) fwd(Args args) {
    extern __shared__ __attribute__((aligned(16))) unsigned char lds[];
    Frame F;
    F.lds = (LAS unsigned char*)lds; F.MISC = (volatile LAS unsigned*)(F.lds + MISC_OFF);
    F.tid = threadIdx.x; F.lane = F.tid & 63; F.wave = __builtin_amdgcn_readfirstlane(F.tid >> 6);
    F.G = gridDim.x; F.bid = blockIdx.x; F.in = args.in; F.out = args.out; F.ws = args.ws; F.ctl = (unsigned*)(args.ws + WS_CTL);
    for (int u = F.tid; u < 64; u += NTHR) F.MISC[u] = 0u;
    __syncthreads();
    const int lo = args.ph_lo, hi = args.ph_hi;
    XcdBarrier bar; bar.bar = F.ctl + CW_BAR; bar.x = 0; bar.st = nullptr;
    if (hi - lo > 1) bar = xcd_barrier_post(F.ctl + CW_BAR, F.MISC + 8);
    int ph = 0;
#define IN_PH (lo <= ph && ph < hi)
#define END_PH do { if (IN_PH && ph + 1 < hi) xcd_barrier(bar); ++ph; } while (0)
    LAS unsigned char* ring = F.lds;
    bf16* HM = (bf16*)(F.ws + WS_HM); bf16* PROJ = (bf16*)(F.ws + WS_PROJ); float* X = F.out;

    if (PHON(0) && IN_PH) p0_prologue(F);
    END_PH;
    layer_phases<0>(F, bar, lo, hi, ph);
    layer_phases<1>(F, bar, lo, hi, ph);
#undef IN_PH
#undef END_PH
}

extern "C" void kernel_launch(void* const* d_in, const int* in_sizes, int n_in, void* d_out, int out_size, void* d_ws, size_t ws_size, hipStream_t stream) {
    static int grid = 0;
    if (grid == 0) {
        if (n_in != 30 || in_sizes[0] != T * D || out_size != T * D || ws_size < WS_NEED) { fprintf(stderr, "kernel_launch: unexpected shapes (n_in %d, in0 %d, out %d, ws %zu < %zu); nothing launched\n", n_in, n_in > 0 ? in_sizes[0] : -1, out_size, ws_size, (size_t)WS_NEED); grid = -1; return; }
        int dev = 0, cus = 0, per_cu = 0;
        if (hipGetDevice(&dev) != hipSuccess || hipDeviceGetAttribute(&cus, hipDeviceAttributeMultiprocessorCount, dev) != hipSuccess) { grid = -1; return; }
        if (hipFuncSetAttribute((const void*)fwd, hipFuncAttributeMaxDynamicSharedMemorySize, LDS_BYTES) != hipSuccess) { fprintf(stderr, "kernel_launch: hipFuncSetAttribute failed\n"); grid = -1; return; }
        if (hipOccupancyMaxActiveBlocksPerMultiprocessor(&per_cu, (const void*)fwd, NTHR, LDS_BYTES) != hipSuccess || per_cu < 1) fprintf(stderr, "kernel_launch: occupancy query says %d\n", per_cu);
        (void)hipGetLastError();
        grid = cus;
    }
    if (grid < 0) return;
    if (hipMemsetAsync((char*)d_ws + WS_CTL, 0, CTL_ZERO_BYTES, stream) != hipSuccess) return;
    Args a{};
    for (int i = 0; i < 30; ++i) a.in[i] = (const float*)d_in[i];
    a.out = (float*)d_out; a.ws = (unsigned char*)d_ws;
#if MK_ONE_LAUNCH
    a.ph_lo = 0; a.ph_hi = N_PHASES;
    hipLaunchKernelGGL(fwd, dim3(grid), dim3(NTHR), LDS_BYTES, stream, a);
#else
    for (int p = 0; p < N_PHASES; ++p) { a.ph_lo = p; a.ph_hi = p + 1; hipLaunchKernelGGL(fwd, dim3(grid), dim3(NTHR), LDS_BYTES, stream, a); }
#endif
}
```

```cpp
#include <hip/hip_runtime.h>
#include <cstdio>
#include <cstdint>

#ifndef PHMASK
#define PHMASK 0xffff
#endif
#define PHON(k) ((PHMASK >> (k)) & 1)
#ifndef REPEAT
#define REPEAT 0
#endif
#ifndef DUMPS
#define DUMPS 0
#endif
#ifndef FINPARTS
#define FINPARTS 7
#endif
#ifndef ABL
#define ABL 0
#endif
#ifndef MK_ONE_LAUNCH
#define MK_ONE_LAUNCH 1
#endif

#define LAS __attribute__((address_space(3)))
#define GAS __attribute__((address_space(1)))
typedef unsigned short bf16;
typedef short bf16x8 __attribute__((ext_vector_type(8)));
typedef short s16x4 __attribute__((ext_vector_type(4)));
typedef float f32x4 __attribute__((ext_vector_type(4)));
typedef float f32x16 __attribute__((ext_vector_type(16)));
typedef unsigned u32x4 __attribute__((ext_vector_type(4)));
typedef unsigned u32x2 __attribute__((ext_vector_type(2)));

constexpr int T = 32768, D = 1024, SEQ = 4096, NB = 8, NCH = 64, CH = 64;
constexpr int PP = 3072;
constexpr int QA = 0, KA = 256, VA = 512, GA = 768, QB = 1024, KB = 1280, VB = 1536, XC = 1792, GC = 2048, QD = 2304, KD = 2432, VD = 2560, RD = 2816;
constexpr int NIN = 3328;
constexpr int DFF = 2816, DFE = 3584, NE = 8;
constexpr float EPS = 1e-6f;
constexpr float LOG2E = 1.4426950408889634f;

constexpr size_t MiB = 1u << 20;
constexpr size_t WS_CTL = 0, CTL_ZERO_BYTES = 1 * MiB;
constexpr size_t WS_STOK = 1 * MiB;
constexpr size_t WS_SW = 3 * MiB;
constexpr size_t WS_WIN = 5 * MiB;
constexpr size_t WS_WOUT = 18 * MiB;
constexpr size_t WS_WGU = 22 * MiB;
constexpr size_t WS_WD = 33 * MiB;
constexpr size_t WS_HM = 39 * MiB;
constexpr size_t WS_SMALL = 103 * MiB;
constexpr size_t WS_PROJ = 107 * MiB;
constexpr size_t WS_TMP = 299 * MiB;
constexpr size_t WS_GM = WS_TMP;
constexpr size_t WS_GN = WS_GM + 32 * MiB;
constexpr size_t WS_GQ = WS_GN + 32 * MiB;
constexpr size_t WS_GO = WS_GQ + 32 * MiB;
constexpr size_t WS_LOI = WS_GO + 32 * MiB;
constexpr size_t WS_LQG = WS_LOI + 32 * MiB;
constexpr size_t WS_LKV = WS_LQG + 16 * MiB;
constexpr size_t WS_RHL = WS_LKV + 16 * MiB;
constexpr size_t WS_RP = WS_RHL + 16 * MiB;
constexpr size_t WS_MISC = WS_RP + 16 * MiB;
constexpr size_t WS_LDL = WS_MISC;
constexpr size_t WS_RAT = WS_MISC + 512 * 1024;
constexpr size_t WS_RHE = WS_RAT + 512 * 1024;
constexpr size_t WS_RCA = WS_RHE + 512 * 1024;
constexpr size_t WS_TMP_END = WS_MISC + 2 * MiB;
constexpr size_t WS_MOEW_GU = 345 * MiB;
constexpr size_t WS_MOEW_D = 457 * MiB;
constexpr size_t WS_END = 513 * MiB;
constexpr size_t WS_NEED = 525 * MiB;
static_assert(WS_TMP_END <= WS_NEED && WS_END <= WS_NEED, "ws map");
static_assert(WS_PROJ + (size_t)34816 * DFE * 2 <= WS_MOEW_GU, "moe act fits under moe weights");
constexpr int CW_TMO = 0;
constexpr int CW_QUEUE = 64;
constexpr int CW_MOECNT = 1024;
constexpr int CW_BAR = 4096;

constexpr int RING_BYTES = 131072;
constexpr int MISC_OFF = RING_BYTES;
constexpr int LDS_BYTES = RING_BYTES + 4096;
constexpr int NWAVES = 8, NTHR = 512;

__device__ __forceinline__ unsigned f2bf(float f) { unsigned u = __builtin_bit_cast(unsigned, f); return (u + 0x7fffu + ((u >> 16) & 1u)) >> 16; }
__device__ __forceinline__ unsigned pk2(float lo, float hi) { return f2bf(lo) | (f2bf(hi) << 16); }
__device__ __forceinline__ float bflo(unsigned w) { return __builtin_bit_cast(float, w << 16); }
__device__ __forceinline__ float bfhi(unsigned w) { return __builtin_bit_cast(float, w & 0xffff0000u); }
__device__ __forceinline__ float bf2f(bf16 b) { return __builtin_bit_cast(float, ((unsigned)b) << 16); }
__device__ __forceinline__ float wave_sum(float v) {
#pragma unroll
    for (int o = 1; o < 64; o <<= 1) v += __shfl_xor(v, o);
    return v;
}
__device__ __forceinline__ float fexp(float x) { return __builtin_amdgcn_exp2f(x * LOG2E); }
__device__ __forceinline__ float sigmoidf_(float x) { return 1.0f / (1.0f + __expf(-x)); }
__device__ __forceinline__ float siluf_(float x) { return x / (1.0f + __expf(-x)); }
__device__ __forceinline__ float softplusf_(float x) { return fmaxf(x, 0.f) + log1pf(__expf(-fabsf(x))); }
__device__ __forceinline__ float gelu_tanh(float x) { const float u = 0.7978845608028654f * (x + 0.044715f * x * x * x); return 0.5f * x * (1.0f + tanhf(u)); }
#define LDS_WAIT() asm volatile("s_waitcnt lgkmcnt(0)" ::: "memory")
#define VM_WAIT() asm volatile("s_waitcnt vmcnt(0)" ::: "memory")

namespace pg8 {
constexpr int BM = 256, BK = 64, HALF = 128, HTB = HALF * BK * 2, STAGE_BYTES = 8 * HTB, NXCD = 8, WGM = 8;
__host__ __device__ __forceinline__ int lds_byte(int r, int c) { const int st = (r >> 4) * 2 + (c >> 5), rr = r & 15, cc = c & 31, ob = rr * 64 + cc * 2; return st * 1024 + (ob ^ (((ob >> 9) & 1) << 5)); }
__host__ __device__ __forceinline__ void stage_rc(int b, int& R, int& C) { const int st = b / 1024, sb = b % 1024, swz = sb ^ (((sb >> 9) & 1) << 5); R = (st >> 1) * 16 + swz / 64; C = (st & 1) * 32 + (swz % 64) / 2; }
__host__ __device__ __forceinline__ int perm32(int rho) { const int n = rho >> 4, i = rho & 15; return 8 * (i >> 2) + 4 * n + (i & 3); }

struct Unit { int pm, pn, e, vr, lbase; };

struct StaticOrder {
    int nM, nN, nwg, G, c;
    __device__ void init(int M, int N, int G_, int c_) { nM = M / BM; nN = N / BM; nwg = nM * nN; G = G_; c = c_; }
    __device__ bool next(int i, Unit& u) const {
        const long L = (long)i * G + c; if (L >= nwg) return false;
        int wgid = (int)L; { const int q = nwg / NXCD, r = nwg % NXCD, xcd = wgid % NXCD, off = wgid / NXCD; wgid = (xcd < r ? xcd * (q + 1) : r * (q + 1) + (xcd - r) * q) + off; }
        const int nig = WGM * nN, gid = wgid / nig, fm = gid * WGM, gsz = (nM - fm) < WGM ? (nM - fm) : WGM;
        u.pm = fm + ((wgid % nig) % gsz); u.pn = (wgid % nig) / gsz; u.e = 0; u.vr = 256; u.lbase = 0; return true;
    }
};
struct MoeOrder {
    int pre[9], cnt[8], nN, G, c, total;
    __device__ void init(const unsigned* gcnt, int nN_, int G_, int c_) {
        int p = 0;
#pragma unroll
        for (int e = 0; e < 8; ++e) { cnt[e] = (int)__hip_atomic_load(gcnt + e, __ATOMIC_RELAXED, __HIP_MEMORY_SCOPE_AGENT); pre[e] = p; p += (cnt[e] + 255) >> 8; }
        pre[8] = p; nN = nN_; G = G_; c = c_; total = p * nN_;
    }
    __device__ bool next(int i, Unit& u) const {
        const long L = (long)i * G + c; if (L >= total) return false;
        const int pm = (int)(L / nN), pl = (int)(L % nN); int e = 0;
#pragma unroll
        for (int j = 1; j < 8; ++j) if (pm >= pre[j]) e = j;
        int pe = 0, ce = 0;
#pragma unroll
        for (int j = 0; j < 8; ++j) if (j == e) { pe = pre[j]; ce = cnt[j]; }
        const int lt = pm - pe, rem = ce - lt * 256;
        u.pm = pm; u.pn = e * nN + pl; u.e = e; u.vr = rem < 256 ? rem : 256; u.lbase = e * T + lt * 256; return true;
    }
};

__device__ __forceinline__ unsigned cvt_pk_bf16(float lo, float hi) { unsigned r; asm volatile("v_cvt_pk_bf16_f32 %0, %1, %2" : "=v"(r) : "v"(lo), "v"(hi)); return r; }

struct EpiProj {
    static constexpr bool PERM = true;
    bf16* P; float* SM;
    __device__ __forceinline__ void operator()(const f32x4 (&acc)[2][2][4][2], const Unit& u, int wr, int wc, int fr, int fq) const {
        const int row0 = u.pm * BM + wr * 64 + fr;
        if (u.pn < 12) {
            const int col0 = u.pn * BM + wc * 32 + 8 * fq;
#pragma unroll
            for (int ai = 0; ai < 2; ++ai)
#pragma unroll
                for (int m = 0; m < 4; ++m) { bf16* rowp = P + (size_t)(row0 + ai * HALF + m * 16) * PP + col0;
#pragma unroll
                    for (int bj = 0; bj < 2; ++bj) { const f32x4 v0 = acc[ai][bj][m][0], v1 = acc[ai][bj][m][1];
                        u32x4 w; w.x = cvt_pk_bf16(v0[0], v0[1]); w.y = cvt_pk_bf16(v0[2], v0[3]); w.z = cvt_pk_bf16(v1[0], v1[1]); w.w = cvt_pk_bf16(v1[2], v1[3]);
                        *(u32x4*)(rowp + bj * HALF) = w; } }
        } else if (wc == 0) {
#pragma unroll
            for (int ai = 0; ai < 2; ++ai)
#pragma unroll
                for (int m = 0; m < 4; ++m) { float* sp = SM + (size_t)(row0 + ai * HALF + m * 16) * 32 + 8 * fq;
                    *(f32x4*)sp = acc[ai][0][m][0]; *(f32x4*)(sp + 4) = acc[ai][0][m][1]; }
        }
    }
};
struct EpiResid {
    static constexpr bool PERM = false;
    const float* res; float* out;
    __device__ __forceinline__ void operator()(const f32x4 (&acc)[2][2][4][2], const Unit& u, int wr, int wc, int fr, int fq) const {
        const int row0 = u.pm * BM + wr * 64 + fr, col0 = u.pn * BM + wc * 32 + 4 * fq;
#pragma unroll
        for (int ai = 0; ai < 2; ++ai)
#pragma unroll
            for (int m = 0; m < 4; ++m) { const size_t off = (size_t)(row0 + ai * HALF + m * 16) * D + col0;
#pragma unroll
                for (int bj = 0; bj < 2; ++bj)
#pragma unroll
                    for (int n = 0; n < 2; ++n) { const size_t o = off + bj * HALF + n * 16; *(f32x4*)(out + o) = *(const f32x4*)(res + o) + acc[ai][bj][m][n]; }
                asm volatile("" ::: "memory"); }
    }
};
struct EpiSwiglu {
    static constexpr bool PERM = true;
    bf16* act; int ldc, nN;
    __device__ __forceinline__ void operator()(const f32x4 (&acc)[2][2][4][2], const Unit& u, int wr, int wc, int fr, int fq) const {
        const int pl = u.pn % nN;
        const int row0 = u.pm * BM + wr * 64 + fr, col0 = pl * HALF + wc * 32 + 8 * fq;
#pragma unroll
        for (int ai = 0; ai < 2; ++ai)
#pragma unroll
            for (int m = 0; m < 4; ++m) { bf16* rowp = act + (size_t)(row0 + ai * HALF + m * 16) * ldc + col0;
                float o[8];
#pragma unroll
                for (int n = 0; n < 2; ++n)
#pragma unroll
                    for (int j = 0; j < 4; ++j) { const float g = acc[ai][0][m][n][j], up = acc[ai][1][m][n][j];
                        o[4 * n + j] = g * up * __builtin_amdgcn_rcpf(1.0f + __builtin_amdgcn_exp2f(-g * LOG2E)); }
                u32x4 w; w.x = cvt_pk_bf16(o[0], o[1]); w.y = cvt_pk_bf16(o[2], o[3]); w.z = cvt_pk_bf16(o[4], o[5]); w.w = cvt_pk_bf16(o[6], o[7]);
                *(u32x4*)rowp = w; asm volatile("" ::: "memory"); }
    }
};
struct EpiScatter {
    static constexpr bool PERM = false;
    float* x; const int* tok; const float* wgt; int nN;
    __device__ __forceinline__ void operator()(const f32x4 (&acc)[2][2][4][2], const Unit& u, int wr, int wc, int fr, int fq) const {
        const int pl = u.pn % nN;
        const int rl0 = wr * 64 + fr, col0 = pl * BM + wc * 32 + 4 * fq;
#pragma unroll
        for (int ai = 0; ai < 2; ++ai)
#pragma unroll
            for (int m = 0; m < 4; ++m) { const int rl = rl0 + ai * HALF + m * 16;
                if (rl < u.vr) { const int t = tok[u.lbase + rl]; const float w = wgt[u.lbase + rl]; float* xp = x + (size_t)t * D + col0;
#pragma unroll
                    for (int bj = 0; bj < 2; ++bj)
#pragma unroll
                        for (int n = 0; n < 2; ++n) { f32x4* p = (f32x4*)(xp + bj * HALF + n * 16); *p = *p + acc[ai][bj][m][n] * w; } }
                asm volatile("" ::: "memory"); }
    }
};

template <class Epi, class Sched, bool GATHER>
__device__ __forceinline__ void gemm_phase(LAS unsigned char* lds, const bf16* A, const bf16* Bt, const int K, const Sched& S, const Epi& E, const int* glist) {
    int tid_ = threadIdx.x; asm volatile("" : "+v"(tid_));
    const int tid = tid_, wid = __builtin_amdgcn_readfirstlane(tid >> 6), lane = tid & 63, wr = wid >> 2, wc = wid & 3, fr = lane & 15, fq = lane >> 4;
    const int nt = K / BK;
    unsigned voffA[2], voffB[2]; int gR[2], gC[2];
#pragma unroll
    for (int i = 0; i < 2; ++i) { int R, C; stage_rc(tid * 16 + i * 8192, R, C); const int Rb = Epi::PERM ? ((R & ~31) + perm32(R & 31)) : R;
        voffA[i] = (unsigned)(R * K + C) * 2u; voffB[i] = (unsigned)(Rb * K + C) * 2u; gR[i] = R; gC[i] = C; }
    const size_t kstep = (size_t)(BK * 2);
    const size_t hstep = (size_t)HALF * K * 2;
    const size_t tstep = 2 * hstep;
    const unsigned ldsw = (unsigned)wid * 1024u;
    const int aoff = lds_byte(wr * 64 + fr, fq * 8), boff = lds_byte(wc * 32 + fr, fq * 8);
#define PG8_SA(b, h) (((b) * 2 + (h)) * HTB)
#define PG8_SB(b, h) ((4 + (b) * 2 + (h)) * HTB)
#define PG8_STAGE(bufoff, gbase, voff) do { _Pragma("unroll") for (int _i = 0; _i < 2; ++_i) \
        __builtin_amdgcn_global_load_lds((const unsigned*)((const char*)(gbase) + (voff)[_i]), (LAS unsigned*)(lds + (bufoff) + ldsw + _i * 8192), 16, 0, 0); } while (0)
#define PG8_STAGE_A(b, h, ubase, koff, OFFS) do { if constexpr (GATHER) { PG8_STAGE(PG8_SA(b, h), (const char*)A + (koff), (OFFS)[h]); } \
        else { PG8_STAGE(PG8_SA(b, h), (ubase) + (size_t)(h) * hstep + (koff), voffA); } } while (0)
#define PG8_LDA(dst, b, h) do { _Pragma("unroll") for (int m = 0; m < 4; ++m) _Pragma("unroll") for (int k = 0; k < 2; ++k) dst[m][k] = *(const LAS bf16x8*)(lds + PG8_SA(b, h) + aoff + m * 2048 + k * 1024); } while (0)
#define PG8_LDB(dst, b, h) do { _Pragma("unroll") for (int n = 0; n < 2; ++n) _Pragma("unroll") for (int k = 0; k < 2; ++k) dst[n][k] = *(const LAS bf16x8*)(lds + PG8_SB(b, h) + boff + n * 2048 + k * 1024); } while (0)
#define PG8_MMA(ai, bj, At, Bt_) do { __builtin_amdgcn_s_setprio(1); _Pragma("unroll") for (int m = 0; m < 4; ++m) _Pragma("unroll") for (int n = 0; n < 2; ++n) _Pragma("unroll") for (int k = 0; k < 2; ++k) \
        acc[ai][bj][m][n] = __builtin_amdgcn_mfma_f32_16x16x32_bf16(Bt_[n][k], At[m][k], acc[ai][bj][m][n], 0, 0, 0); __builtin_amdgcn_s_setprio(0); } while (0)
#define PG8_WAIT_V(n) asm volatile("s_waitcnt vmcnt(" #n ")" ::: "memory")
#define PG8_WAIT_L(n) asm volatile("s_waitcnt lgkmcnt(" #n ")" ::: "memory")
#define PG8_BAR __builtin_amdgcn_s_barrier()
#define PG8_SCHED __builtin_amdgcn_sched_barrier(0)
#define PG8_GOFF(dst, U) do { _Pragma("unroll") for (int _h = 0; _h < 2; ++_h) _Pragma("unroll") for (int _i = 0; _i < 2; ++_i) { const int _row = _h * HALF + gR[_i]; \
        const int _tk = (_row < (U).vr) ? glist[(U).lbase + _row] : 0; dst[_h][_i] = (unsigned)(_tk * K + gC[_i]) * 2u; } } while (0)
    Unit cur, nxt; int ui = 0;
    if (!S.next(0, cur)) return;
    f32x4 acc[2][2][4][2];
#pragma unroll
    for (int a = 0; a < 2; ++a)
#pragma unroll
        for (int b = 0; b < 2; ++b)
#pragma unroll
            for (int m = 0; m < 4; ++m)
#pragma unroll
                for (int n = 0; n < 2; ++n) acc[a][b][m][n] = (f32x4){0.f, 0.f, 0.f, 0.f};
    bf16x8 At[4][2], B0[2][2], B1[2][2];
    unsigned gofc[2][2] = {{0u, 0u}, {0u, 0u}}, gofn[2][2] = {{0u, 0u}, {0u, 0u}};
    if constexpr (GATHER) { PG8_GOFF(gofc, cur); }
    const char* cA = (const char*)A + (size_t)cur.pm * tstep; const char* cB = (const char*)Bt + (size_t)cur.pn * tstep;
    PG8_STAGE(PG8_SB(0, 0), cB, voffB); PG8_STAGE(PG8_SB(0, 1), cB + hstep, voffB); PG8_STAGE_A(0, 0, cA, 0, gofc); PG8_STAGE_A(0, 1, cA, 0, gofc);
    if (wr == 1) PG8_BAR;
    PG8_WAIT_V(2); PG8_BAR;
    PG8_STAGE(PG8_SB(1, 0), cB + kstep, voffB); PG8_STAGE_A(1, 0, cA, kstep, gofc); PG8_STAGE(PG8_SB(1, 1), cB + hstep + kstep, voffB);
    PG8_WAIT_V(6); PG8_BAR;
    for (;;) {
        const bool has_next = S.next(ui + 1, nxt);
        const char* nA = has_next ? (const char*)A + (size_t)nxt.pm * tstep : cA; const char* nB = has_next ? (const char*)Bt + (size_t)nxt.pn * tstep : cB;
        if constexpr (GATHER) { if (has_next) { PG8_GOFF(gofn, nxt); } else {
#pragma unroll
            for (int h = 0; h < 2; ++h)
#pragma unroll
                for (int i = 0; i < 2; ++i) gofn[h][i] = gofc[h][i]; } }
        for (int t = 0; t < nt; t += 2) {
            const bool last = (t == nt - 2);
            const size_t k1 = (size_t)(t + 1) * kstep;
            const char* ua2 = last ? nA : cA; const size_t k2 = last ? 0 : (size_t)(t + 2) * kstep; const size_t k3 = k2 + kstep;
            const char* b2 = last ? nB : cB + (size_t)(t + 2) * kstep; const char* b3 = b2 + kstep;
            unsigned go2[2][2];
#pragma unroll
            for (int h = 0; h < 2; ++h)
#pragma unroll
                for (int i = 0; i < 2; ++i) go2[h][i] = last ? gofn[h][i] : gofc[h][i];
            PG8_LDB(B0, 0, 0); PG8_LDB(B1, 0, 1); PG8_SCHED; PG8_LDA(At, 0, 0); PG8_STAGE_A(1, 1, cA, k1, gofc);
            PG8_WAIT_V(8); PG8_WAIT_L(0); PG8_BAR; PG8_MMA(0, 0, At, B0); PG8_MMA(0, 1, At, B1); PG8_BAR; PG8_SCHED;
            PG8_LDA(At, 0, 1); PG8_STAGE(PG8_SB(0, 0), b2, voffB); PG8_STAGE(PG8_SB(0, 1), b2 + hstep, voffB); PG8_STAGE_A(0, 0, ua2, k2, go2);
            PG8_WAIT_V(8); PG8_WAIT_L(0); PG8_BAR; PG8_MMA(1, 0, At, B0); PG8_MMA(1, 1, At, B1); PG8_BAR; PG8_SCHED;
            PG8_LDB(B0, 1, 0); PG8_LDB(B1, 1, 1); PG8_SCHED; PG8_LDA(At, 1, 0); PG8_STAGE_A(0, 1, ua2, k2, go2);
            PG8_WAIT_V(8); PG8_WAIT_L(0); PG8_BAR; PG8_MMA(0, 0, At, B0); PG8_MMA(0, 1, At, B1); PG8_BAR; PG8_SCHED;
            PG8_LDA(At, 1, 1); PG8_STAGE(PG8_SB(1, 0), b3, voffB); PG8_STAGE(PG8_SB(1, 1), b3 + hstep, voffB); PG8_STAGE_A(1, 0, ua2, k3, go2);
            PG8_WAIT_V(8); PG8_WAIT_L(0); PG8_BAR; PG8_MMA(1, 0, At, B0); PG8_MMA(1, 1, At, B1); PG8_BAR; PG8_SCHED;
        }
        if (wr == 0) PG8_BAR;
        E(acc, cur, wr, wc, fr, fq);
        if (!has_next) break;
#pragma unroll
        for (int a = 0; a < 2; ++a)
#pragma unroll
            for (int b = 0; b < 2; ++b)
#pragma unroll
                for (int m = 0; m < 4; ++m)
#pragma unroll
                    for (int n = 0; n < 2; ++n) acc[a][b][m][n] = (f32x4){0.f, 0.f, 0.f, 0.f};
        cur = nxt; cA = nA; cB = nB; ++ui;
#pragma unroll
        for (int h = 0; h < 2; ++h)
#pragma unroll
            for (int i = 0; i < 2; ++i) gofc[h][i] = gofn[h][i];
        if (wr == 1) PG8_BAR;
    }
    PG8_WAIT_V(0);
    PG8_BAR;
#undef PG8_SA
#undef PG8_SB
#undef PG8_STAGE
#undef PG8_STAGE_A
#undef PG8_LDA
#undef PG8_LDB
#undef PG8_MMA
#undef PG8_WAIT_V
#undef PG8_WAIT_L
#undef PG8_BAR
#undef PG8_SCHED
#undef PG8_GOFF
}
}

#define XB_TMO      128
#define XB_XCNT(j)  (256  + 64 * (j))
#define XB_XSUB(j)  (1280 + 64 * (j))
#define XB_XGEN(j)  (2304 + 64 * (j))
#define XB_TOP      3328
#define XB_TOPGEN   3392
#define XCD_BAR_WORDS 3456
#define XB_SPIN_CAP (1u << 18)
__device__ __forceinline__ unsigned xb_ld(unsigned* p)              { return __hip_atomic_load(p, __ATOMIC_RELAXED, __HIP_MEMORY_SCOPE_AGENT); }
__device__ __forceinline__ unsigned xb_add(unsigned* p, unsigned v) { return __hip_atomic_fetch_add(p, v, __ATOMIC_RELAXED, __HIP_MEMORY_SCOPE_AGENT); }
__device__ __forceinline__ unsigned xb_xcc_id() { return (unsigned)__builtin_amdgcn_s_getreg((3 << 11) | 20) & 0xFu; }
#define XB_SPIN(cond, bar) do { unsigned _sp = 0; while (cond) { __builtin_amdgcn_s_sleep(1); \
    if ((++_sp & 255u) == 0u) { if (xb_ld(&(bar)[XB_TMO])) break; if (_sp > XB_SPIN_CAP) { atomicAdd(&(bar)[XB_TMO], 1u); break; } } } } while (0)
struct XcdBarrier { unsigned* bar; unsigned x; volatile LAS unsigned* st; };
__device__ __forceinline__ XcdBarrier xcd_barrier_post(unsigned* bar, volatile LAS unsigned* st) {
    XcdBarrier b; b.bar = bar; b.x = xb_xcc_id(); b.st = st;
    if (threadIdx.x == 0) (void)xb_add(&bar[XB_XCNT(b.x)], 1u);
    return b;
}
__device__ __forceinline__ void xcd_barrier_complete(unsigned* bar, unsigned x, unsigned& nloc, unsigned& nx) {
    const unsigned G = gridDim.x * gridDim.y * gridDim.z;
    unsigned sum, cnt, mine, sp = 0u;
    for (;;) {
        sum = 0u; cnt = 0u; mine = 0u;
#pragma unroll
        for (unsigned j = 0; j < 16; ++j) { const unsigned c = xb_ld(&bar[XB_XCNT(j)]); sum += c; cnt += (c > 0u) ? 1u : 0u; mine = (j == x) ? c : mine; }
        if (sum == G) break;
        __builtin_amdgcn_s_sleep(1);
        if ((++sp & 255u) == 0u) { if (xb_ld(&bar[XB_TMO])) break; if (sp > XB_SPIN_CAP) { atomicAdd(&bar[XB_TMO], 1u); break; } }
    }
    nloc = mine > 0u ? mine : 1u; nx = cnt > 0u ? cnt : 1u;
}
__device__ __forceinline__ void xcd_barrier(const XcdBarrier& b) {
    asm volatile("s_waitcnt vmcnt(0)" ::: "memory");
    __syncthreads();
    if (threadIdx.x == 0) {
        unsigned* bar = b.bar;
        __builtin_amdgcn_s_waitcnt(0);
        unsigned nloc = b.st[0], nx = b.st[1];
        if (nloc == 0u) { xcd_barrier_complete(bar, b.x, nloc, nx); b.st[0] = nloc; b.st[1] = nx; }
        const unsigned old = xb_add(&bar[XB_XSUB(b.x)], 1u);
        const unsigned gen = old / nloc;
        if (old + 1u == (gen + 1u) * nloc) {
            __builtin_amdgcn_fence(__ATOMIC_RELEASE, "agent");
            asm volatile("s_waitcnt vmcnt(0)" ::: "memory");
            const unsigned og = xb_add(&bar[XB_TOP], 1u);
            const unsigned tg = og / nx;
            if (og + 1u == (tg + 1u) * nx) xb_add(&bar[XB_TOPGEN], 1u);
            else XB_SPIN(xb_ld(&bar[XB_TOPGEN]) == tg, bar);
            __builtin_amdgcn_fence(__ATOMIC_ACQUIRE, "agent");
            xb_add(&bar[XB_XGEN(b.x)], 1u);
            asm volatile("s_waitcnt vmcnt(0)" ::: "memory");
        } else {
            XB_SPIN(xb_ld(&bar[XB_XGEN(b.x)]) == gen, bar);
            __builtin_amdgcn_fence(__ATOMIC_ACQUIRE, "agent");
            asm volatile("s_waitcnt vmcnt(0)" ::: "memory");
        }
    }
    __syncthreads();
}


struct Frame {
    LAS unsigned char* lds;
    volatile LAS unsigned* MISC;
    unsigned* ctl;
    int tid, lane, wave, G, bid;
    const float* const* in;
    float* out; unsigned char* ws;
};

template <class P> __device__ __forceinline__ P lptr(P p) { unsigned long long v = (unsigned long long)p; unsigned lo = (unsigned)v, hi = (unsigned)(v >> 32); asm volatile("" : "+v"(lo), "+v"(hi));
    lo = __builtin_amdgcn_readfirstlane(lo); hi = __builtin_amdgcn_readfirstlane(hi); return (P)(((unsigned long long)hi << 32) | lo); }
__device__ __forceinline__ Frame opq(Frame F) { asm volatile("" : "+v"(F.tid));  F.lane = F.tid & 63; F.wave = __builtin_amdgcn_readfirstlane(F.tid >> 6); return F; }

template <bool TA, bool TB>
__device__ __forceinline__ f32x4 mm16(const LAS float* A, int lda, const LAS float* B, int ldb, int i0, int j0, int K, f32x4 acc, int lane) {
    const int lr = lane & 15, lg = lane >> 4;
    for (int ks = 0; ks < K; ks += 4) {
        const int k = ks + lg;
        const float a = TA ? A[k * lda + i0 + lr] : A[(i0 + lr) * lda + k];
        const float b = TB ? B[(j0 + lr) * ldb + k] : B[k * ldb + j0 + lr];
        acc = __builtin_amdgcn_mfma_f32_16x16x4f32(a, b, acc, 0, 0, 0);
    }
    asm volatile("s_nop 15\n\ts_nop 7" : "+v"(acc));
    return acc;
}

template <bool TA, bool TB>
__device__ __forceinline__ f32x4 mm16b(const LAS float* A, int lda, const LAS float* B, int ldb, int i0, int j0, int K, f32x4 acc, int lane) {
    const int lr = lane & 15, lg = lane >> 4;
    for (int ks = 0; ks < K; ks += 32) {
        const int k0 = ks + 8 * lg; const bool in = k0 < K;
        f32x4 a0 = (f32x4){0.f, 0.f, 0.f, 0.f}, a1 = a0, b0 = a0, b1 = a0;
        if (in) {
            if (TA) { const LAS float* p = A + k0 * lda + i0 + lr; a0 = (f32x4){p[0], p[lda], p[2 * lda], p[3 * lda]}; a1 = (f32x4){p[4 * lda], p[5 * lda], p[6 * lda], p[7 * lda]}; }
            else { const LAS float* p = A + (i0 + lr) * lda + k0; a0 = *(const LAS f32x4*)p; a1 = *(const LAS f32x4*)(p + 4); }
            if (TB) { const LAS float* p = B + (j0 + lr) * ldb + k0; b0 = *(const LAS f32x4*)p; b1 = *(const LAS f32x4*)(p + 4); }
            else { const LAS float* p = B + k0 * ldb + j0 + lr; b0 = (f32x4){p[0], p[ldb], p[2 * ldb], p[3 * ldb]}; b1 = (f32x4){p[4 * ldb], p[5 * ldb], p[6 * ldb], p[7 * ldb]}; }
        }
        u32x4 aw, bw;
        aw.x = pg8::cvt_pk_bf16(a0.x, a0.y); aw.y = pg8::cvt_pk_bf16(a0.z, a0.w); aw.z = pg8::cvt_pk_bf16(a1.x, a1.y); aw.w = pg8::cvt_pk_bf16(a1.z, a1.w);
        bw.x = pg8::cvt_pk_bf16(b0.x, b0.y); bw.y = pg8::cvt_pk_bf16(b0.z, b0.w); bw.z = pg8::cvt_pk_bf16(b1.x, b1.y); bw.w = pg8::cvt_pk_bf16(b1.z, b1.w);
        acc = __builtin_amdgcn_mfma_f32_16x16x32_bf16(__builtin_bit_cast(bf16x8, aw), __builtin_bit_cast(bf16x8, bw), acc, 0, 0, 0);
    }
    asm volatile("s_nop 15\n\ts_nop 7" : "+v"(acc));
    return acc;
}

__device__ __forceinline__ void tr_item(const float* src, int ld, int scol, bf16* WT, int K, int r0, int k0, LAS float* scr, int lane) {
#pragma unroll 8
    for (int i = 0; i < 32; ++i) { const int kk = 2 * i + (lane >> 5); const float v = scol >= 0 ? src[(size_t)(k0 + kk) * ld + scol] : 0.f; scr[kk * 33 + (lane & 31)] = v; }
    LDS_WAIT(); asm volatile("" ::: "memory");
    const int c = lane & 7;
#pragma unroll
    for (int j = 0; j < 4; ++j) { const int n = (lane >> 3) + 8 * j; const LAS float* s = scr + (8 * c) * 33 + n;
        u32x4 o; o.x = pk2(s[0 * 33], s[1 * 33]); o.y = pk2(s[2 * 33], s[3 * 33]); o.z = pk2(s[4 * 33], s[5 * 33]); o.w = pk2(s[6 * 33], s[7 * 33]);
        *(u32x4*)(WT + (size_t)(r0 + n) * K + k0 + 8 * c) = o; }
    LDS_WAIT(); asm volatile("" ::: "memory");
}

__device__ __forceinline__ void norm_row(const float* xrow, const f32x4 (&g)[4], bf16* orow, f32x4 (&v)[4], int lane) {
    const f32x4* xr = (const f32x4*)xrow + lane; float s = 0.f;
#pragma unroll
    for (int j = 0; j < 4; ++j) { v[j] = xr[64 * j]; s += (v[j].x * v[j].x + v[j].y * v[j].y) + (v[j].z * v[j].z + v[j].w * v[j].w); }
    const float r = 1.0f / sqrtf(wave_sum(s) * (1.f / D) + EPS);
    unsigned long long* o8 = (unsigned long long*)orow + lane;
#pragma unroll
    for (int j = 0; j < 4; ++j) { v[j] = v[j] * r * g[j]; o8[64 * j] = (unsigned long long)pk2(v[j].x, v[j].y) | ((unsigned long long)pk2(v[j].z, v[j].w) << 32); }
}

__device__ __forceinline__ void p0_prologue(const Frame& F0) { Frame F = opq(F0);
    LAS float* scr = (LAS float*)(F.lds + F.wave * 16384);
    const int gw = F.bid * NWAVES + F.wave, NGW = F.G * NWAVES;
    const float* w_in = F.in[2]; const float* w_out = F.in[20]; const float* fg = F.in[22]; const float* fu = F.in[23]; const float* fd = F.in[24];
    bf16* Win = (bf16*)(F.ws + WS_WIN); bf16* Wout = (bf16*)(F.ws + WS_WOUT); bf16* Wgu = (bf16*)(F.ws + WS_WGU); bf16* Wd = (bf16*)(F.ws + WS_WD);
    constexpr int I_IN = 2 * 16 * 104, I_OUT = 2 * 16 * 32, I_GU = 16 * 176, I_D = 44 * 32;
    const int j = F.lane & 31;
    for (int it = gw; it < I_IN + I_OUT + I_GU + I_D; it += NGW) {
        int r = it;
        if (r < I_IN) { const int l = r / (16 * 104), q = r % (16 * 104), kb = q / 104, nb = q % 104, n = 32 * nb + j;
            const int scol = n < 1024 ? n : n < 3072 ? n + 8 : n < 3080 ? n - 2048 : n < 3096 ? n : -1;
            tr_item(w_in + (size_t)l * D * 3096, 3096, scol, Win + (size_t)l * NIN * D, D, 32 * nb, 64 * kb, scr, F.lane); continue; }
        r -= I_IN;
        if (r < I_OUT) { const int l = r / 512, q = r % 512, kb = q / 32, nb = q % 32;
            tr_item(w_out + (size_t)l * D * D, D, 32 * nb + j, Wout + (size_t)l * D * D, D, 32 * nb, 64 * kb, scr, F.lane); continue; }
        r -= I_OUT;
        if (r < I_GU) { const int kb = r / 176, nb = r % 176, r0 = 32 * nb, pn = r0 >> 8, j0 = r0 & 255;
            tr_item(j0 < 128 ? fg : fu, DFF, pn * 128 + (j0 & 127) + j, Wgu, D, r0, 64 * kb, scr, F.lane); continue; }
        r -= I_GU;
        { const int kb = r / 32, nb = r % 32; tr_item(fd, D, 32 * nb + j, Wd, DFF, 32 * nb, 64 * kb, scr, F.lane); }
    }
    f32x4 g[4];
#pragma unroll
    for (int q = 0; q < 4; ++q) g[q] = ((const f32x4*)F.in[1])[F.lane + 64 * q];
    bf16* H = (bf16*)(F.ws + WS_HM);
    for (int m = gw; m < T; m += NGW) { f32x4 v[4]; norm_row(F.in[0] + (size_t)m * D, g, H + (size_t)m * D, v, F.lane); }
}
__device__ __forceinline__ void moe_convert(const Frame& F0) { Frame F = opq(F0);
    LAS float* scr = (LAS float*)(F.lds + F.wave * 16384);
    const int gw = F.bid * NWAVES + F.wave, NGW = F.G * NWAVES;
    const float* mg = F.in[26]; const float* mu = F.in[27]; const float* md = F.in[28];
    bf16* Wgu = (bf16*)(F.ws + WS_MOEW_GU); bf16* Wd = (bf16*)(F.ws + WS_MOEW_D);
    constexpr int I_GU = 16 * 224, I_D = 56 * 32;
    const int j = F.lane & 31;
    for (int it = gw; it < NE * (I_GU + I_D); it += NGW) {
        const int e = it / (I_GU + I_D); int r = it % (I_GU + I_D);
        if (r < I_GU) { const int kb = r / 224, nb = r % 224, r0 = 32 * nb, pn = r0 >> 8, j0 = r0 & 255;
            tr_item((j0 < 128 ? mg : mu) + (size_t)e * D * DFE, DFE, pn * 128 + (j0 & 127) + j, Wgu + (size_t)e * 7168 * D, D, r0, 64 * kb, scr, F.lane); continue; }
        r -= I_GU;
        { const int kb = r / 32, nb = r % 32; tr_item(md + (size_t)e * DFE * D, D, 32 * nb + j, Wd + (size_t)e * D * DFE, DFE, 32 * nb, 64 * kb, scr, F.lane); }
    }
}

__device__ __forceinline__ void norm_phase(const Frame& F0, const float* x, const float* gain) { Frame F = opq(F0);
    const int gw = F.bid * NWAVES + F.wave, NGW = F.G * NWAVES;
    f32x4 g[4];
#pragma unroll
    for (int q = 0; q < 4; ++q) g[q] = ((const f32x4*)gain)[F.lane + 64 * q];
    bf16* H = (bf16*)(F.ws + WS_HM);
    for (int m = gw; m < T; m += NGW) { f32x4 v[4]; norm_row(x + (size_t)m * D, g, H + (size_t)m * D, v, F.lane); }
}
__device__ __forceinline__ void norm_router_phase(const Frame& F0, const float* x, const float* gain, const float* wr) { Frame F = opq(F0);
    LAS float* WR = (LAS float*)F.lds;
    LAS int* lcnt = (LAS int*)(F.lds + 32768);
    LAS int* lbase = lcnt + 16;
    LAS int* rE = lbase + 16;
    LAS int* rP1 = rE + 128; LAS int* rP2 = rP1 + 128;
    LAS float* rW = (LAS float*)(rP2 + 128);
    f32x4 g[4];
#pragma unroll
    for (int q = 0; q < 4; ++q) g[q] = ((const f32x4*)gain)[F.lane + 64 * q];
    for (int i = F.tid; i < 2048; i += NTHR) ((LAS f32x4*)WR)[i] = ((const f32x4*)wr)[i];
    bf16* H = (bf16*)(F.ws + WS_HM);
    int* stok = (int*)(F.ws + WS_STOK); float* sw = (float*)(F.ws + WS_SW);
    unsigned* gcnt = F.ctl + CW_MOECNT;
    for (int blk = F.bid; blk < T / 128; blk += F.G) {
        if (F.tid < 16) lcnt[F.tid] = 0;
        __syncthreads();
        for (int rr = 0; rr < 16; ++rr) {
            const int rl = F.wave * 16 + rr, m = blk * 128 + rl;
            f32x4 v[4]; norm_row(x + (size_t)m * D, g, H + (size_t)m * D, v, F.lane);
            float lg[8];
#pragma unroll
            for (int e = 0; e < 8; ++e) lg[e] = 0.f;
#pragma unroll
            for (int q = 0; q < 4; ++q)
#pragma unroll
                for (int c = 0; c < 4; ++c) { const int k = 4 * (F.lane + 64 * q) + c; const f32x4 w0 = *(const LAS f32x4*)(WR + k * 8), w1 = *(const LAS f32x4*)(WR + k * 8 + 4); const float hv = v[q][c];
                    lg[0] += hv * w0.x; lg[1] += hv * w0.y; lg[2] += hv * w0.z; lg[3] += hv * w0.w; lg[4] += hv * w1.x; lg[5] += hv * w1.y; lg[6] += hv * w1.z; lg[7] += hv * w1.w; }
#pragma unroll
            for (int e = 0; e < 8; ++e) lg[e] = wave_sum(lg[e]);
            if (F.lane == 0) {
                int e1 = 0; float l1 = lg[0];
#pragma unroll
                for (int e = 1; e < 8; ++e) if (lg[e] > l1) { l1 = lg[e]; e1 = e; }
                int e2 = -1; float l2 = -3.0e38f;
#pragma unroll
                for (int e = 0; e < 8; ++e) if (e != e1 && lg[e] > l2) { l2 = lg[e]; e2 = e; }
                const float w1 = 1.0f / (1.0f + __expf(l2 - l1));
                rE[rl] = e1 | (e2 << 8); rW[rl] = w1;
                rP1[rl] = __hip_atomic_fetch_add(lcnt + e1, 1, __ATOMIC_RELAXED, __HIP_MEMORY_SCOPE_WORKGROUP);
                rP2[rl] = __hip_atomic_fetch_add(lcnt + 8 + e2, 1, __ATOMIC_RELAXED, __HIP_MEMORY_SCOPE_WORKGROUP);
            }
        }
        __syncthreads();
        if (F.tid < 16) lbase[F.tid] = (int)__hip_atomic_fetch_add(gcnt + F.tid, (unsigned)lcnt[F.tid], __ATOMIC_RELAXED, __HIP_MEMORY_SCOPE_AGENT);
        __syncthreads();
        if (F.tid < 128) { const int m = blk * 128 + F.tid, e1 = rE[F.tid] & 255, e2 = rE[F.tid] >> 8; const float w1 = rW[F.tid];
            const int s1 = e1 * T + lbase[e1] + rP1[F.tid], s2 = (8 + e2) * T + lbase[8 + e2] + rP2[F.tid];
            stok[s1] = m; sw[s1] = w1; stok[s2] = m; sw[s2] = 1.0f - w1; }
        __syncthreads();
    }
}
__device__ __forceinline__ void final_norm_phase(const Frame& F0, float* x, const float* gain) { Frame F = opq(F0);
    const int gw = F.bid * NWAVES + F.wave, NGW = F.G * NWAVES;
    f32x4 g[4];
#pragma unroll
    for (int q = 0; q < 4; ++q) g[q] = ((const f32x4*)gain)[F.lane + 64 * q];
    for (int m = gw; m < T; m += NGW) {
        f32x4* xr = (f32x4*)(x + (size_t)m * D) + F.lane; f32x4 v[4]; float s = 0.f;
#pragma unroll
        for (int j = 0; j < 4; ++j) { v[j] = xr[64 * j]; s += (v[j].x * v[j].x + v[j].y * v[j].y) + (v[j].z * v[j].z + v[j].w * v[j].w); }
        const float r = 1.0f / sqrtf(wave_sum(s) * (1.f / D) + EPS);
#pragma unroll
        for (int j = 0; j < 4; ++j) xr[64 * j] = v[j] * r * g[j];
    }
}

constexpr int LD = 68;
constexpr int MATF = 64 * LD;

__device__ __forceinline__ void ld8(const bf16* p, float (&o)[8]) { const u32x4 w = *(const u32x4*)p; o[0] = bflo(w.x); o[1] = bfhi(w.x); o[2] = bflo(w.y); o[3] = bfhi(w.y); o[4] = bflo(w.z); o[5] = bfhi(w.z); o[6] = bflo(w.w); o[7] = bfhi(w.w); }

__device__ __forceinline__ void conv8(const bf16* PROJ, int b, int tpos  , int col, const float* cw, int cwld, int c0, float (&y)[8]) {
#pragma unroll
    for (int e = 0; e < 8; ++e) y[e] = 0.f;
#pragma unroll
    for (int j = 0; j < 4; ++j) { const int tp = tpos - 3 + j;
        if (tp >= 0) { float xv[8]; ld8(PROJ + (size_t)(b * SEQ + tp) * PP + col, xv);
            const f32x4 w0 = *(const f32x4*)(cw + j * cwld + c0), w1 = *(const f32x4*)(cw + j * cwld + c0 + 4);
            y[0] += xv[0] * w0.x; y[1] += xv[1] * w0.y; y[2] += xv[2] * w0.z; y[3] += xv[3] * w0.w; y[4] += xv[4] * w1.x; y[5] += xv[5] * w1.y; y[6] += xv[6] * w1.z; y[7] += xv[7] * w1.w; } }
}

__device__ __forceinline__ void conv8r(const u32x4 (&r)[4], const float* cw, int cwld, int c0, float (&y)[8]) {
#pragma unroll
    for (int e = 0; e < 8; ++e) y[e] = 0.f;
#pragma unroll
    for (int j = 0; j < 4; ++j) { const u32x4 w = r[j]; const float xv[8] = {bflo(w.x), bfhi(w.x), bflo(w.y), bfhi(w.y), bflo(w.z), bfhi(w.z), bflo(w.w), bfhi(w.w)};
        const f32x4 w0 = *(const f32x4*)(cw + j * cwld + c0), w1 = *(const f32x4*)(cw + j * cwld + c0 + 4);
        y[0] += xv[0] * w0.x; y[1] += xv[1] * w0.y; y[2] += xv[2] * w0.z; y[3] += xv[3] * w0.w; y[4] += xv[4] * w1.x; y[5] += xv[5] * w1.y; y[6] += xv[6] * w1.z; y[7] += xv[7] * w1.w; }
}
__device__ __forceinline__ void fetch_rows(const bf16* PROJ, int b, int tpos, int col, u32x4 (&r)[4]) {
#pragma unroll
    for (int j = 0; j < 4; ++j) { const int tp = tpos - 3 + j; r[j] = tp >= 0 ? *(const u32x4*)(PROJ + (size_t)(b * SEQ + tp) * PP + col) : (u32x4){0u, 0u, 0u, 0u}; }
}
__device__ __forceinline__ void gdn_fetch(const Frame& F, int b, int n, int h, u32x4 (&rows)[3][4]) {
    const bf16* PROJ = (const bf16*)(F.ws + WS_PROJ);
#pragma unroll
    for (int i = 0; i < 3; ++i) { const int u = F.tid + NTHR * i, grp = u % 24, t = u / 24; fetch_rows(PROJ, b, n * CH + t, (grp >> 3) * 256 + h * 64 + (grp & 7) * 8, rows[i]); }
}
__device__ __forceinline__ void rg_fetch(const Frame& F, int b, int n, int nb, u32x4 (&rows)[4]) {
    fetch_rows((const bf16*)(F.ws + WS_PROJ), b, n * CH + (F.tid >> 3), XC + nb * 64 + 8 * (F.tid & 7), rows);
}
struct GlaIn { u32x4 v, qk; f32x4 lr; };
__device__ __forceinline__ void gla_fetch(const Frame& F, int b, int n, int h, GlaIn& g) {
    const bf16* PROJ = (const bf16*)(F.ws + WS_PROJ); const float* SM = (const float*)(F.ws + WS_SMALL);
    const int tok0 = b * SEQ + n * CH, t = F.tid >> 3, p = F.tid & 7;
    g.v = *(const u32x4*)(PROJ + (size_t)(tok0 + t) * PP + VD + h * 64 + 8 * p);
    g.qk = *(const u32x4*)(PROJ + (size_t)(tok0 + t) * PP + (p < 4 ? QD + h * 32 + 8 * p : KD + h * 32 + 8 * (p - 4)));
    g.lr = F.tid < 256 ? *(const f32x4*)(SM + (size_t)(tok0 + (F.tid >> 2)) * 32 + 8 + 4 * (F.tid & 3)) : (f32x4){0.f, 0.f, 0.f, 0.f};
}
__device__ __forceinline__ void unpack8(const u32x4 w, float (&o)[8]) { o[0] = bflo(w.x); o[1] = bfhi(w.x); o[2] = bflo(w.y); o[3] = bfhi(w.y); o[4] = bflo(w.z); o[5] = bfhi(w.z); o[6] = bflo(w.w); o[7] = bfhi(w.w); }

__device__ __forceinline__ void gdn_prep(const Frame& F0, int l, int b, int n, int h, const u32x4 (&rows)[3][4]) { Frame F = opq(F0);
    LAS float* Q = (LAS float*)F.lds; LAS float* Kk = Q + MATF; LAS float* UT = Kk + MATF; LAS float* WT = UT + MATF; LAS float* A = WT + MATF; LAS float* AQ = A + MATF; LAS float* KDT = AQ + MATF;
    LAS float* sBeta = KDT + MATF; LAS float* sG = sBeta + 64;
    const float* SM = (const float*)(F.ws + WS_SMALL);
    const float* cw = F.in[3] + (size_t)l * 4 * 768;
    const int tok0 = b * SEQ + n * CH, ch = ((b * NCH + n) * 4 + h);
#pragma unroll
    for (int i = 0; i < 3; ++i) { const int u = F.tid + NTHR * i, grp = u % 24, t = u / 24, which = grp >> 3, d0 = (grp & 7) * 8, c0 = which * 256 + h * 64 + d0;
        float y[8]; conv8r(rows[i], cw, 768, c0, y);
        if (which < 2) { LAS float* dst = (which == 0 ? Q : Kk) + t * LD + d0;
            *(LAS f32x4*)dst = (f32x4){siluf_(y[0]), siluf_(y[1]), siluf_(y[2]), siluf_(y[3])}; *(LAS f32x4*)(dst + 4) = (f32x4){siluf_(y[4]), siluf_(y[5]), siluf_(y[6]), siluf_(y[7])}; }
        else {
#pragma unroll
            for (int e = 0; e < 8; ++e) UT[(d0 + e) * LD + t] = siluf_(y[e]); } }
    if (F.wave == 0) { const int t = F.lane; const float bl = SM[(size_t)(tok0 + t) * 32 + h], al = SM[(size_t)(tok0 + t) * 32 + 4 + h];
        float g = -__expf(F.in[4][l * 4 + h]) * softplusf_(al + F.in[5][l * 4 + h]);
#pragma unroll
        for (int o = 1; o < 64; o <<= 1) { const float up = __shfl_up(g, o); if (t >= o) g += up; }
        sBeta[t] = sigmoidf_(bl); sG[t] = g; }
    __syncthreads();
    { const int t = F.tid >> 3, p = F.tid & 7; LAS float* qp = Q + t * LD + 8 * p; LAS float* kp = Kk + t * LD + 8 * p;
        f32x4 q0 = *(LAS f32x4*)qp, q1 = *(LAS f32x4*)(qp + 4), k0 = *(LAS f32x4*)kp, k1 = *(LAS f32x4*)(kp + 4);
        float sq = (q0.x * q0.x + q0.y * q0.y) + (q0.z * q0.z + q0.w * q0.w) + (q1.x * q1.x + q1.y * q1.y) + (q1.z * q1.z + q1.w * q1.w);
        float sk = (k0.x * k0.x + k0.y * k0.y) + (k0.z * k0.z + k0.w * k0.w) + (k1.x * k1.x + k1.y * k1.y) + (k1.z * k1.z + k1.w * k1.w);
#pragma unroll
        for (int o = 1; o < 8; o <<= 1) { sq += __shfl_xor(sq, o); sk += __shfl_xor(sk, o); }
        const float rq = 0.125f / sqrtf(sq + EPS), rk = 1.0f / sqrtf(sk + EPS), be = sBeta[t], eg = __expf(sG[t]);
        q0 = q0 * rq; q1 = q1 * rq; k0 = k0 * rk; k1 = k1 * rk;
        *(LAS f32x4*)qp = q0; *(LAS f32x4*)(qp + 4) = q1; *(LAS f32x4*)kp = k0; *(LAS f32x4*)(kp + 4) = k1;
        const float kw[8] = {k0.x, k0.y, k0.z, k0.w, k1.x, k1.y, k1.z, k1.w};
#pragma unroll
        for (int e = 0; e < 8; ++e) { WT[(8 * p + e) * LD + t] = kw[e] * (be * eg); UT[(8 * p + e) * LD + t] *= be; } }
    __syncthreads();
    { const int lr = F.lane & 15, lg = F.lane >> 4;
        for (int tl = F.wave; tl < 32; tl += NWAVES) { const int mat = tl >> 4, mi = (tl >> 2) & 3, ni = tl & 3; LAS float* dst = mat ? AQ : A;
            f32x4 acc = (f32x4){0.f, 0.f, 0.f, 0.f};
            if (mi >= ni) acc = mm16b<false, true>(mat ? Q : Kk, LD, Kk, LD, 16 * mi, 16 * ni, 64, acc, F.lane);
#pragma unroll
            for (int r = 0; r < 4; ++r) { const int i = 16 * mi + 4 * lg + r, j = 16 * ni + lr; float v = 0.f;
                if (mat ? (i >= j) : (i > j)) v = acc[r] * __expf(sG[i] - sG[j]) * (mat ? 1.0f : sBeta[i]);
                dst[i * LD + j] = v; } } }
    __syncthreads();
    { LAS float* TI = sG + 64; constexpr int TLD = 20;
        if (F.wave == 0) { const int blk = F.lane >> 4, c = F.lane & 15; float x[16];
#pragma unroll
            for (int r = 0; r < 16; ++r) { float v = (r == c) ? 1.0f : 0.0f;
#pragma unroll
                for (int c2 = 0; c2 < r; ++c2) v -= A[(16 * blk + r) * LD + 16 * blk + c2] * x[c2];
                x[r] = v; TI[(blk * 16 + r) * TLD + c] = v; } }
        __syncthreads();
        LAS float* XT = F.wave < 4 ? UT : WT; const int j0 = 16 * (F.wave & 3), lr = F.lane & 15, lg = F.lane >> 4;
        for (int bi = 0; bi < 4; ++bi) { LAS f32x4* xp = (LAS f32x4*)(XT + (j0 + lr) * LD + 16 * bi + 4 * lg);
            if (bi > 0) { const f32x4 acc = mm16b<false, true>(A, LD, XT, LD, 16 * bi, j0, 16 * bi, (f32x4){0.f, 0.f, 0.f, 0.f}, F.lane); *xp = *xp - acc; }
            const f32x4 xs = mm16b<false, true>(TI + bi * 16 * TLD, TLD, XT + 16 * bi, LD, 0, j0, 16, (f32x4){0.f, 0.f, 0.f, 0.f}, F.lane);
            *xp = xs; }
        __syncthreads(); }
    { const int t = F.tid >> 3, p = F.tid & 7; const float gl = sG[63], gt = sG[t], e1 = __expf(gl - gt), e2 = __expf(gt);
        LAS float* qp = Q + t * LD + 8 * p; const LAS float* kp = Kk + t * LD + 8 * p;
        *(LAS f32x4*)qp = *(LAS f32x4*)qp * e2; *(LAS f32x4*)(qp + 4) = *(LAS f32x4*)(qp + 4) * e2;
        const f32x4 k0 = *(const LAS f32x4*)kp, k1 = *(const LAS f32x4*)(kp + 4); const float kw[8] = {k0.x, k0.y, k0.z, k0.w, k1.x, k1.y, k1.z, k1.w};
#pragma unroll
        for (int e = 0; e < 8; ++e) KDT[(8 * p + e) * LD + t] = kw[e] * e1; }
    __syncthreads();
    { const int lr = F.lane & 15, lg = F.lane >> 4; const float dl = __expf(sG[63]);
        float* GM = (float*)(F.ws + WS_GM) + (size_t)ch * 4096; float* GN = (float*)(F.ws + WS_GN) + (size_t)ch * 4096;
        float* GQ = (float*)(F.ws + WS_GQ) + (size_t)ch * 4096; float* GO = (float*)(F.ws + WS_GO) + (size_t)ch * 4096;
        for (int tl = F.wave; tl < 16; tl += NWAVES) { const int mi = tl >> 2, ni = tl & 3;
            const f32x4 acc = mm16b<false, true>(KDT, LD, WT, LD, 16 * mi, 16 * ni, 64, (f32x4){0.f, 0.f, 0.f, 0.f}, F.lane);
#pragma unroll
            for (int r = 0; r < 4; ++r) { const int i = 16 * mi + 4 * lg + r, j = 16 * ni + lr, ks = j >> 2; const float v = (i == j ? dl : 0.f) - acc[r];
                GM[((mi * 4 + (ks >> 2)) * 64 + (i & 15) + 16 * (j & 3)) * 4 + (ks & 3)] = v; } }
        for (int tl = F.wave; tl < 16; tl += NWAVES) { const int mi = tl >> 2, ni = tl & 3;
            const f32x4 acc = mm16b<false, true>(KDT, LD, UT, LD, 16 * mi, 16 * ni, 64, (f32x4){0.f, 0.f, 0.f, 0.f}, F.lane);
#pragma unroll
            for (int r = 0; r < 4; ++r) GN[(16 * mi + 4 * lg + r) * 64 + 16 * ni + lr] = acc[r]; }
        for (int tl = F.wave; tl < 16; tl += NWAVES) { const int mi = tl >> 2, ni = tl & 3;
            const f32x4 acc = mm16b<false, true>(AQ, LD, WT, LD, 16 * mi, 16 * ni, 64, (f32x4){0.f, 0.f, 0.f, 0.f}, F.lane);
#pragma unroll
            for (int r = 0; r < 4; ++r) { const int i = 16 * mi + 4 * lg + r, j = 16 * ni + lr; GQ[i * 64 + j] = Q[i * LD + j] - acc[r]; } }
        for (int tl = F.wave; tl < 16; tl += NWAVES) { const int mi = tl >> 2, ni = tl & 3;
            const f32x4 acc = mm16b<false, true>(AQ, LD, UT, LD, 16 * mi, 16 * ni, 64, (f32x4){0.f, 0.f, 0.f, 0.f}, F.lane);
#pragma unroll
            for (int r = 0; r < 4; ++r) GO[(16 * mi + 4 * lg + r) * 64 + 16 * ni + lr] = acc[r]; } }
    __syncthreads();
}

__device__ __forceinline__ void gla_prep(const Frame& F0, int l, int b, int n, int h, const GlaIn& gin, bool load_w) { Frame F = opq(F0);
    constexpr int L3 = 36;
    LAS float* QE = (LAS float*)F.lds; LAS float* KE = QE + 64 * L3; LAS float* KDm = KE + 64 * L3; LAS float* Gm = KDm + 64 * L3; LAS float* V = Gm + 64 * L3; LAS float* AIN = V + MATF;
    LAS float* LR = AIN + MATF; LAS float* WL = LR + 64 * 16; LAS float* Qr = WL + 16 * 32; LAS float* Kr = Qr + 64 * L3;
    const bf16* PROJ = (const bf16*)(F.ws + WS_PROJ); const float* SM = (const float*)(F.ws + WS_SMALL);
    const int tok0 = b * SEQ + n * CH, ch = ((b * NCH + n) * 4 + h);
    { const int t = F.tid >> 3, p = F.tid & 7; float xv[8];
        unpack8(gin.v, xv);
        *(LAS f32x4*)(V + t * LD + 8 * p) = (f32x4){xv[0], xv[1], xv[2], xv[3]}; *(LAS f32x4*)(V + t * LD + 8 * p + 4) = (f32x4){xv[4], xv[5], xv[6], xv[7]};
        unpack8(gin.qk, xv);
        { LAS float* dst = (p < 4 ? Qr : Kr) + t * L3 + 8 * (p & 3); *(LAS f32x4*)dst = (f32x4){xv[0], xv[1], xv[2], xv[3]}; *(LAS f32x4*)(dst + 4) = (f32x4){xv[4], xv[5], xv[6], xv[7]}; }
        if (F.tid < 256) { const int t2 = F.tid >> 2, q4 = F.tid & 3; *(LAS f32x4*)(LR + t2 * 16 + 4 * q4) = gin.lr; }
        if (load_w) { const int r = F.tid >> 5, d = F.tid & 31; WL[r * 32 + d] = F.in[17][(size_t)l * 16 * 128 + r * 128 + h * 32 + d]; } }
    __syncthreads();
    { const int t = F.lane;
#pragma unroll
        for (int c = 0; c < 4; ++c) { const int d = F.wave * 4 + c; float s = F.in[18][l * 128 + h * 32 + d];
#pragma unroll
            for (int r = 0; r < 16; ++r) s += LR[t * 16 + r] * WL[r * 32 + d];
            float la = -softplusf_(-s) * (1.0f / 16.0f);
#pragma unroll
            for (int o = 1; o < 64; o <<= 1) { const float up = __shfl_up(la, o); if (t >= o) la += up; }
            Gm[t * L3 + d] = la; } }
    __syncthreads();
    { float* LQG = (float*)(F.ws + WS_LQG) + (size_t)ch * 2048; float* LDL = (float*)(F.ws + WS_LDL) + (size_t)ch * 32;
        const float sc = 0.17677669529663687f;
        for (int u = F.tid; u < 2048; u += NTHR) { const int t = u >> 5, d = u & 31; const float G = Gm[t * L3 + d], Gr = Gm[32 * L3 + d], Gl = Gm[63 * L3 + d];
            const float q = Qr[t * L3 + d] * sc, k = Kr[t * L3 + d];
            QE[t * L3 + d] = q * __expf(G - Gr); KE[t * L3 + d] = k * __expf(Gr - G); KDm[t * L3 + d] = k * __expf(Gl - G);
            LQG[t * 32 + d] = q * __expf(G); if (t == 63) LDL[d] = __expf(Gl); } }
    __syncthreads();
    { const int lr = F.lane & 15, lg = F.lane >> 4;
        for (int tl = F.wave; tl < 16; tl += NWAVES) { const int mi = tl >> 2, ni = tl & 3; f32x4 acc = (f32x4){0.f, 0.f, 0.f, 0.f};
            if (mi >= ni) acc = mm16b<false, true>(QE, L3, KE, L3, 16 * mi, 16 * ni, 32, acc, F.lane);
#pragma unroll
            for (int r = 0; r < 4; ++r) { const int i = 16 * mi + 4 * lg + r, j = 16 * ni + lr; AIN[i * LD + j] = (i >= j) ? acc[r] : 0.f; } } }
    __syncthreads();
    { const int lr = F.lane & 15, lg = F.lane >> 4; float* LOI = (float*)(F.ws + WS_LOI) + (size_t)ch * 4096; float* LKV = (float*)(F.ws + WS_LKV) + (size_t)ch * 2048;
        for (int tl = F.wave; tl < 16; tl += NWAVES) { const int mi = tl >> 2, ni = tl & 3;
            const f32x4 acc = mm16b<false, false>(AIN, LD, V, LD, 16 * mi, 16 * ni, 64, (f32x4){0.f, 0.f, 0.f, 0.f}, F.lane);
#pragma unroll
            for (int r = 0; r < 4; ++r) LOI[(16 * mi + 4 * lg + r) * 64 + 16 * ni + lr] = acc[r]; }
        { const int mi = F.wave >> 2, ni = F.wave & 3;
            const f32x4 acc = mm16b<true, false>(KDm, L3, V, LD, 16 * mi, 16 * ni, 64, (f32x4){0.f, 0.f, 0.f, 0.f}, F.lane);
#pragma unroll
            for (int r = 0; r < 4; ++r) LKV[(16 * mi + 4 * lg + r) * 64 + 16 * ni + lr] = acc[r]; } }
    __syncthreads();
}

__device__ __forceinline__ void rg_prep(const Frame& F0, int l, int b, int n, int nb, const u32x4 (&rows)[4], bool load_w) { Frame F = opq(F0);
    LAS float* XCm = (LAS float*)F.lds; LAS float* WA = XCm + MATF; LAS float* WX = WA + MATF; LAS float* AA = WX + MATF; LAS float* segA = AA + MATF; LAS float* segH = segA + 512;
    const bf16* PROJ = (const bf16*)(F.ws + WS_PROJ);
    const int tok0 = b * SEQ + n * CH;
    { const int t = F.tid >> 3, p = F.tid & 7, c0 = nb * 64 + 8 * p; float y[8];
        conv8r(rows, F.in[10] + (size_t)l * 4 * 256, 256, c0, y);
        const float* cb = F.in[11] + l * 256 + c0;
        *(LAS f32x4*)(XCm + t * LD + 8 * p) = (f32x4){y[0] + cb[0], y[1] + cb[1], y[2] + cb[2], y[3] + cb[3]}; *(LAS f32x4*)(XCm + t * LD + 8 * p + 4) = (f32x4){y[4] + cb[4], y[5] + cb[5], y[6] + cb[6], y[7] + cb[7]};
        const float* wa = F.in[12] + ((size_t)l * 4 + nb) * 4096; const float* wx = F.in[14] + ((size_t)l * 4 + nb) * 4096;
        if (load_w)
#pragma unroll
        for (int i = 0; i < 2; ++i) { const int e = F.tid + NTHR * i, r = e >> 4, c4 = (e & 15) * 4;
            *(LAS f32x4*)(WA + r * LD + c4) = *(const f32x4*)(wa + r * 64 + c4); *(LAS f32x4*)(WX + r * LD + c4) = *(const f32x4*)(wx + r * 64 + c4); } }
    __syncthreads();
    { const int lr = F.lane & 15, lg = F.lane >> 4; f32x4 ga[2], gx[2];
#pragma unroll
        for (int q = 0; q < 2; ++q) { const int tl = F.wave + 8 * q, mi = tl >> 2, ni = tl & 3;
            ga[q] = mm16b<false, false>(XCm, LD, WA, LD, 16 * mi, 16 * ni, 64, (f32x4){0.f, 0.f, 0.f, 0.f}, F.lane);
            gx[q] = mm16b<false, false>(XCm, LD, WX, LD, 16 * mi, 16 * ni, 64, (f32x4){0.f, 0.f, 0.f, 0.f}, F.lane); }
        __syncthreads();
#pragma unroll
        for (int q = 0; q < 2; ++q) { const int tl = F.wave + 8 * q, mi = tl >> 2, ni = tl & 3, j = 16 * ni + lr, cg = nb * 64 + j;
            const float ba = F.in[13][l * 256 + cg], bx = F.in[15][l * 256 + cg], sp = softplusf_(F.in[16][l * 256 + cg]);
#pragma unroll
            for (int r = 0; r < 4; ++r) { const int i = 16 * mi + 4 * lg + r; const float la = -8.0f * sigmoidf_(ga[q][r] + ba) * sp, a = __expf(la);
                const float mult = sqrtf(fmaxf(-expm1f(2.0f * la), 0.f)); const float xc = XCm[i * LD + j];
                AA[i * LD + j] = a; XCm[i * LD + j] = xc * sigmoidf_(gx[q][r] + bx) * mult; } } }
    __syncthreads();
    { const int c = F.tid & 63, sg = F.tid >> 6; float hh = 0.f, pp = 1.f; float hl[8], pl[8];
#pragma unroll
        for (int tt = 0; tt < 8; ++tt) { const int t = 8 * sg + tt; const float a = AA[t * LD + c], u = XCm[t * LD + c]; hh = a * hh + u; pp = pp * a; hl[tt] = hh; pl[tt] = pp; }
        segA[sg * 64 + c] = pp; segH[sg * 64 + c] = hh;
        __syncthreads();
        float hin = 0.f, pin = 1.f;
        for (int s2 = 0; s2 < sg; ++s2) { const float a = segA[s2 * 64 + c]; hin = a * hin + segH[s2 * 64 + c]; pin *= a; }
        bf16* RHL = (bf16*)(F.ws + WS_RHL); bf16* RP = (bf16*)(F.ws + WS_RP);
#pragma unroll
        for (int tt = 0; tt < 8; ++tt) { const int t = 8 * sg + tt; const float hv = hl[tt] + pl[tt] * hin, pv = pl[tt] * pin;
            RHL[(size_t)(tok0 + t) * 256 + nb * 64 + c] = (bf16)f2bf(hv); RP[(size_t)(tok0 + t) * 256 + nb * 64 + c] = (bf16)f2bf(pv);
            if (t == 63) { ((float*)(F.ws + WS_RAT))[(b * NCH + n) * 256 + nb * 64 + c] = pv; ((float*)(F.ws + WS_RHE))[(b * NCH + n) * 256 + nb * 64 + c] = hv; } } }
    __syncthreads();
}
__device__ __forceinline__ void prep_phase(Frame& F, int l) {
    { u32x4 nx[3][4]; int idx = F.bid;
        if (idx < 2048) gdn_fetch(F, (idx >> 2) >> 6, (idx >> 2) & 63, idx & 3, nx);
        for (; idx < 2048; idx += F.G) { u32x4 cur[3][4];
#pragma unroll
            for (int i = 0; i < 3; ++i)
#pragma unroll
                for (int j = 0; j < 4; ++j) cur[i][j] = nx[i][j];
            const int ni = idx + F.G; if (ni < 2048) gdn_fetch(F, (ni >> 2) >> 6, (ni >> 2) & 63, ni & 3, nx);
            gdn_prep(F, l, (idx >> 2) >> 6, (idx >> 2) & 63, idx & 3, cur); } }
    { GlaIn nx; int idx = F.bid, hw = -1;
        if (idx < 2048) gla_fetch(F, (idx >> 2) >> 6, (idx >> 2) & 63, idx & 3, nx);
        for (; idx < 2048; idx += F.G) { const GlaIn cur = nx;
            const int ni = idx + F.G; if (ni < 2048) gla_fetch(F, (ni >> 2) >> 6, (ni >> 2) & 63, ni & 3, nx);
            gla_prep(F, l, (idx >> 2) >> 6, (idx >> 2) & 63, idx & 3, cur, (idx & 3) != hw); hw = idx & 3; } }
    { u32x4 nx[4]; int idx = F.bid, bw = -1;
        if (idx < 2048) rg_fetch(F, (idx >> 2) >> 6, (idx >> 2) & 63, idx & 3, nx);
        for (; idx < 2048; idx += F.G) { u32x4 cur[4];
#pragma unroll
            for (int j = 0; j < 4; ++j) cur[j] = nx[j];
            const int ni = idx + F.G; if (ni < 2048) rg_fetch(F, (ni >> 2) >> 6, (ni >> 2) & 63, ni & 3, nx);
            rg_prep(F, l, (idx >> 2) >> 6, (idx >> 2) & 63, idx & 3, cur, (idx & 3) != bw); bw = idx & 3; } }
}

__device__ __forceinline__ f32x16 mfma32(bf16x8 a, bf16x8 b, f32x16 c) { return __builtin_amdgcn_mfma_f32_32x32x16_bf16(a, b, c, 0, 0, 0); }
typedef short v4i16_t __attribute__((ext_vector_type(4)));
__device__ __forceinline__ s16x4 vtr(const LAS unsigned char* p) { return __builtin_bit_cast(s16x4, __builtin_amdgcn_ds_read_tr16_b64_v4i16((LAS v4i16_t*)p)); }

__device__ __forceinline__ void attn_item(const Frame& F0, int l, int b, int h, int qb) { Frame F = opq(F0);
    constexpr int KP = 144, KT_BYTES = 64 * KP;
    LAS unsigned char* Kt = F.lds; LAS unsigned char* Vt = F.lds + 2 * KT_BYTES;
    LAS float* LUT = (LAS float*)(F.lds + 4 * KT_BYTES); LAS float* sLam = LUT + 256;
    const bf16* PROJ = (const bf16*)(F.ws + WS_PROJ); bf16* MIX = (bf16*)(F.ws + WS_HM);
    const float lam_init = l == 0 ? 0.2f : 0.35550906759096926f;
    if (F.tid < 256) { const int delta = F.tid - 191, na = delta < 0 ? -delta : delta;
        int bk = na < 8 ? na : na < 12 ? 8 : na < 16 ? 9 : na < 23 ? 10 : na < 32 ? 11 : na < 46 ? 12 : na < 64 ? 13 : na < 91 ? 14 : 15;
        if (delta > 0) bk += 16;
        LUT[F.tid] = F.in[9][bk * 4 + h] * LOG2E; }
    if (F.wave == 4) { const float* lv = F.in[7] + l * 128; const int i = F.lane & 31;
        float p = F.lane < 32 ? lv[i] * lv[32 + i] : lv[64 + i] * lv[96 + i];
#pragma unroll
        for (int o = 1; o < 32; o <<= 1) p += __shfl_xor(p, o);
        const float e = __expf(p), e2 = __shfl_xor(e, 32);
        if (F.lane == 0) sLam[0] = e - e2 + lam_init; }
    __syncthreads();
    const float lam = sLam[0];
    const int w = F.wave, cq = qb * 4 + (w >> 1), r32 = F.lane & 31, hh = F.lane >> 5, qoff = 32 * (w & 1) + r32;
    const size_t t0 = (size_t)b * SEQ + qb * 256 + 32 * w + r32;
    bf16x8 qf[2][2];
#pragma unroll
    for (int c = 0; c < 2; ++c)
#pragma unroll
        for (int s = 0; s < 2; ++s) qf[c][s] = *(const bf16x8*)(PROJ + t0 * PP + QB + h * 64 + c * 32 + 16 * s + 8 * hh);
    f32x16 O[2][2]; float mrun[2], lrun[2];
#pragma unroll
    for (int c = 0; c < 2; ++c) { mrun[c] = -1.0e30f; lrun[c] = 0.f;
#pragma unroll
        for (int mt = 0; mt < 2; ++mt)
#pragma unroll
            for (int i = 0; i < 16; ++i) O[c][mt][i] = 0.f; }
    const int skey = F.tid >> 3, sseg = F.tid & 7, ntile = 4 * qb + 4;
    const bf16* kg = PROJ + ((size_t)b * SEQ + skey) * PP + KB + h * 64 + sseg * 8; const bf16* vg = PROJ + ((size_t)b * SEQ + skey) * PP + VB + h * 64 + sseg * 8;
    u32x4 kreg = *(const u32x4*)kg, vreg = *(const u32x4*)vg;
    const float SC = 0.17677669529663687f * LOG2E;
    for (int kt = 0; kt < ntile; ++kt) {
        const int buf = kt & 1;
        *(LAS u32x4*)(Kt + buf * KT_BYTES + skey * KP + sseg * 16) = kreg; *(LAS u32x4*)(Vt + buf * KT_BYTES + skey * KP + sseg * 16) = vreg;
        __syncthreads();
        if (kt + 1 < ntile) { kreg = *(const u32x4*)(kg + (size_t)(kt + 1) * 64 * PP); vreg = *(const u32x4*)(vg + (size_t)(kt + 1) * 64 * PP); }
        if (kt <= cq) {
            const bool far = kt + 3 <= cq; const float c15 = LUT[0];
            const LAS unsigned char* Kb = Kt + buf * KT_BYTES; const LAS unsigned char* Vb = Vt + buf * KT_BYTES;
#pragma unroll
            for (int kb = 0; kb < 2; ++kb) {
                f32x16 S[2];
#pragma unroll
                for (int c = 0; c < 2; ++c) { f32x16 z;
#pragma unroll
                    for (int i = 0; i < 16; ++i) z[i] = 0.f;
                    const bf16x8 k0 = *(const LAS bf16x8*)(Kb + (32 * kb + r32) * KP + (c * 32 + 8 * hh) * 2), k1 = *(const LAS bf16x8*)(Kb + (32 * kb + r32) * KP + (c * 32 + 16 + 8 * hh) * 2);
                    z = mfma32(k0, qf[c][0], z); S[c] = mfma32(k1, qf[c][1], z); }
                float bias[16];
#pragma unroll
                for (int i = 0; i < 16; ++i) { if (far) bias[i] = c15; else { const int krow = 32 * kb + (i & 3) + 8 * (i >> 2) + 4 * hh; bias[i] = LUT[(kt - cq) * 64 + krow - qoff + 191]; } }
                bf16x8 pb[2][2];
#pragma unroll
                for (int c = 0; c < 2; ++c) {
                    float mx = -1.0e30f;
#pragma unroll
                    for (int i = 0; i < 16; ++i) { S[c][i] = S[c][i] * SC + bias[i]; mx = fmaxf(mx, S[c][i]); }
                    mx = fmaxf(mx, __shfl_xor(mx, 32));
                    if (__any(mx > mrun[c] + 8.0f)) {
                        const float mn = fmaxf(mrun[c], mx), alpha = __builtin_amdgcn_exp2f(mrun[c] - mn); mrun[c] = mn; lrun[c] *= alpha;
#pragma unroll
                        for (int mt = 0; mt < 2; ++mt)
#pragma unroll
                            for (int i = 0; i < 16; ++i) O[c][mt][i] *= alpha; }
                    const float mr = mrun[c]; float ps = 0.f;
#pragma unroll
                    for (int i = 0; i < 16; ++i) { S[c][i] = __builtin_amdgcn_exp2f(S[c][i] - mr); ps += S[c][i]; }
                    lrun[c] += ps;
#pragma unroll
                    for (int s = 0; s < 2; ++s) { u32x4 pw; pw.x = pg8::cvt_pk_bf16(S[c][8 * s + 0], S[c][8 * s + 1]); pw.y = pg8::cvt_pk_bf16(S[c][8 * s + 2], S[c][8 * s + 3]); pw.z = pg8::cvt_pk_bf16(S[c][8 * s + 4], S[c][8 * s + 5]); pw.w = pg8::cvt_pk_bf16(S[c][8 * s + 6], S[c][8 * s + 7]);
                        pb[c][s] = __builtin_bit_cast(bf16x8, pw); }
                }
#pragma unroll
                for (int mt = 0; mt < 2; ++mt)
#pragma unroll
                    for (int s = 0; s < 2; ++s) {
                        const LAS unsigned char* vp = Vb + (32 * kb + 16 * s + 4 * hh + ((F.lane & 15) >> 2)) * KP + (32 * mt + 16 * ((F.lane >> 4) & 1) + 4 * (F.lane & 3)) * 2;
                        const s16x4 v0 = vtr(vp), v1 = vtr(vp + 8 * KP);
                        bf16x8 vf; vf[0] = v0[0]; vf[1] = v0[1]; vf[2] = v0[2]; vf[3] = v0[3]; vf[4] = v1[0]; vf[5] = v1[1]; vf[6] = v1[2]; vf[7] = v1[3];
                        O[0][mt] = mfma32(vf, pb[0][s], O[0][mt]); O[1][mt] = mfma32(vf, pb[1][s], O[1][mt]); }
            }
        }
    }
    { const float i0 = 1.0f / (lrun[0] + __shfl_xor(lrun[0], 32)), i1 = lam / (lrun[1] + __shfl_xor(lrun[1], 32));
        float ss = 0.f;
#pragma unroll
        for (int mt = 0; mt < 2; ++mt)
#pragma unroll
            for (int i = 0; i < 16; ++i) { const float a = O[0][mt][i] * i0 - O[1][mt][i] * i1; O[0][mt][i] = a; ss += a * a; }
        ss += __shfl_xor(ss, 32);
        const float rs = (1.0f - lam_init) / sqrtf(ss * (1.0f / 64.0f) + EPS);
        const float* bn = F.in[8] + l * 64;
#pragma unroll
        for (int mt = 0; mt < 2; ++mt)
#pragma unroll
            for (int g4 = 0; g4 < 4; ++g4) { const int dv0 = 32 * mt + 8 * g4 + 4 * hh; const f32x4 gn = *(const f32x4*)(bn + dv0);
                u32x2 o; o.x = pk2(O[0][mt][4 * g4 + 0] * rs * gn.x, O[0][mt][4 * g4 + 1] * rs * gn.y); o.y = pk2(O[0][mt][4 * g4 + 2] * rs * gn.z, O[0][mt][4 * g4 + 3] * rs * gn.w);
                if (ABL & 8) { o.x = 0u; o.y = 0u; }
                *(u32x2*)(MIX + t0 * D + 256 + h * 64 + dv0) = o; } }
    __syncthreads();
}

__device__ __forceinline__ void gdn_chain_item(const Frame& F0, int b, int h, int pair) { Frame F = opq(F0);
    const int w = F.wave, chain = w >> 2, cg = 2 * pair + chain, mi = w & 3, lr = F.lane & 15, lg = F.lane >> 4;
    LAS float* Sb = (LAS float*)F.lds + chain * 2048;
    const f32x4* GMv = (const f32x4*)(F.ws + WS_GM); float* GN = (float*)(F.ws + WS_GN);
    f32x4 s_cur = (f32x4){0.f, 0.f, 0.f, 0.f};
#pragma unroll
    for (int r = 0; r < 4; ++r) Sb[(16 * mi + 4 * lg + r) * 16 + lr] = 0.f;
    __syncthreads();
    f32x4 mq[4][4], nq[4];
#define GDN_LOAD(slot, n_) do { const size_t _ch = (size_t)((b * NCH + (n_)) * 4 + h); \
        _Pragma("unroll") for (int _q = 0; _q < 4; ++_q) mq[slot][_q] = GMv[_ch * 1024 + (mi * 4 + _q) * 64 + F.lane]; \
        _Pragma("unroll") for (int _r = 0; _r < 4; ++_r) nq[slot][_r] = GN[_ch * 4096 + (16 * mi + 4 * lg + _r) * 64 + 16 * cg + lr]; } while (0)
    GDN_LOAD(0, 0); GDN_LOAD(1, 1); GDN_LOAD(2, 2); GDN_LOAD(3, 3);
    for (int n0 = 0; n0 < NCH; n0 += 4) {
#pragma unroll
        for (int u = 0; u < 4; ++u) { const int n = n0 + u, buf = u & 1; const size_t ch = (size_t)((b * NCH + n) * 4 + h);
            f32x4 acc = nq[u];
#pragma unroll
            for (int r = 0; r < 4; ++r) GN[ch * 4096 + (16 * mi + 4 * lg + r) * 64 + 16 * cg + lr] = s_cur[r];
#pragma unroll
            for (int ks = 0; ks < 16; ++ks) { const float a = mq[u][ks >> 2][ks & 3], bv = Sb[buf * 1024 + (4 * ks + lg) * 16 + lr]; acc = __builtin_amdgcn_mfma_f32_16x16x4f32(a, bv, acc, 0, 0, 0); }
            asm volatile("s_nop 15\n\ts_nop 7" : "+v"(acc));
            s_cur = acc;
#pragma unroll
            for (int r = 0; r < 4; ++r) Sb[(buf ^ 1) * 1024 + (16 * mi + 4 * lg + r) * 16 + lr] = acc[r];
            if (n + 4 < NCH) GDN_LOAD(u, n + 4);
            __syncthreads(); }
    }
#undef GDN_LOAD
}
__device__ __forceinline__ void gla_prefix_item(const Frame& F0, int b, int h) { Frame F = opq(F0);
    f32x4* LKV = (f32x4*)(F.ws + WS_LKV); const float* LDL = (const float*)(F.ws + WS_LDL); const int dk = F.tid >> 4;
    f32x4 s = (f32x4){0.f, 0.f, 0.f, 0.f}, kvq[8]; float dq[8];
#pragma unroll
    for (int u = 0; u < 8; ++u) { const size_t ch = (size_t)((b * NCH + u) * 4 + h); kvq[u] = LKV[ch * 512 + F.tid]; dq[u] = LDL[ch * 32 + dk]; }
    for (int n0 = 0; n0 < NCH; n0 += 8) {
#pragma unroll
        for (int u = 0; u < 8; ++u) { const int n = n0 + u; const size_t ch = (size_t)((b * NCH + n) * 4 + h);
            const f32x4 kv = kvq[u]; const float d = dq[u];
            LKV[ch * 512 + F.tid] = s; s = s * d + kv;
            if (n + 8 < NCH) { const size_t c2 = (size_t)((b * NCH + n + 8) * 4 + h); kvq[u] = LKV[c2 * 512 + F.tid]; dq[u] = LDL[c2 * 32 + dk]; } }
    }
}
__device__ __forceinline__ void rg_carry_item(const Frame& F0, int j) { Frame F = opq(F0);
    const int gid = j * NTHR + F.tid, b = gid >> 8, c = gid & 255;
    const float* RAT = (const float*)(F.ws + WS_RAT); const float* RHE = (const float*)(F.ws + WS_RHE); float* RCA = (float*)(F.ws + WS_RCA);
    float carry = 0.f;
#pragma unroll 8
    for (int n = 0; n < NCH; ++n) { const int ci = (b * NCH + n) * 256 + c; const float a = RAT[ci], hn = RHE[ci]; RCA[ci] = carry; carry = a * carry + hn; }
}
constexpr int Q_GDN = 64, Q_GLA = 32, Q_RG = 4, Q_ATT = 512, Q_ITEMS = Q_GDN + Q_GLA + Q_RG + Q_ATT;
__device__ __forceinline__ void scan_attn_phase(Frame& F, int l) {
    for (;;) {
        __syncthreads();
        if (F.tid == 0) F.MISC[16] = __hip_atomic_fetch_add(F.ctl + CW_QUEUE + 64 * l, 1u, __ATOMIC_RELAXED, __HIP_MEMORY_SCOPE_AGENT);
        __syncthreads();
        const int it = (int)F.MISC[16];
        if (it >= Q_ITEMS) break;
        if (it < Q_GDN) gdn_chain_item(F, it >> 3, (it >> 1) & 3, it & 1);
        else if (it < Q_GDN + Q_GLA) { const int q = it - Q_GDN; gla_prefix_item(F, q >> 2, q & 3); }
        else if (it < Q_GDN + Q_GLA + Q_RG) rg_carry_item(F, it - Q_GDN - Q_GLA);
        else { const int a = it - (Q_GDN + Q_GLA + Q_RG), qb = 15 - (a >> 5), bh = a & 31; attn_item(F, l, bh >> 2, bh & 3, qb); }
    }
    if (REPEAT & 4) for (;;) {
        __syncthreads();
        if (F.tid == 0) F.MISC[16] = __hip_atomic_fetch_add(F.ctl + CW_QUEUE + 64 * (2 + l), 1u, __ATOMIC_RELAXED, __HIP_MEMORY_SCOPE_AGENT);
        __syncthreads();
        const int a = (int)F.MISC[16];
        if (a >= Q_ATT) break;
        const int qb = 15 - (a >> 5), bh = a & 31; attn_item(F, l, bh >> 2, bh & 3, qb);
    }
}

__device__ __forceinline__ void norm_gate_store(Frame& F, const LAS float* OUT, const float* gain, const bf16* gate  , bf16* dst, bool silu_gate) {
    const int t = F.tid >> 3, p = F.tid & 7; const f32x4 a = *(const LAS f32x4*)(OUT + t * LD + 8 * p), c = *(const LAS f32x4*)(OUT + t * LD + 8 * p + 4);
    float ss = (a.x * a.x + a.y * a.y) + (a.z * a.z + a.w * a.w) + (c.x * c.x + c.y * c.y) + (c.z * c.z + c.w * c.w);
#pragma unroll
    for (int o = 1; o < 8; o <<= 1) ss += __shfl_xor(ss, o);
    const float rs = 1.0f / sqrtf(ss * (1.0f / 64.0f) + EPS);
    float gv[8]; ld8(gate + (size_t)t * PP + 8 * p, gv);
    const f32x4 g0 = *(const f32x4*)(gain + 8 * p), g1 = *(const f32x4*)(gain + 8 * p + 4);
    float o[8] = {a.x * rs * g0.x, a.y * rs * g0.y, a.z * rs * g0.z, a.w * rs * g0.w, c.x * rs * g1.x, c.y * rs * g1.y, c.z * rs * g1.z, c.w * rs * g1.w};
#pragma unroll
    for (int e = 0; e < 8; ++e) o[e] *= siluf_(gv[e]) * (((ABL & 512) && gain == F.in[6] + 0) ? 2.0f : 1.0f);
    u32x4 w; w.x = pk2(o[0], o[1]); w.y = pk2(o[2], o[3]); w.z = pk2(o[4], o[5]); w.w = pk2(o[6], o[7]);
    if (!silu_gate) w = (u32x4){0u, 0u, 0u, 0u};
    *(u32x4*)(dst + (size_t)t * D + 8 * p) = w;
}
struct FinIn { f32x4 a0, a1, b0, b1, c0, c1; u32x4 gate; };
__device__ __forceinline__ void fin_fetch(const Frame& F, int it, int hj, FinIn& x) {
    const int b = it >> 6, n = it & 63, h = hj & 3, lr = F.lane & 15, lg = F.lane >> 4; const size_t ch = (size_t)((b * NCH + n) * 4 + h), tok0 = (size_t)b * SEQ + n * CH;
    const bf16* PROJ = (const bf16*)(F.ws + WS_PROJ); const float* ini;
    if (hj < 4) { const f32x4* GQ = (const f32x4*)(F.ws + WS_GQ) + ch * 1024; const f32x4* GS = (const f32x4*)(F.ws + WS_GN) + ch * 1024; ini = (const float*)(F.ws + WS_GO) + ch * 4096;
        x.a0 = GQ[F.tid]; x.a1 = GQ[F.tid + NTHR]; x.b0 = GS[F.tid]; x.b1 = GS[F.tid + NTHR]; }
    else { const f32x4* LQG = (const f32x4*)(F.ws + WS_LQG) + ch * 512; const f32x4* LS = (const f32x4*)(F.ws + WS_LKV) + ch * 512; ini = (const float*)(F.ws + WS_LOI) + ch * 4096;
        x.a0 = LQG[F.tid]; x.b0 = LS[F.tid]; x.a1 = x.a0; x.b1 = x.b0; }
#pragma unroll
    for (int r = 0; r < 4; ++r) { const int t0 = F.wave, t1 = F.wave + 8; x.c0[r] = ini[(16 * (t0 >> 2) + 4 * lg + r) * 64 + 16 * (t0 & 3) + lr]; x.c1[r] = ini[(16 * (t1 >> 2) + 4 * lg + r) * 64 + 16 * (t1 & 3) + lr]; }
    x.gate = *(const u32x4*)(PROJ + (tok0 + (F.tid >> 3)) * PP + (hj < 4 ? GA : RD) + h * 64 + 8 * (F.tid & 7));
}
__device__ __forceinline__ void finalize_phase(const Frame& F0, int l) { Frame F = opq(F0);
    LAS float* QP = (LAS float*)F.lds; LAS float* SPT = QP + MATF; LAS float* OUT = SPT + MATF;
    const bf16* PROJ = (const bf16*)(F.ws + WS_PROJ); bf16* MIX = (bf16*)(F.ws + WS_HM);
    const int lr = F.lane & 15, lg = F.lane >> 4;
    FinIn nx; if (F.bid < NB * NCH) fin_fetch(F, F.bid, 0, nx);
    for (int it = F.bid; it < NB * NCH; it += F.G) { const int b = it >> 6, n = it & 63; const size_t tok0 = (size_t)b * SEQ + n * CH;
        for (int hj = 0; hj < 8; ++hj) { const FinIn cur = nx; const int h = hj & 3;
            if (hj < 4) {
#pragma unroll
                for (int i = 0; i < 2; ++i) { const int e = F.tid + NTHR * i, r = e >> 4, c4 = (e & 15) * 4; const f32x4 qv = i ? cur.a1 : cur.a0, sv = i ? cur.b1 : cur.b0;
                    *(LAS f32x4*)(QP + r * LD + c4) = qv; SPT[(c4 + 0) * LD + r] = sv.x; SPT[(c4 + 1) * LD + r] = sv.y; SPT[(c4 + 2) * LD + r] = sv.z; SPT[(c4 + 3) * LD + r] = sv.w; } }
            else { const int r = F.tid >> 3, c4 = (F.tid & 7) * 4; *(LAS f32x4*)(QP + r * 36 + c4) = cur.a0;
                const int r2 = F.tid >> 4, c42 = (F.tid & 15) * 4; SPT[(c42 + 0) * LD + r2] = cur.b0.x; SPT[(c42 + 1) * LD + r2] = cur.b0.y; SPT[(c42 + 2) * LD + r2] = cur.b0.z; SPT[(c42 + 3) * LD + r2] = cur.b0.w; }
            __syncthreads();
            { int nit = it, nhj = hj + 1; if (nhj == 8) { nhj = 0; nit = it + F.G; } if (nit < NB * NCH) fin_fetch(F, nit, nhj, nx); }
#pragma unroll
            for (int q = 0; q < 2; ++q) { const int tl = F.wave + 8 * q, mi = tl >> 2, ni = tl & 3; f32x4 acc = q ? cur.c1 : cur.c0;
                if (hj < 4) { if (!(ABL & 128)) acc = mm16b<false, true>(QP, LD, SPT, LD, 16 * mi, 16 * ni, 64, acc, F.lane); }
                else acc = mm16b<false, true>(QP, 36, SPT, LD, 16 * mi, 16 * ni, 32, acc, F.lane);
#pragma unroll
                for (int r = 0; r < 4; ++r) OUT[(16 * mi + 4 * lg + r) * LD + 16 * ni + lr] = acc[r]; }
            __syncthreads();
            { const int t = F.tid >> 3, p = F.tid & 7; const f32x4 a = *(const LAS f32x4*)(OUT + t * LD + 8 * p), c = *(const LAS f32x4*)(OUT + t * LD + 8 * p + 4);
                float ss = (a.x * a.x + a.y * a.y) + (a.z * a.z + a.w * a.w) + (c.x * c.x + c.y * c.y) + (c.z * c.z + c.w * c.w);
#pragma unroll
                for (int o = 1; o < 8; o <<= 1) ss += __shfl_xor(ss, o);
                const float rs = 1.0f / sqrtf(ss * (1.0f / 64.0f) + EPS);
                float gv[8]; unpack8(cur.gate, gv);
                const float* gain = (hj < 4 ? F.in[6] : F.in[19]) + l * 64;
                const f32x4 g0 = *(const f32x4*)(gain + 8 * p), g1 = *(const f32x4*)(gain + 8 * p + 4);
                float o[8] = {a.x * rs * g0.x, a.y * rs * g0.y, a.z * rs * g0.z, a.w * rs * g0.w, c.x * rs * g1.x, c.y * rs * g1.y, c.z * rs * g1.z, c.w * rs * g1.w};
#pragma unroll
                for (int e = 0; e < 8; ++e) o[e] *= siluf_(gv[e]);
                u32x4 w; w.x = pk2(o[0], o[1]); w.y = pk2(o[2], o[3]); w.z = pk2(o[4], o[5]); w.w = pk2(o[6], o[7]);
                *(u32x4*)(MIX + (tok0 + t) * D + (hj < 4 ? 0 : 768) + h * 64 + 8 * p) = w; }
        }
        { const int t = F.tid >> 3, c0 = (F.tid & 7) * 32; const size_t tok = tok0 + t;
            const bf16* RHL = (const bf16*)(F.ws + WS_RHL) + tok * 256; const bf16* RP = (const bf16*)(F.ws + WS_RP) + tok * 256; const float* RCA = (const float*)(F.ws + WS_RCA) + (b * NCH + n) * 256;
#pragma unroll
            for (int q = 0; q < 4; ++q) { const int c = c0 + 8 * q; float hl[8], pv[8], gc[8]; ld8(RHL + c, hl); ld8(RP + c, pv); ld8(PROJ + tok * PP + GC + c, gc);
                const f32x4 ca0 = *(const f32x4*)(RCA + c), ca1 = *(const f32x4*)(RCA + c + 4); const float ca[8] = {ca0.x, ca0.y, ca0.z, ca0.w, ca1.x, ca1.y, ca1.z, ca1.w};
                float o[8];
#pragma unroll
                for (int e = 0; e < 8; ++e) o[e] = (hl[e] + pv[e] * ca[e]) * gelu_tanh(gc[e]);
                u32x4 w; w.x = pk2(o[0], o[1]); w.y = pk2(o[2], o[3]); w.z = pk2(o[4], o[5]); w.w = pk2(o[6], o[7]);
                *(u32x4*)(MIX + tok * D + 512 + c) = w; } }
    }
    __syncthreads();
}

__device__ __forceinline__ void dbg_gdn_check(const Frame& F0, int l, int bsel, int hsel, int msel, float* dbgout) { Frame F = opq(F0);
    if (F.bid != 0) return;
    constexpr int NT = 512;
    LAS float* S = (LAS float*)F.lds;
    LAS float* qv = S + 4096; LAS float* kv = qv + 64; LAS float* vv = kv + 64; LAS float* tmp = vv + 64; LAS float* ov = tmp + 64; LAS float* sc = ov + 64;
    const bf16* PROJ = (const bf16*)(F.ws + WS_PROJ); const float* SM = (const float*)(F.ws + WS_SMALL); const bf16* MIX = (const bf16*)(F.ws + WS_HM);
    const float* cw = F.in[3] + (size_t)l * 4 * 768;
    for (int i = F.tid; i < 4096; i += NTHR) S[i] = 0.f;
    float errsum = 0.f, refsum = 0.f;
    __syncthreads();
    for (int t = 0; t < NT; ++t) {
        const size_t tok = (size_t)bsel * SEQ + t;
        if (F.tid < 192) { const int which = F.tid >> 6, d = F.tid & 63, c = which * 256 + hsel * 64 + d; float y = 0.f;
            for (int j = 0; j < 4; ++j) { const int tp = t - 3 + j; if (tp >= 0) y += bf2f(PROJ[((size_t)bsel * SEQ + tp) * PP + c]) * cw[j * 768 + c]; }
            y = y / (1.0f + expf(-y)); (which == 0 ? qv : which == 1 ? kv : vv)[d] = y; }
        __syncthreads();
        if (F.tid == 0) { float sq = 0.f, sk = 0.f; for (int d = 0; d < 64; ++d) { sq += qv[d] * qv[d]; sk += kv[d] * kv[d]; }
            sc[0] = 0.125f / sqrtf(sq + EPS); sc[1] = 1.0f / sqrtf(sk + EPS);
            sc[2] = 1.0f / (1.0f + expf(-SM[tok * 32 + hsel]));
            const float x = SM[tok * 32 + 4 + hsel] + F.in[5][l * 4 + hsel]; const float sp = fmaxf(x, 0.f) + log1pf(expf(-fabsf(x)));
            sc[3] = expf(-expf(F.in[4][l * 4 + hsel]) * sp); }
        __syncthreads();
        if (F.tid < 64) { qv[F.tid] *= sc[0]; kv[F.tid] *= sc[1]; }
        for (int i = F.tid; i < 4096; i += NTHR) S[i] *= sc[3];
        __syncthreads();
        if ((ABL & (1 << 21)) && t < 64 && F.tid < 64) { const float* dq = (const float*)(F.ctl + 8192); const int which = msel; if (which < 3) { const float r = which == 0 ? qv[F.tid] : which == 1 ? kv[F.tid] : vv[F.tid] * sc[2];
            const float m = dq[which * 4096 + t * 64 + F.tid]; errsum += (m - r) * (m - r); refsum += r * r; } }
        if ((ABL & (1 << 22)) && t < 64) { LAS float* KH = sc + 16; LAS float* GH = KH + 4096;
            if (F.tid < 64) KH[t * 64 + F.tid] = kv[F.tid];
            if (F.tid == 0) GH[t] = (t ? GH[t - 1] : 0.f) + logf(sc[3]);
            __syncthreads();
            if (F.tid <= t && msel < 2) { const int j = F.tid; float d = 0.f; for (int dk = 0; dk < 64; ++dk) d += (msel == 0 ? qv[dk] : kv[dk]) * KH[j * 64 + dk];
                float r = d * expf(GH[t] - GH[j]) * (msel == 0 ? 1.0f : sc[2]); if (msel == 1 && j == t) r = 0.f;
                const float m = ((const float*)(F.ctl + 8192 + 3 * 4096))[(msel == 0 ? 4096 : 0) + t * 64 + j]; errsum += (m - r) * (m - r); refsum += r * r; }
            __syncthreads(); }
        if (F.tid < 64) { float a = 0.f; for (int dk = 0; dk < 64; ++dk) a += S[dk * 64 + F.tid] * kv[dk]; tmp[F.tid] = sc[2] * (vv[F.tid] - a); }
        __syncthreads();
        if ((ABL & (1 << 22)) && msel == 2 && t < 64 && F.tid < 64) { const float m = ((const float*)(F.ctl + 8192 + 5 * 4096))[t * 64 + F.tid], r = tmp[F.tid]; errsum += (m - r) * (m - r); refsum += r * r; }
        for (int i = F.tid; i < 4096; i += NTHR) S[i] += kv[i >> 6] * tmp[i & 63];
        __syncthreads();
        if (F.tid < 64) { float a = 0.f; for (int dk = 0; dk < 64; ++dk) a += S[dk * 64 + F.tid] * qv[dk]; ov[F.tid] = a; }
        __syncthreads();
        if ((ABL & (1 << 21)) && msel == 3 && t < 64 && F.tid < 64) { const float* GO = (const float*)(F.ws + WS_GO) + (size_t)((bsel * NCH + 0) * 4 + hsel) * 4096;
            const float m = (ABL & (1 << 23)) ? ((const float*)(F.ctl + 8192 + 6 * 4096))[t * 64 + F.tid] : GO[t * 64 + F.tid], r = ov[F.tid]; errsum += (m - r) * (m - r); refsum += r * r; }
        if (F.tid == 0) { float ss = 0.f; for (int d = 0; d < 64; ++d) ss += ov[d] * ov[d]; sc[4] = 1.0f / sqrtf(ss / 64.0f + EPS); }
        __syncthreads();
        if (F.tid < 64) { const float gt = bf2f(PROJ[tok * PP + GA + hsel * 64 + F.tid]); const float r = ov[F.tid] * sc[4] * F.in[6][l * 64 + F.tid] * (gt / (1.0f + expf(-gt)));
            const float m = bf2f(MIX[tok * D + hsel * 64 + F.tid]);
            const bool use = msel == 0 ? true : msel == 1 ? ((t & 63) < 16) : msel == 2 ? (t < 64) : (t >= 64);
            if (use && !(ABL & (3 << 21))) { errsum += (m - r) * (m - r); refsum += r * r; } }
        __syncthreads();
    }
    if (F.tid < 64) { errsum = wave_sum(errsum); refsum = wave_sum(refsum); if (F.tid == 0) dbgout[0] = 1000.0f * sqrtf(errsum / fmaxf(refsum, 1e-30f)); }
}
#define IN_PH (lo <= ph && ph < hi)
#define END_PH do { if (IN_PH && ph + 1 < hi) xcd_barrier(bar); ++ph; } while (0)
template <int l>
__device__ __forceinline__ void layer_phases(Frame& F, const XcdBarrier& bar, const int lo, const int hi, int& ph) {
    LAS unsigned char* ring = F.lds;
    bf16* HM = (bf16*)(F.ws + WS_HM); bf16* PROJ = (bf16*)(F.ws + WS_PROJ); float* X = F.out;
        if (PHON(1) && IN_PH) {
            pg8::StaticOrder S; S.init(T, NIN, F.G, F.bid); pg8::EpiProj E{PROJ, (float*)(F.ws + WS_SMALL)};
            pg8::gemm_phase<pg8::EpiProj, pg8::StaticOrder, false>(ring, HM, (const bf16*)(F.ws + WS_WIN) + (size_t)l * NIN * D, D, S, E, nullptr); }
        END_PH;
        if (PHON(2) && IN_PH) { prep_phase(F, l); if (REPEAT & 1) { __syncthreads(); prep_phase(F, l); } }
        END_PH;
        if ((ABL & 4096) && (ABL & (1 << 24)) && l == ((ABL >> 15) & 1)) { if (IN_PH) dbg_gdn_check(F, l, (ABL >> 18) & 7, (ABL >> 16) & 3, (ABL >> 13) & 3, (float*)(F.ctl + 2048)); END_PH; }
        if (PHON(3) && IN_PH) scan_attn_phase(F, l);
        END_PH;
        if ((ABL & 4096) && (ABL & (1 << 25)) && l == ((ABL >> 15) & 1)) { if (IN_PH) dbg_gdn_check(F, l, (ABL >> 18) & 7, (ABL >> 16) & 3, (ABL >> 13) & 3, (float*)(F.ctl + 2048)); END_PH; }
        if (PHON(4) && IN_PH) { finalize_phase(F, l); if (REPEAT & 2) { __syncthreads(); finalize_phase(F, l); } }
        END_PH;
        if ((ABL & 4096) && !(ABL & (3 << 24)) && l == ((ABL >> 15) & 1)) { if (IN_PH) dbg_gdn_check(F, l, (ABL >> 18) & 7, (ABL >> 16) & 3, (ABL >> 13) & 3, (float*)(F.ctl + 2048)); END_PH; }
        if (PHON(5) && IN_PH) {
            pg8::StaticOrder S; S.init(T, D, F.G, F.bid); pg8::EpiResid E{l == 0 ? F.in[0] : (const float*)X, X};
            pg8::gemm_phase<pg8::EpiResid, pg8::StaticOrder, false>(ring, HM, (const bf16*)(F.ws + WS_WOUT) + (size_t)l * D * D, D, S, E, nullptr); }
        END_PH;
        if (l == 0) {
            if (PHON(6) && IN_PH) norm_phase(F, X, F.in[21]);
            END_PH;
            if (PHON(7) && !(ABL & 4) && IN_PH) { pg8::StaticOrder S; S.init(T, 2 * DFF, F.G, F.bid); pg8::EpiSwiglu E{PROJ, DFF, 22};
                pg8::gemm_phase<pg8::EpiSwiglu, pg8::StaticOrder, false>(ring, HM, (const bf16*)(F.ws + WS_WGU), D, S, E, nullptr); }
            END_PH;
            if (PHON(8) && !(ABL & 4) && IN_PH) { pg8::StaticOrder S; S.init(T, D, F.G, F.bid); pg8::EpiResid E{X, X};
                pg8::gemm_phase<pg8::EpiResid, pg8::StaticOrder, false>(ring, PROJ, (const bf16*)(F.ws + WS_WD), DFF, S, E, nullptr); }
            END_PH;
            if (PHON(6) && IN_PH) norm_phase(F, X, F.in[1] + D);
            END_PH;
        } else {
            if (PHON(9) && IN_PH) { norm_router_phase(F, X, F.in[21] + D, F.in[25]); __syncthreads(); moe_convert(F); }
            END_PH;
            for (int k = 0; k < ((ABL & 1) ? 0 : 2); ++k) {
                const int* stok = (const int*)(F.ws + WS_STOK) + (size_t)k * NE * T; const float* sw = (const float*)(F.ws + WS_SW) + (size_t)k * NE * T;
                if (PHON(10) && IN_PH) { pg8::MoeOrder S; S.init(F.ctl + CW_MOECNT + 8 * k, 28, F.G, F.bid); pg8::EpiSwiglu E{PROJ, DFE, 28};
                    pg8::gemm_phase<pg8::EpiSwiglu, pg8::MoeOrder, true>(ring, HM, (const bf16*)(F.ws + WS_MOEW_GU), D, S, E, stok); }
                END_PH;
                if (PHON(11) && IN_PH) { pg8::MoeOrder S; S.init(F.ctl + CW_MOECNT + 8 * k, 4, F.G, F.bid); pg8::EpiScatter E{X, stok, sw, 4};
                    pg8::gemm_phase<pg8::EpiScatter, pg8::MoeOrder, false>(ring, PROJ, (const bf16*)(F.ws + WS_MOEW_D), DFE, S, E, nullptr); }
                END_PH;
            }
            if (PHON(12) && IN_PH) final_norm_phase(F, X, F.in[29]);
            END_PH;
            if (ABL & 4096) { if (IN_PH) { for (size_t i = (size_t)F.bid * NTHR + F.tid; i < (size_t)T * D; i += (size_t)F.G * NTHR) X[i] = (i == 0) ? ((const float*)(F.ctl + 2048))[0] : 0.f; } END_PH; }
        }
}
#undef IN_PH
#undef END_PH
struct Args { const float* in[30]; float* out; unsigned char* ws; int ph_lo, ph_hi; };
constexpr int N_PHASES = 21 + ((ABL & 4096) ? 2 : 0);
__global__ void __launch_bounds__(NTHR, 2) fwd(Args args) {
    extern __shared__ __attribute__((aligned(16))) unsigned char lds[];
    Frame F;
    F.lds = (LAS unsigned char*)lds; F.MISC = (volatile LAS unsigned*)(F.lds + MISC_OFF);
    F.tid = threadIdx.x; F.lane = F.tid & 63; F.wave = __builtin_amdgcn_readfirstlane(F.tid >> 6);
    F.G = gridDim.x; F.bid = blockIdx.x; F.in = args.in; F.out = args.out; F.ws = args.ws; F.ctl = (unsigned*)(args.ws + WS_CTL);
    for (int u = F.tid; u < 64; u += NTHR) F.MISC[u] = 0u;
    __syncthreads();
    const int lo = args.ph_lo, hi = args.ph_hi;
    XcdBarrier bar; bar.bar = F.ctl + CW_BAR; bar.x = 0; bar.st = nullptr;
    if (hi - lo > 1) bar = xcd_barrier_post(F.ctl + CW_BAR, F.MISC + 8);
    int ph = 0;
#define IN_PH (lo <= ph && ph < hi)
#define END_PH do { if (IN_PH && ph + 1 < hi) xcd_barrier(bar); ++ph; } while (0)
    LAS unsigned char* ring = F.lds;
    bf16* HM = (bf16*)(F.ws + WS_HM); bf16* PROJ = (bf16*)(F.ws + WS_PROJ); float* X = F.out;

    if (PHON(0) && IN_PH) p0_prologue(F);
    END_PH;
    layer_phases<0>(F, bar, lo, hi, ph);
    layer_phases<1>(F, bar, lo, hi, ph);
#undef IN_PH
#undef END_PH
}

extern "C" void kernel_launch(void* const* d_in, const int* in_sizes, int n_in, void* d_out, int out_size, void* d_ws, size_t ws_size, hipStream_t stream) {
    static int grid = 0;
    if (grid == 0) {
        if (n_in != 30 || in_sizes[0] != T * D || out_size != T * D || ws_size < WS_NEED) { fprintf(stderr, "kernel_launch: unexpected shapes (n_in %d, in0 %d, out %d, ws %zu < %zu); nothing launched\n", n_in, n_in > 0 ? in_sizes[0] : -1, out_size, ws_size, (size_t)WS_NEED); grid = -1; return; }
        int dev = 0, cus = 0, per_cu = 0;
        if (hipGetDevice(&dev) != hipSuccess || hipDeviceGetAttribute(&cus, hipDeviceAttributeMultiprocessorCount, dev) != hipSuccess) { grid = -1; return; }
        if (hipFuncSetAttribute((const void*)fwd, hipFuncAttributeMaxDynamicSharedMemorySize, LDS_BYTES) != hipSuccess) { fprintf(stderr, "kernel_launch: hipFuncSetAttribute failed\n"); grid = -1; return; }
        if (hipOccupancyMaxActiveBlocksPerMultiprocessor(&per_cu, (const void*)fwd, NTHR, LDS_BYTES) != hipSuccess || per_cu < 1) fprintf(stderr, "kernel_launch: occupancy query says %d\n", per_cu);
        (void)hipGetLastError();
        grid = cus;
    }
    if (grid < 0) return;
    if (hipMemsetAsync((char*)d_ws + WS_CTL, 0, CTL_ZERO_BYTES, stream) != hipSuccess) return;
    Args a{};
    for (int i = 0; i < 30; ++i) a.in[i] = (const float*)d_in[i];
    a.out = (float*)d_out; a.ws = (unsigned char*)d_ws;
#if MK_ONE_LAUNCH
    a.ph_lo = 0; a.ph_hi = N_PHASES;
    hipLaunchKernelGGL(fwd, dim3(grid), dim3(NTHR), LDS_BYTES, stream, a);
#else
    for (int p = 0; p < N_PHASES; ++p) { a.ph_lo = p; a.ph_hi = p + 1; hipLaunchKernelGGL(fwd, dim3(grid), dim3(NTHR), LDS_BYTES, stream, a); }
#endif
}
```

```cpp
#include <hip/hip_runtime.h>
#include <cstdio>
#include <cstdint>

#ifndef PHMASK
#define PHMASK 0xffff
#endif
#define PHON(k) ((PHMASK >> (k)) & 1)
#ifndef PROBE_A
#define PROBE_A -1
#endif
#ifndef PROBE_B
#define PROBE_B -1
#endif
#ifndef REPEAT
#define REPEAT 0
#endif
#ifndef DUMPS
#define DUMPS 0
#endif
#ifndef FINPARTS
#define FINPARTS 7
#endif
#ifndef ABL
#define ABL 0
#endif
#ifndef MK_ONE_LAUNCH
#define MK_ONE_LAUNCH 1
#endif

#define LAS __attribute__((address_space(3)))
#define GAS __attribute__((address_space(1)))
typedef unsigned short bf16;
typedef short bf16x8 __attribute__((ext_vector_type(8)));
typedef short s16x4 __attribute__((ext_vector_type(4)));
typedef float f32x4 __attribute__((ext_vector_type(4)));
typedef float f32x16 __attribute__((ext_vector_type(16)));
typedef unsigned u32x4 __attribute__((ext_vector_type(4)));
typedef unsigned u32x2 __attribute__((ext_vector_type(2)));

constexpr int T = 32768, D = 1024, SEQ = 4096, NB = 8, NCH = 64, CH = 64;
constexpr int PP = 3072;
constexpr int QA = 0, KA = 256, VA = 512, GA = 768, QB = 1024, KB = 1280, VB = 1536, XC = 1792, GC = 2048, QD = 2304, KD = 2432, VD = 2560, RD = 2816;
constexpr int NIN = 3328;
constexpr int DFF = 2816, DFE = 3584, NE = 8;
constexpr float EPS = 1e-6f;
constexpr float LOG2E = 1.4426950408889634f;

constexpr size_t MiB = 1u << 20;
constexpr size_t WS_CTL = 0, CTL_ZERO_BYTES = 1 * MiB;
constexpr size_t WS_STOK = 1 * MiB;
constexpr size_t WS_SW = 3 * MiB;
constexpr size_t WS_WIN = 5 * MiB;
constexpr size_t WS_WOUT = 18 * MiB;
constexpr size_t WS_WGU = 22 * MiB;
constexpr size_t WS_WD = 33 * MiB;
constexpr size_t WS_HM = 39 * MiB;
constexpr size_t WS_SMALL = 103 * MiB;
constexpr size_t WS_PROJ = 107 * MiB;
constexpr size_t WS_TMP = 299 * MiB;
constexpr size_t WS_GM = WS_TMP;
constexpr size_t WS_GN = WS_GM + 32 * MiB;
constexpr size_t WS_GQ = WS_GN + 32 * MiB;
constexpr size_t WS_GO = WS_GQ + 32 * MiB;
constexpr size_t WS_LOI = WS_GO + 32 * MiB;
constexpr size_t WS_LQG = WS_LOI + 32 * MiB;
constexpr size_t WS_LKV = WS_LQG + 16 * MiB;
constexpr size_t WS_RHL = WS_LKV + 16 * MiB;
constexpr size_t WS_RP = WS_RHL + 16 * MiB;
constexpr size_t WS_MISC = WS_RP + 16 * MiB;
constexpr size_t WS_LDL = WS_MISC;
constexpr size_t WS_RAT = WS_MISC + 512 * 1024;
constexpr size_t WS_RHE = WS_RAT + 512 * 1024;
constexpr size_t WS_RCA = WS_RHE + 512 * 1024;
constexpr size_t WS_TMP_END = WS_MISC + 2 * MiB;
constexpr size_t WS_MOEW_GU = 345 * MiB;
constexpr size_t WS_MOEW_D = 457 * MiB;
constexpr size_t WS_END = 513 * MiB;
constexpr size_t WS_NEED = 525 * MiB;
static_assert(WS_TMP_END <= WS_NEED && WS_END <= WS_NEED, "ws map");
static_assert(WS_PROJ + (size_t)34816 * DFE * 2 <= WS_MOEW_GU, "moe act fits under moe weights");
constexpr int CW_TMO = 0;
constexpr int CW_QUEUE = 64;
constexpr int CW_MOECNT = 1024;
constexpr int CW_BAR = 4096;

constexpr int RING_BYTES = 131072;
constexpr int MISC_OFF = RING_BYTES;
constexpr int LDS_BYTES = RING_BYTES + 4096;
constexpr int NWAVES = 8, NTHR = 512;

__device__ __forceinline__ unsigned f2bf(float f) { unsigned u = __builtin_bit_cast(unsigned, f); return (u + 0x7fffu + ((u >> 16) & 1u)) >> 16; }
__device__ __forceinline__ unsigned pk2(float lo, float hi) { return f2bf(lo) | (f2bf(hi) << 16); }
__device__ __forceinline__ float bflo(unsigned w) { return __builtin_bit_cast(float, w << 16); }
__device__ __forceinline__ float bfhi(unsigned w) { return __builtin_bit_cast(float, w & 0xffff0000u); }
__device__ __forceinline__ float bf2f(bf16 b) { return __builtin_bit_cast(float, ((unsigned)b) << 16); }
__device__ __forceinline__ float wave_sum(float v) {
#pragma unroll
    for (int o = 1; o < 64; o <<= 1) v += __shfl_xor(v, o);
    return v;
}
__device__ __forceinline__ float fexp(float x) { return __builtin_amdgcn_exp2f(x * LOG2E); }
__device__ __forceinline__ float sigmoidf_(float x) { return 1.0f / (1.0f + __expf(-x)); }
__device__ __forceinline__ float siluf_(float x) { return x / (1.0f + __expf(-x)); }
__device__ __forceinline__ float softplusf_(float x) { return fmaxf(x, 0.f) + log1pf(__expf(-fabsf(x))); }
__device__ __forceinline__ float gelu_tanh(float x) { const float u = 0.7978845608028654f * (x + 0.044715f * x * x * x); return 0.5f * x * (1.0f + tanhf(u)); }
#define LDS_WAIT() asm volatile("s_waitcnt lgkmcnt(0)" ::: "memory")
#define VM_WAIT() asm volatile("s_waitcnt vmcnt(0)" ::: "memory")

namespace pg8 {
constexpr int BM = 256, BK = 64, HALF = 128, HTB = HALF * BK * 2, STAGE_BYTES = 8 * HTB, NXCD = 8, WGM = 8;
__host__ __device__ __forceinline__ int lds_byte(int r, int c) { const int st = (r >> 4) * 2 + (c >> 5), rr = r & 15, cc = c & 31, ob = rr * 64 + cc * 2; return st * 1024 + (ob ^ (((ob >> 9) & 1) << 5)); }
__host__ __device__ __forceinline__ void stage_rc(int b, int& R, int& C) { const int st = b / 1024, sb = b % 1024, swz = sb ^ (((sb >> 9) & 1) << 5); R = (st >> 1) * 16 + swz / 64; C = (st & 1) * 32 + (swz % 64) / 2; }
__host__ __device__ __forceinline__ int perm32(int rho) { const int n = rho >> 4, i = rho & 15; return 8 * (i >> 2) + 4 * n + (i & 3); }

struct Unit { int pm, pn, e, vr, lbase; };

struct StaticOrder {
    int nM, nN, nwg, G, c;
    __device__ void init(int M, int N, int G_, int c_) { nM = M / BM; nN = N / BM; nwg = nM * nN; G = G_; c = c_; }
    __device__ bool next(int i, Unit& u) const {
        const long L = (long)i * G + c; if (L >= nwg) return false;
        int wgid = (int)L; { const int q = nwg / NXCD, r = nwg % NXCD, xcd = wgid % NXCD, off = wgid / NXCD; wgid = (xcd < r ? xcd * (q + 1) : r * (q + 1) + (xcd - r) * q) + off; }
        const int nig = WGM * nN, gid = wgid / nig, fm = gid * WGM, gsz = (nM - fm) < WGM ? (nM - fm) : WGM;
        u.pm = fm + ((wgid % nig) % gsz); u.pn = (wgid % nig) / gsz; u.e = 0; u.vr = 256; u.lbase = 0; return true;
    }
};
struct MoeOrder {
    int pre[9], cnt[8], nN, G, c, total;
    __device__ void init(const unsigned* gcnt, int nN_, int G_, int c_) {
        int p = 0;
#pragma unroll
        for (int e = 0; e < 8; ++e) { cnt[e] = (int)__hip_atomic_load(gcnt + e, __ATOMIC_RELAXED, __HIP_MEMORY_SCOPE_AGENT); pre[e] = p; p += (cnt[e] + 255) >> 8; }
        pre[8] = p; nN = nN_; G = G_; c = c_; total = p * nN_;
    }
    __device__ bool next(int i, Unit& u) const {
        const long L = (long)i * G + c; if (L >= total) return false;
        const int pm = (int)(L / nN), pl = (int)(L % nN); int e = 0;
#pragma unroll
        for (int j = 1; j < 8; ++j) if (pm >= pre[j]) e = j;
        int pe = 0, ce = 0;
#pragma unroll
        for (int j = 0; j < 8; ++j) if (j == e) { pe = pre[j]; ce = cnt[j]; }
        const int lt = pm - pe, rem = ce - lt * 256;
        u.pm = pm; u.pn = e * nN + pl; u.e = e; u.vr = rem < 256 ? rem : 256; u.lbase = e * T + lt * 256; return true;
    }
};

__device__ __forceinline__ unsigned cvt_pk_bf16(float lo, float hi) { unsigned r; asm volatile("v_cvt_pk_bf16_f32 %0, %1, %2" : "=v"(r) : "v"(lo), "v"(hi)); return r; }

struct EpiProj {
    static constexpr bool PERM = true;
    bf16* P; float* SM;
    __device__ __forceinline__ void operator()(const f32x4 (&acc)[2][2][4][2], const Unit& u, int wr, int wc, int fr, int fq) const {
        const int row0 = u.pm * BM + wr * 64 + fr;
        if (u.pn < 12) {
            const int col0 = u.pn * BM + wc * 32 + 8 * fq;
#pragma unroll
            for (int ai = 0; ai < 2; ++ai)
#pragma unroll
                for (int m = 0; m < 4; ++m) { bf16* rowp = P + (size_t)(row0 + ai * HALF + m * 16) * PP + col0;
#pragma unroll
                    for (int bj = 0; bj < 2; ++bj) { const f32x4 v0 = acc[ai][bj][m][0], v1 = acc[ai][bj][m][1];
                        u32x4 w; w.x = cvt_pk_bf16(v0[0], v0[1]); w.y = cvt_pk_bf16(v0[2], v0[3]); w.z = cvt_pk_bf16(v1[0], v1[1]); w.w = cvt_pk_bf16(v1[2], v1[3]);
                        *(u32x4*)(rowp + bj * HALF) = w; } }
        } else if (wc == 0) {
#pragma unroll
            for (int ai = 0; ai < 2; ++ai)
#pragma unroll
                for (int m = 0; m < 4; ++m) { float* sp = SM + (size_t)(row0 + ai * HALF + m * 16) * 32 + 8 * fq;
                    *(f32x4*)sp = acc[ai][0][m][0]; *(f32x4*)(sp + 4) = acc[ai][0][m][1]; }
        }
    }
};
struct EpiResid {
    static constexpr bool PERM = false;
    const float* res; float* out;
    __device__ __forceinline__ void operator()(const f32x4 (&acc)[2][2][4][2], const Unit& u, int wr, int wc, int fr, int fq) const {
        const int row0 = u.pm * BM + wr * 64 + fr, col0 = u.pn * BM + wc * 32 + 4 * fq;
#pragma unroll
        for (int ai = 0; ai < 2; ++ai)
#pragma unroll
            for (int m = 0; m < 4; ++m) { const size_t off = (size_t)(row0 + ai * HALF + m * 16) * D + col0;
#pragma unroll
                for (int bj = 0; bj < 2; ++bj)
#pragma unroll
                    for (int n = 0; n < 2; ++n) { const size_t o = off + bj * HALF + n * 16; *(f32x4*)(out + o) = *(const f32x4*)(res + o) + acc[ai][bj][m][n]; }
                asm volatile("" ::: "memory"); }
    }
};
struct EpiSwiglu {
    static constexpr bool PERM = true;
    bf16* act; int ldc, nN;
    __device__ __forceinline__ void operator()(const f32x4 (&acc)[2][2][4][2], const Unit& u, int wr, int wc, int fr, int fq) const {
        const int pl = u.pn % nN;
        const int row0 = u.pm * BM + wr * 64 + fr, col0 = pl * HALF + wc * 32 + 8 * fq;
#pragma unroll
        for (int ai = 0; ai < 2; ++ai)
#pragma unroll
            for (int m = 0; m < 4; ++m) { bf16* rowp = act + (size_t)(row0 + ai * HALF + m * 16) * ldc + col0;
                float o[8];
#pragma unroll
                for (int n = 0; n < 2; ++n)
#pragma unroll
                    for (int j = 0; j < 4; ++j) { const float g = acc[ai][0][m][n][j], up = acc[ai][1][m][n][j];
                        o[4 * n + j] = g * up * __builtin_amdgcn_rcpf(1.0f + __builtin_amdgcn_exp2f(-g * LOG2E)); }
                u32x4 w; w.x = cvt_pk_bf16(o[0], o[1]); w.y = cvt_pk_bf16(o[2], o[3]); w.z = cvt_pk_bf16(o[4], o[5]); w.w = cvt_pk_bf16(o[6], o[7]);
                *(u32x4*)rowp = w; asm volatile("" ::: "memory"); }
    }
};
struct EpiScatter {
    static constexpr bool PERM = false;
    float* x; const int* tok; const float* wgt; int nN;
    __device__ __forceinline__ void operator()(const f32x4 (&acc)[2][2][4][2], const Unit& u, int wr, int wc, int fr, int fq) const {
        const int pl = u.pn % nN;
        const int rl0 = wr * 64 + fr, col0 = pl * BM + wc * 32 + 4 * fq;
#pragma unroll
        for (int ai = 0; ai < 2; ++ai)
#pragma unroll
            for (int m = 0; m < 4; ++m) { const int rl = rl0 + ai * HALF + m * 16;
                if (rl < u.vr) { const int t = tok[u.lbase + rl]; const float w = wgt[u.lbase + rl]; float* xp = x + (size_t)t * D + col0;
#pragma unroll
                    for (int bj = 0; bj < 2; ++bj)
#pragma unroll
                        for (int n = 0; n < 2; ++n) { f32x4* p = (f32x4*)(xp + bj * HALF + n * 16); *p = *p + acc[ai][bj][m][n] * w; } }
                asm volatile("" ::: "memory"); }
    }
};

template <class Epi, class Sched, bool GATHER>
__device__ __forceinline__ void gemm_phase(LAS unsigned char* lds, const bf16* A, const bf16* Bt, const int K, const Sched& S, const Epi& E, const int* glist) {
    int tid_ = threadIdx.x; asm volatile("" : "+v"(tid_));
    const int tid = tid_, wid = __builtin_amdgcn_readfirstlane(tid >> 6), lane = tid & 63, wr = wid >> 2, wc = wid & 3, fr = lane & 15, fq = lane >> 4;
    const int nt = K / BK;
    unsigned voffA[2], voffB[2]; int gR[2], gC[2];
#pragma unroll
    for (int i = 0; i < 2; ++i) { int R, C; stage_rc(tid * 16 + i * 8192, R, C); const int Rb = Epi::PERM ? ((R & ~31) + perm32(R & 31)) : R;
        voffA[i] = (unsigned)(R * K + C) * 2u; voffB[i] = (unsigned)(Rb * K + C) * 2u; gR[i] = R; gC[i] = C; }
    const size_t kstep = (size_t)(BK * 2);
    const size_t hstep = (size_t)HALF * K * 2;
    const size_t tstep = 2 * hstep;
    const unsigned ldsw = (unsigned)wid * 1024u;
    const int aoff = lds_byte(wr * 64 + fr, fq * 8), boff = lds_byte(wc * 32 + fr, fq * 8);
#define PG8_SA(b, h) (((b) * 2 + (h)) * HTB)
#define PG8_SB(b, h) ((4 + (b) * 2 + (h)) * HTB)
#define PG8_STAGE(bufoff, gbase, voff) do { _Pragma("unroll") for (int _i = 0; _i < 2; ++_i) \
        __builtin_amdgcn_global_load_lds((const unsigned*)((const char*)(gbase) + (voff)[_i]), (LAS unsigned*)(lds + (bufoff) + ldsw + _i * 8192), 16, 0, 0); } while (0)
#define PG8_STAGE_A(b, h, ubase, koff, OFFS) do { if constexpr (GATHER) { PG8_STAGE(PG8_SA(b, h), (const char*)A + (koff), (OFFS)[h]); } \
        else { PG8_STAGE(PG8_SA(b, h), (ubase) + (size_t)(h) * hstep + (koff), voffA); } } while (0)
#define PG8_LDA(dst, b, h) do { _Pragma("unroll") for (int m = 0; m < 4; ++m) _Pragma("unroll") for (int k = 0; k < 2; ++k) dst[m][k] = *(const LAS bf16x8*)(lds + PG8_SA(b, h) + aoff + m * 2048 + k * 1024); } while (0)
#define PG8_LDB(dst, b, h) do { _Pragma("unroll") for (int n = 0; n < 2; ++n) _Pragma("unroll") for (int k = 0; k < 2; ++k) dst[n][k] = *(const LAS bf16x8*)(lds + PG8_SB(b, h) + boff + n * 2048 + k * 1024); } while (0)
#define PG8_MMA(ai, bj, At, Bt_) do { __builtin_amdgcn_s_setprio(1); _Pragma("unroll") for (int m = 0; m < 4; ++m) _Pragma("unroll") for (int n = 0; n < 2; ++n) _Pragma("unroll") for (int k = 0; k < 2; ++k) \
        acc[ai][bj][m][n] = __builtin_amdgcn_mfma_f32_16x16x32_bf16(Bt_[n][k], At[m][k], acc[ai][bj][m][n], 0, 0, 0); __builtin_amdgcn_s_setprio(0); } while (0)
#define PG8_WAIT_V(n) asm volatile("s_waitcnt vmcnt(" #n ")" ::: "memory")
#define PG8_WAIT_L(n) asm volatile("s_waitcnt lgkmcnt(" #n ")" ::: "memory")
#define PG8_BAR __builtin_amdgcn_s_barrier()
#define PG8_SCHED __builtin_amdgcn_sched_barrier(0)
#define PG8_GOFF(dst, U) do { _Pragma("unroll") for (int _h = 0; _h < 2; ++_h) _Pragma("unroll") for (int _i = 0; _i < 2; ++_i) { const int _row = _h * HALF + gR[_i]; \
        const int _tk = (_row < (U).vr) ? glist[(U).lbase + _row] : 0; dst[_h][_i] = (unsigned)(_tk * K + gC[_i]) * 2u; } } while (0)
    Unit cur, nxt; int ui = 0;
    if (!S.next(0, cur)) return;
    f32x4 acc[2][2][4][2];
#pragma unroll
    for (int a = 0; a < 2; ++a)
#pragma unroll
        for (int b = 0; b < 2; ++b)
#pragma unroll
            for (int m = 0; m < 4; ++m)
#pragma unroll
                for (int n = 0; n < 2; ++n) acc[a][b][m][n] = (f32x4){0.f, 0.f, 0.f, 0.f};
    bf16x8 At[4][2], B0[2][2], B1[2][2];
    unsigned gofc[2][2] = {{0u, 0u}, {0u, 0u}}, gofn[2][2] = {{0u, 0u}, {0u, 0u}};
    if constexpr (GATHER) { PG8_GOFF(gofc, cur); }
    const char* cA = (const char*)A + (size_t)cur.pm * tstep; const char* cB = (const char*)Bt + (size_t)cur.pn * tstep;
    PG8_STAGE(PG8_SB(0, 0), cB, voffB); PG8_STAGE(PG8_SB(0, 1), cB + hstep, voffB); PG8_STAGE_A(0, 0, cA, 0, gofc); PG8_STAGE_A(0, 1, cA, 0, gofc);
    if (wr == 1) PG8_BAR;
    PG8_WAIT_V(2); PG8_BAR;
    PG8_STAGE(PG8_SB(1, 0), cB + kstep, voffB); PG8_STAGE_A(1, 0, cA, kstep, gofc); PG8_STAGE(PG8_SB(1, 1), cB + hstep + kstep, voffB);
    PG8_WAIT_V(6); PG8_BAR;
    for (;;) {
        const bool has_next = S.next(ui + 1, nxt);
        const char* nA = has_next ? (const char*)A + (size_t)nxt.pm * tstep : cA; const char* nB = has_next ? (const char*)Bt + (size_t)nxt.pn * tstep : cB;
        if constexpr (GATHER) { if (has_next) { PG8_GOFF(gofn, nxt); } else {
#pragma unroll
            for (int h = 0; h < 2; ++h)
#pragma unroll
                for (int i = 0; i < 2; ++i) gofn[h][i] = gofc[h][i]; } }
        for (int t = 0; t < nt; t += 2) {
            const bool last = (t == nt - 2);
            const size_t k1 = (size_t)(t + 1) * kstep;
            const char* ua2 = last ? nA : cA; const size_t k2 = last ? 0 : (size_t)(t + 2) * kstep; const size_t k3 = k2 + kstep;
            const char* b2 = last ? nB : cB + (size_t)(t + 2) * kstep; const char* b3 = b2 + kstep;
            unsigned go2[2][2];
#pragma unroll
            for (int h = 0; h < 2; ++h)
#pragma unroll
                for (int i = 0; i < 2; ++i) go2[h][i] = last ? gofn[h][i] : gofc[h][i];
            PG8_LDB(B0, 0, 0); PG8_LDB(B1, 0, 1); PG8_SCHED; PG8_LDA(At, 0, 0); PG8_STAGE_A(1, 1, cA, k1, gofc);
            PG8_WAIT_V(8); PG8_WAIT_L(0); PG8_BAR; PG8_MMA(0, 0, At, B0); PG8_MMA(0, 1, At, B1); PG8_BAR; PG8_SCHED;
            PG8_LDA(At, 0, 1); PG8_STAGE(PG8_SB(0, 0), b2, voffB); PG8_STAGE(PG8_SB(0, 1), b2 + hstep, voffB); PG8_STAGE_A(0, 0, ua2, k2, go2);
            PG8_WAIT_V(8); PG8_WAIT_L(0); PG8_BAR; PG8_MMA(1, 0, At, B0); PG8_MMA(1, 1, At, B1); PG8_BAR; PG8_SCHED;
            PG8_LDB(B0, 1, 0); PG8_LDB(B1, 1, 1); PG8_SCHED; PG8_LDA(At, 1, 0); PG8_STAGE_A(0, 1, ua2, k2, go2);
            PG8_WAIT_V(8); PG8_WAIT_L(0); PG8_BAR; PG8_MMA(0, 0, At, B0); PG8_MMA(0, 1, At, B1); PG8_BAR; PG8_SCHED;
            PG8_LDA(At, 1, 1); PG8_STAGE(PG8_SB(1, 0), b3, voffB); PG8_STAGE(PG8_SB(1, 1), b3 + hstep, voffB); PG8_STAGE_A(1, 0, ua2, k3, go2);
            PG8_WAIT_V(8); PG8_WAIT_L(0); PG8_BAR; PG8_MMA(1, 0, At, B0); PG8_MMA(1, 1, At, B1); PG8_BAR; PG8_SCHED;
        }
        if (wr == 0) PG8_BAR;
        E(acc, cur, wr, wc, fr, fq);
        if (!has_next) break;
#pragma unroll
        for (int a = 0; a < 2; ++a)
#pragma unroll
            for (int b = 0; b < 2; ++b)
#pragma unroll
                for (int m = 0; m < 4; ++m)
#pragma unroll
                    for (int n = 0; n < 2; ++n) acc[a][b][m][n] = (f32x4){0.f, 0.f, 0.f, 0.f};
        cur = nxt; cA = nA; cB = nB; ++ui;
#pragma unroll
        for (int h = 0; h < 2; ++h)
#pragma unroll
            for (int i = 0; i < 2; ++i) gofc[h][i] = gofn[h][i];
        if (wr == 1) PG8_BAR;
    }
    PG8_WAIT_V(0);
    PG8_BAR;
#undef PG8_SA
#undef PG8_SB
#undef PG8_STAGE
#undef PG8_STAGE_A
#undef PG8_LDA
#undef PG8_LDB
#undef PG8_MMA
#undef PG8_WAIT_V
#undef PG8_WAIT_L
#undef PG8_BAR
#undef PG8_SCHED
#undef PG8_GOFF
}
}

#define XB_TMO      128
#define XB_XCNT(j)  (256  + 64 * (j))
#define XB_XSUB(j)  (1280 + 64 * (j))
#define XB_XGEN(j)  (2304 + 64 * (j))
#define XB_TOP      3328
#define XB_TOPGEN   3392
#define XCD_BAR_WORDS 3456
#define XB_SPIN_CAP (1u << 18)
__device__ __forceinline__ unsigned xb_ld(unsigned* p)              { return __hip_atomic_load(p, __ATOMIC_RELAXED, __HIP_MEMORY_SCOPE_AGENT); }
__device__ __forceinline__ unsigned xb_add(unsigned* p, unsigned v) { return __hip_atomic_fetch_add(p, v, __ATOMIC_RELAXED, __HIP_MEMORY_SCOPE_AGENT); }
__device__ __forceinline__ unsigned xb_xcc_id() { return (unsigned)__builtin_amdgcn_s_getreg((3 << 11) | 20) & 0xFu; }
#define XB_SPIN(cond, bar) do { unsigned _sp = 0; while (cond) { __builtin_amdgcn_s_sleep(1); \
    if ((++_sp & 255u) == 0u) { if (xb_ld(&(bar)[XB_TMO])) break; if (_sp > XB_SPIN_CAP) { atomicAdd(&(bar)[XB_TMO], 1u); break; } } } } while (0)
struct XcdBarrier { unsigned* bar; unsigned x; volatile LAS unsigned* st; };
__device__ __forceinline__ XcdBarrier xcd_barrier_post(unsigned* bar, volatile LAS unsigned* st) {
    XcdBarrier b; b.bar = bar; b.x = xb_xcc_id(); b.st = st;
    if (threadIdx.x == 0) (void)xb_add(&bar[XB_XCNT(b.x)], 1u);
    return b;
}
__device__ __forceinline__ void xcd_barrier_complete(unsigned* bar, unsigned x, unsigned& nloc, unsigned& nx) {
    const unsigned G = gridDim.x * gridDim.y * gridDim.z;
    unsigned sum, cnt, mine, sp = 0u;
    for (;;) {
        sum = 0u; cnt = 0u; mine = 0u;
#pragma unroll
        for (unsigned j = 0; j < 16; ++j) { const unsigned c = xb_ld(&bar[XB_XCNT(j)]); sum += c; cnt += (c > 0u) ? 1u : 0u; mine = (j == x) ? c : mine; }
        if (sum == G) break;
        __builtin_amdgcn_s_sleep(1);
        if ((++sp & 255u) == 0u) { if (xb_ld(&bar[XB_TMO])) break; if (sp > XB_SPIN_CAP) { atomicAdd(&bar[XB_TMO], 1u); break; } }
    }
    nloc = mine > 0u ? mine : 1u; nx = cnt > 0u ? cnt : 1u;
}
__device__ __forceinline__ void xcd_barrier(const XcdBarrier& b) {
    asm volatile("s_waitcnt vmcnt(0)" ::: "memory");
    __syncthreads();
    if (threadIdx.x == 0) {
        unsigned* bar = b.bar;
        __builtin_amdgcn_s_waitcnt(0);
        unsigned nloc = b.st[0], nx = b.st[1];
        if (nloc == 0u) { xcd_barrier_complete(bar, b.x, nloc, nx); b.st[0] = nloc; b.st[1] = nx; }
        const unsigned old = xb_add(&bar[XB_XSUB(b.x)], 1u);
        const unsigned gen = old / nloc;
        if (old + 1u == (gen + 1u) * nloc) {
            __builtin_amdgcn_fence(__ATOMIC_RELEASE, "agent");
            asm volatile("s_waitcnt vmcnt(0)" ::: "memory");
            const unsigned og = xb_add(&bar[XB_TOP], 1u);
            const unsigned tg = og / nx;
            if (og + 1u == (tg + 1u) * nx) xb_add(&bar[XB_TOPGEN], 1u);
            else XB_SPIN(xb_ld(&bar[XB_TOPGEN]) == tg, bar);
            __builtin_amdgcn_fence(__ATOMIC_ACQUIRE, "agent");
            xb_add(&bar[XB_XGEN(b.x)], 1u);
            asm volatile("s_waitcnt vmcnt(0)" ::: "memory");
        } else {
            XB_SPIN(xb_ld(&bar[XB_XGEN(b.x)]) == gen, bar);
            __builtin_amdgcn_fence(__ATOMIC_ACQUIRE, "agent");
            asm volatile("s_waitcnt vmcnt(0)" ::: "memory");
        }
    }
    __syncthreads();
}


struct Frame {
    LAS unsigned char* lds;
    volatile LAS unsigned* MISC;
    unsigned* ctl;
    int tid, lane, wave, G, bid;
    const float* const* in;
    float* out; unsigned char* ws;
};

template <class P> __device__ __forceinline__ P lptr(P p) { unsigned long long v = (unsigned long long)p; unsigned lo = (unsigned)v, hi = (unsigned)(v >> 32); asm volatile("" : "+v"(lo), "+v"(hi));
    lo = __builtin_amdgcn_readfirstlane(lo); hi = __builtin_amdgcn_readfirstlane(hi); return (P)(((unsigned long long)hi << 32) | lo); }
__device__ __forceinline__ Frame opq(Frame F) { asm volatile("" : "+v"(F.tid));  F.lane = F.tid & 63; F.wave = __builtin_amdgcn_readfirstlane(F.tid >> 6); return F; }

template <bool TA, bool TB>
__device__ __forceinline__ f32x4 mm16(const LAS float* A, int lda, const LAS float* B, int ldb, int i0, int j0, int K, f32x4 acc, int lane) {
    const int lr = lane & 15, lg = lane >> 4;
    for (int ks = 0; ks < K; ks += 4) {
        const int k = ks + lg;
        const float a = TA ? A[k * lda + i0 + lr] : A[(i0 + lr) * lda + k];
        const float b = TB ? B[(j0 + lr) * ldb + k] : B[k * ldb + j0 + lr];
        acc = __builtin_amdgcn_mfma_f32_16x16x4f32(a, b, acc, 0, 0, 0);
    }
    asm volatile("s_nop 15\n\ts_nop 7" : "+v"(acc));
    return acc;
}

template <bool TA, bool TB>
__device__ __forceinline__ f32x4 mm16b(const LAS float* A, int lda, const LAS float* B, int ldb, int i0, int j0, int K, f32x4 acc, int lane) {
    const int lr = lane & 15, lg = lane >> 4;
    for (int ks = 0; ks < K; ks += 32) {
        const int k0 = ks + 8 * lg; const bool in = k0 < K;
        f32x4 a0 = (f32x4){0.f, 0.f, 0.f, 0.f}, a1 = a0, b0 = a0, b1 = a0;
        if (in) {
            if (TA) { const LAS float* p = A + k0 * lda + i0 + lr; a0 = (f32x4){p[0], p[lda], p[2 * lda], p[3 * lda]}; a1 = (f32x4){p[4 * lda], p[5 * lda], p[6 * lda], p[7 * lda]}; }
            else { const LAS float* p = A + (i0 + lr) * lda + k0; a0 = *(const LAS f32x4*)p; a1 = *(const LAS f32x4*)(p + 4); }
            if (TB) { const LAS float* p = B + (j0 + lr) * ldb + k0; b0 = *(const LAS f32x4*)p; b1 = *(const LAS f32x4*)(p + 4); }
            else { const LAS float* p = B + k0 * ldb + j0 + lr; b0 = (f32x4){p[0], p[ldb], p[2 * ldb], p[3 * ldb]}; b1 = (f32x4){p[4 * ldb], p[5 * ldb], p[6 * ldb], p[7 * ldb]}; }
        }
        u32x4 aw, bw;
        aw.x = pg8::cvt_pk_bf16(a0.x, a0.y); aw.y = pg8::cvt_pk_bf16(a0.z, a0.w); aw.z = pg8::cvt_pk_bf16(a1.x, a1.y); aw.w = pg8::cvt_pk_bf16(a1.z, a1.w);
        bw.x = pg8::cvt_pk_bf16(b0.x, b0.y); bw.y = pg8::cvt_pk_bf16(b0.z, b0.w); bw.z = pg8::cvt_pk_bf16(b1.x, b1.y); bw.w = pg8::cvt_pk_bf16(b1.z, b1.w);
        acc = __builtin_amdgcn_mfma_f32_16x16x32_bf16(__builtin_bit_cast(bf16x8, aw), __builtin_bit_cast(bf16x8, bw), acc, 0, 0, 0);
    }
    asm volatile("s_nop 15\n\ts_nop 7" : "+v"(acc));
    return acc;
}

__device__ __forceinline__ void tr_item(const float* src, int ld, int scol, bf16* WT, int K, int r0, int k0, LAS float* scr, int lane) {
#pragma unroll 8
    for (int i = 0; i < 32; ++i) { const int kk = 2 * i + (lane >> 5); const float v = scol >= 0 ? src[(size_t)(k0 + kk) * ld + scol] : 0.f; scr[kk * 33 + (lane & 31)] = v; }
    LDS_WAIT(); asm volatile("" ::: "memory");
    const int c = lane & 7;
#pragma unroll
    for (int j = 0; j < 4; ++j) { const int n = (lane >> 3) + 8 * j; const LAS float* s = scr + (8 * c) * 33 + n;
        u32x4 o; o.x = pk2(s[0 * 33], s[1 * 33]); o.y = pk2(s[2 * 33], s[3 * 33]); o.z = pk2(s[4 * 33], s[5 * 33]); o.w = pk2(s[6 * 33], s[7 * 33]);
        *(u32x4*)(WT + (size_t)(r0 + n) * K + k0 + 8 * c) = o; }
    LDS_WAIT(); asm volatile("" ::: "memory");
}

__device__ __forceinline__ void tr_tile64(const float* src, int ld, int col0, bf16* WT, int K, int r0, int k0, LAS unsigned* scr, int lane) {
    const int kp = lane >> 4, n4 = (lane & 15) * 4;
    const float* p = src + (size_t)k0 * ld + col0 + n4;
    f32x4 va[8], vb[8];
#pragma unroll
    for (int i = 0; i < 8; ++i) { const int k = 2 * (4 * i + kp); va[i] = *(const f32x4*)(p + (size_t)k * ld); vb[i] = *(const f32x4*)(p + (size_t)(k + 1) * ld); }
#pragma unroll
    for (int i = 0; i < 8; ++i) { const int kk = 4 * i + kp;
        scr[(n4 + 0) * 33 + kk] = pk2(va[i].x, vb[i].x); scr[(n4 + 1) * 33 + kk] = pk2(va[i].y, vb[i].y); scr[(n4 + 2) * 33 + kk] = pk2(va[i].z, vb[i].z); scr[(n4 + 3) * 33 + kk] = pk2(va[i].w, vb[i].w); }
    LDS_WAIT(); asm volatile("" ::: "memory");
    const int c = lane & 7;
#pragma unroll
    for (int j = 0; j < 8; ++j) { const int n = 8 * j + (lane >> 3); const LAS unsigned* q = scr + n * 33 + 4 * c;
        u32x4 o; o.x = q[0]; o.y = q[1]; o.z = q[2]; o.w = q[3];
        *(u32x4*)(WT + (size_t)(r0 + n) * K + k0 + 8 * c) = o; }
    LDS_WAIT(); asm volatile("" ::: "memory");
}

__device__ __forceinline__ void norm_row(const float* xrow, const f32x4 (&g)[4], bf16* orow, f32x4 (&v)[4], int lane) {
    const f32x4* xr = (const f32x4*)xrow + lane; float s = 0.f;
#pragma unroll
    for (int j = 0; j < 4; ++j) { v[j] = xr[64 * j]; s += (v[j].x * v[j].x + v[j].y * v[j].y) + (v[j].z * v[j].z + v[j].w * v[j].w); }
    const float r = 1.0f / sqrtf(wave_sum(s) * (1.f / D) + EPS);
    unsigned long long* o8 = (unsigned long long*)orow + lane;
#pragma unroll
    for (int j = 0; j < 4; ++j) { v[j] = v[j] * r * g[j]; o8[64 * j] = (unsigned long long)pk2(v[j].x, v[j].y) | ((unsigned long long)pk2(v[j].z, v[j].w) << 32); }
}

__device__ __forceinline__ void p0_prologue(const Frame& F0) { Frame F = opq(F0);
    LAS float* scr = (LAS float*)(F.lds + F.wave * 16384);
    const int gw = F.bid * NWAVES + F.wave, NGW = F.G * NWAVES;
    const float* w_in = F.in[2]; const float* w_out = F.in[20]; const float* fg = F.in[22]; const float* fu = F.in[23]; const float* fd = F.in[24];
    bf16* Win = (bf16*)(F.ws + WS_WIN); bf16* Wout = (bf16*)(F.ws + WS_WOUT); bf16* Wgu = (bf16*)(F.ws + WS_WGU); bf16* Wd = (bf16*)(F.ws + WS_WD);
    constexpr int I_IN = 2 * 16 * 48, I_INT = 2 * 16 * 8, I_OUT = 2 * 16 * 16, I_GU = 16 * 88, I_D = 44 * 16;
    const int j = F.lane & 31; LAS unsigned* scru = (LAS unsigned*)scr;
    for (int it = gw; it < I_IN + I_INT + I_OUT + I_GU + I_D; it += NGW) {
        int r = it;
        if (r < I_IN) { const int l = r / (16 * 48), q = r % (16 * 48), kb = q / 48, nb = q % 48, n0 = 64 * nb;
            tr_tile64(w_in + (size_t)l * D * 3096, 3096, n0 < 1024 ? n0 : n0 + 8, Win + (size_t)l * NIN * D, D, n0, 64 * kb, scru, F.lane); continue; }
        r -= I_IN;
        if (r < I_INT) { const int l = r / (16 * 8), q = r % (16 * 8), kb = q / 8, nb = 96 + q % 8, n = 32 * nb + j;
            const int scol = n < 3080 ? n - 2048 : n < 3096 ? n : -1;
            tr_item(w_in + (size_t)l * D * 3096, 3096, scol, Win + (size_t)l * NIN * D, D, 32 * nb, 64 * kb, scr, F.lane); continue; }
        r -= I_INT;
        if (r < I_OUT) { const int l = r / 256, q = r % 256, kb = q / 16, nb = q % 16;
            tr_tile64(w_out + (size_t)l * D * D, D, 64 * nb, Wout + (size_t)l * D * D, D, 64 * nb, 64 * kb, scru, F.lane); continue; }
        r -= I_OUT;
        if (r < I_GU) { const int kb = r / 88, nb = r % 88, r0 = 64 * nb, pn = r0 >> 8, j0 = r0 & 255;
            tr_tile64(j0 < 128 ? fg : fu, DFF, pn * 128 + (j0 & 127), Wgu, D, r0, 64 * kb, scru, F.lane); continue; }
        r -= I_GU;
        { const int kb = r / 16, nb = r % 16; tr_tile64(fd, D, 64 * nb, Wd, DFF, 64 * nb, 64 * kb, scru, F.lane); }
    }
    f32x4 g[4];
#pragma unroll
    for (int q = 0; q < 4; ++q) g[q] = ((const f32x4*)F.in[1])[F.lane + 64 * q];
    bf16* H = (bf16*)(F.ws + WS_HM);
    for (int m = gw; m < T; m += NGW) { f32x4 v[4]; norm_row(F.in[0] + (size_t)m * D, g, H + (size_t)m * D, v, F.lane); }
}
__device__ __forceinline__ void moe_convert(const Frame& F0) { Frame F = opq(F0);
    LAS float* scr = (LAS float*)(F.lds + F.wave * 16384);
    const int gw = F.bid * NWAVES + F.wave, NGW = F.G * NWAVES;
    const float* mg = F.in[26]; const float* mu = F.in[27]; const float* md = F.in[28];
    bf16* Wgu = (bf16*)(F.ws + WS_MOEW_GU); bf16* Wd = (bf16*)(F.ws + WS_MOEW_D);
    constexpr int I_GU = 16 * 112, I_D = 56 * 16;
    LAS unsigned* scru = (LAS unsigned*)scr;
    for (int it = gw; it < NE * (I_GU + I_D); it += NGW) {
        const int e = it / (I_GU + I_D); int r = it % (I_GU + I_D);
        if (r < I_GU) { const int kb = r / 112, nb = r % 112, r0 = 64 * nb, pn = r0 >> 8, j0 = r0 & 255;
            tr_tile64((j0 < 128 ? mg : mu) + (size_t)e * D * DFE, DFE, pn * 128 + (j0 & 127), Wgu + (size_t)e * 7168 * D, D, r0, 64 * kb, scru, F.lane); continue; }
        r -= I_GU;
        { const int kb = r / 16, nb = r % 16; tr_tile64(md + (size_t)e * DFE * D, D, 64 * nb, Wd + (size_t)e * D * DFE, DFE, 64 * nb, 64 * kb, scru, F.lane); }
    }
}

__device__ __forceinline__ void norm_phase(const Frame& F0, const float* x, const float* gain) { Frame F = opq(F0);
    const int gw = F.bid * NWAVES + F.wave, NGW = F.G * NWAVES;
    f32x4 g[4];
#pragma unroll
    for (int q = 0; q < 4; ++q) g[q] = ((const f32x4*)gain)[F.lane + 64 * q];
    bf16* H = (bf16*)(F.ws + WS_HM);
    for (int m = gw; m < T; m += NGW) { f32x4 v[4]; norm_row(x + (size_t)m * D, g, H + (size_t)m * D, v, F.lane); }
}
__device__ __forceinline__ void norm_router_phase(const Frame& F0, const float* x, const float* gain, const float* wr) { Frame F = opq(F0);
    LAS float* WR = (LAS float*)F.lds;
    LAS int* lcnt = (LAS int*)(F.lds + 32768);
    LAS int* lbase = lcnt + 16;
    LAS int* rE = lbase + 16;
    LAS int* rP1 = rE + 128; LAS int* rP2 = rP1 + 128;
    LAS float* rW = (LAS float*)(rP2 + 128);
    f32x4 g[4];
#pragma unroll
    for (int q = 0; q < 4; ++q) g[q] = ((const f32x4*)gain)[F.lane + 64 * q];
    for (int i = F.tid; i < 2048; i += NTHR) ((LAS f32x4*)WR)[i] = ((const f32x4*)wr)[i];
    bf16* H = (bf16*)(F.ws + WS_HM);
    int* stok = (int*)(F.ws + WS_STOK); float* sw = (float*)(F.ws + WS_SW);
    unsigned* gcnt = F.ctl + CW_MOECNT;
    for (int blk = F.bid; blk < T / 128; blk += F.G) {
        if (F.tid < 16) lcnt[F.tid] = 0;
        __syncthreads();
        f32x4 nv[4];
        { const f32x4* xr = (const f32x4*)(x + (size_t)(blk * 128 + F.wave * 16) * D) + F.lane;
#pragma unroll
            for (int q = 0; q < 4; ++q) nv[q] = xr[64 * q]; }
        for (int rr = 0; rr < 16; ++rr) {
            const int rl = F.wave * 16 + rr, m = blk * 128 + rl;
            f32x4 v[4];
#pragma unroll
            for (int q = 0; q < 4; ++q) v[q] = nv[q];
            if (rr + 1 < 16) { const f32x4* xr = (const f32x4*)(x + (size_t)(m + 1) * D) + F.lane;
#pragma unroll
                for (int q = 0; q < 4; ++q) nv[q] = xr[64 * q]; }
            float ss = 0.f, lg[8];
#pragma unroll
            for (int e = 0; e < 8; ++e) lg[e] = 0.f;
#pragma unroll
            for (int q = 0; q < 4; ++q) { ss += (v[q].x * v[q].x + v[q].y * v[q].y) + (v[q].z * v[q].z + v[q].w * v[q].w); v[q] = v[q] * g[q];
#pragma unroll
                for (int c = 0; c < 4; ++c) { const int k = 4 * (F.lane + 64 * q) + c; const f32x4 w0 = *(const LAS f32x4*)(WR + k * 8), w1 = *(const LAS f32x4*)(WR + k * 8 + 4); const float hv = v[q][c];
                    lg[0] += hv * w0.x; lg[1] += hv * w0.y; lg[2] += hv * w0.z; lg[3] += hv * w0.w; lg[4] += hv * w1.x; lg[5] += hv * w1.y; lg[6] += hv * w1.z; lg[7] += hv * w1.w; } }
            const float rinv = 1.0f / sqrtf(wave_sum(ss) * (1.f / D) + EPS);
            { unsigned long long* o8 = (unsigned long long*)(H + (size_t)m * D) + F.lane;
#pragma unroll
                for (int q = 0; q < 4; ++q) { const f32x4 hq = v[q] * rinv; o8[64 * q] = (unsigned long long)pk2(hq.x, hq.y) | ((unsigned long long)pk2(hq.z, hq.w) << 32); } }
#pragma unroll
            for (int e = 0; e < 8; ++e) lg[e] = wave_sum(lg[e]) * rinv;
            if (F.lane == 0) {
                int e1 = 0; float l1 = lg[0];
#pragma unroll
                for (int e = 1; e < 8; ++e) if (lg[e] > l1) { l1 = lg[e]; e1 = e; }
                int e2 = -1; float l2 = -3.0e38f;
#pragma unroll
                for (int e = 0; e < 8; ++e) if (e != e1 && lg[e] > l2) { l2 = lg[e]; e2 = e; }
                const float w1 = 1.0f / (1.0f + __expf(l2 - l1));
                rE[rl] = e1 | (e2 << 8); rW[rl] = w1;
                rP1[rl] = __hip_atomic_fetch_add(lcnt + e1, 1, __ATOMIC_RELAXED, __HIP_MEMORY_SCOPE_WORKGROUP);
                rP2[rl] = __hip_atomic_fetch_add(lcnt + 8 + e2, 1, __ATOMIC_RELAXED, __HIP_MEMORY_SCOPE_WORKGROUP);
            }
        }
        __syncthreads();
        if (F.tid < 16) lbase[F.tid] = (int)__hip_atomic_fetch_add(gcnt + F.tid, (unsigned)lcnt[F.tid], __ATOMIC_RELAXED, __HIP_MEMORY_SCOPE_AGENT);
        __syncthreads();
        if (F.tid < 128) { const int m = blk * 128 + F.tid, e1 = rE[F.tid] & 255, e2 = rE[F.tid] >> 8; const float w1 = rW[F.tid];
            const int s1 = e1 * T + lbase[e1] + rP1[F.tid], s2 = (8 + e2) * T + lbase[8 + e2] + rP2[F.tid];
            stok[s1] = m; sw[s1] = w1; stok[s2] = m; sw[s2] = 1.0f - w1; }
        __syncthreads();
    }
}
__device__ __forceinline__ void final_norm_phase(const Frame& F0, float* x, const float* gain) { Frame F = opq(F0);
    const int gw = F.bid * NWAVES + F.wave, NGW = F.G * NWAVES;
    f32x4 g[4];
#pragma unroll
    for (int q = 0; q < 4; ++q) g[q] = ((const f32x4*)gain)[F.lane + 64 * q];
    for (int m = gw; m < T; m += NGW) {
        f32x4* xr = (f32x4*)(x + (size_t)m * D) + F.lane; f32x4 v[4]; float s = 0.f;
#pragma unroll
        for (int j = 0; j < 4; ++j) { v[j] = xr[64 * j]; s += (v[j].x * v[j].x + v[j].y * v[j].y) + (v[j].z * v[j].z + v[j].w * v[j].w); }
        const float r = 1.0f / sqrtf(wave_sum(s) * (1.f / D) + EPS);
#pragma unroll
        for (int j = 0; j < 4; ++j) xr[64 * j] = v[j] * r * g[j];
    }
}

constexpr int LD = 68;
constexpr int MATF = 64 * LD;

__device__ __forceinline__ void ld8(const bf16* p, float (&o)[8]) { const u32x4 w = *(const u32x4*)p; o[0] = bflo(w.x); o[1] = bfhi(w.x); o[2] = bflo(w.y); o[3] = bfhi(w.y); o[4] = bflo(w.z); o[5] = bfhi(w.z); o[6] = bflo(w.w); o[7] = bfhi(w.w); }

__device__ __forceinline__ void conv8(const bf16* PROJ, int b, int tpos  , int col, const float* cw, int cwld, int c0, float (&y)[8]) {
#pragma unroll
    for (int e = 0; e < 8; ++e) y[e] = 0.f;
#pragma unroll
    for (int j = 0; j < 4; ++j) { const int tp = tpos - 3 + j;
        if (tp >= 0) { float xv[8]; ld8(PROJ + (size_t)(b * SEQ + tp) * PP + col, xv);
            const f32x4 w0 = *(const f32x4*)(cw + j * cwld + c0), w1 = *(const f32x4*)(cw + j * cwld + c0 + 4);
            y[0] += xv[0] * w0.x; y[1] += xv[1] * w0.y; y[2] += xv[2] * w0.z; y[3] += xv[3] * w0.w; y[4] += xv[4] * w1.x; y[5] += xv[5] * w1.y; y[6] += xv[6] * w1.z; y[7] += xv[7] * w1.w; } }
}

__device__ __forceinline__ void conv8r(const u32x4 (&r)[4], const float* cw, int cwld, int c0, float (&y)[8]) {
#pragma unroll
    for (int e = 0; e < 8; ++e) y[e] = 0.f;
#pragma unroll
    for (int j = 0; j < 4; ++j) { const u32x4 w = r[j]; const float xv[8] = {bflo(w.x), bfhi(w.x), bflo(w.y), bfhi(w.y), bflo(w.z), bfhi(w.z), bflo(w.w), bfhi(w.w)};
        const f32x4 w0 = *(const f32x4*)(cw + j * cwld + c0), w1 = *(const f32x4*)(cw + j * cwld + c0 + 4);
        y[0] += xv[0] * w0.x; y[1] += xv[1] * w0.y; y[2] += xv[2] * w0.z; y[3] += xv[3] * w0.w; y[4] += xv[4] * w1.x; y[5] += xv[5] * w1.y; y[6] += xv[6] * w1.z; y[7] += xv[7] * w1.w; }
}
__device__ __forceinline__ void fetch_rows(const bf16* PROJ, int b, int tpos, int col, u32x4 (&r)[4]) {
#pragma unroll
    for (int j = 0; j < 4; ++j) { const int tp = tpos - 3 + j; r[j] = tp >= 0 ? *(const u32x4*)(PROJ + (size_t)(b * SEQ + tp) * PP + col) : (u32x4){0u, 0u, 0u, 0u}; }
}
__device__ __forceinline__ void gdn_fetch(const Frame& F, int b, int n, int h, u32x4 (&rows)[3][4]) {
    const bf16* PROJ = (const bf16*)(F.ws + WS_PROJ);
#pragma unroll
    for (int i = 0; i < 3; ++i) { const int u = F.tid + NTHR * i, grp = u % 24, t = u / 24; fetch_rows(PROJ, b, n * CH + t, (grp >> 3) * 256 + h * 64 + (grp & 7) * 8, rows[i]); }
}
__device__ __forceinline__ void rg_fetch(const Frame& F, int b, int n, int nb, u32x4 (&rows)[4]) {
    fetch_rows((const bf16*)(F.ws + WS_PROJ), b, n * CH + (F.tid >> 3), XC + nb * 64 + 8 * (F.tid & 7), rows);
}
struct GlaIn { u32x4 v, qk; f32x4 lr; };
__device__ __forceinline__ void gla_fetch(const Frame& F, int b, int n, int h, GlaIn& g) {
    const bf16* PROJ = (const bf16*)(F.ws + WS_PROJ); const float* SM = (const float*)(F.ws + WS_SMALL);
    const int tok0 = b * SEQ + n * CH, t = F.tid >> 3, p = F.tid & 7;
    g.v = *(const u32x4*)(PROJ + (size_t)(tok0 + t) * PP + VD + h * 64 + 8 * p);
    g.qk = *(const u32x4*)(PROJ + (size_t)(tok0 + t) * PP + (p < 4 ? QD + h * 32 + 8 * p : KD + h * 32 + 8 * (p - 4)));
    g.lr = F.tid < 256 ? *(const f32x4*)(SM + (size_t)(tok0 + (F.tid >> 2)) * 32 + 8 + 4 * (F.tid & 3)) : (f32x4){0.f, 0.f, 0.f, 0.f};
}
__device__ __forceinline__ void unpack8(const u32x4 w, float (&o)[8]) { o[0] = bflo(w.x); o[1] = bfhi(w.x); o[2] = bflo(w.y); o[3] = bfhi(w.y); o[4] = bflo(w.z); o[5] = bfhi(w.z); o[6] = bflo(w.w); o[7] = bfhi(w.w); }

__device__ __forceinline__ void gdn_prep(const Frame& F0, int l, int b, int n, int h, const u32x4 (&rows)[3][4]) { Frame F = opq(F0);
    LAS float* Q = (LAS float*)F.lds; LAS float* Kk = Q + MATF; LAS float* UT = Kk + MATF; LAS float* WT = UT + MATF; LAS float* A = WT + MATF; LAS float* AQ = A + MATF; LAS float* KDT = AQ + MATF;
    LAS float* sBeta = KDT + MATF; LAS float* sG = sBeta + 64;
    const float* SM = (const float*)(F.ws + WS_SMALL);
    const float* cw = F.in[3] + (size_t)l * 4 * 768;
    const int tok0 = b * SEQ + n * CH, ch = ((b * NCH + n) * 4 + h);
#pragma unroll
    for (int i = 0; i < 3; ++i) { const int u = F.tid + NTHR * i, grp = u % 24, t = u / 24, which = grp >> 3, d0 = (grp & 7) * 8, c0 = which * 256 + h * 64 + d0;
        float y[8]; conv8r(rows[i], cw, 768, c0, y);
        if (which < 2) { LAS float* dst = (which == 0 ? Q : Kk) + t * LD + d0;
            *(LAS f32x4*)dst = (f32x4){siluf_(y[0]), siluf_(y[1]), siluf_(y[2]), siluf_(y[3])}; *(LAS f32x4*)(dst + 4) = (f32x4){siluf_(y[4]), siluf_(y[5]), siluf_(y[6]), siluf_(y[7])}; }
        else {
#pragma unroll
            for (int e = 0; e < 8; ++e) UT[(d0 + e) * LD + t] = siluf_(y[e]); } }
    if (F.wave == 0) { const int t = F.lane; const float bl = SM[(size_t)(tok0 + t) * 32 + h], al = SM[(size_t)(tok0 + t) * 32 + 4 + h];
        float g = -__expf(F.in[4][l * 4 + h]) * softplusf_(al + F.in[5][l * 4 + h]);
#pragma unroll
        for (int o = 1; o < 64; o <<= 1) { const float up = __shfl_up(g, o); if (t >= o) g += up; }
        sBeta[t] = sigmoidf_(bl); sG[t] = g; }
    __syncthreads();
    { const int t = F.tid >> 3, p = F.tid & 7; LAS float* qp = Q + t * LD + 8 * p; LAS float* kp = Kk + t * LD + 8 * p;
        f32x4 q0 = *(LAS f32x4*)qp, q1 = *(LAS f32x4*)(qp + 4), k0 = *(LAS f32x4*)kp, k1 = *(LAS f32x4*)(kp + 4);
        float sq = (q0.x * q0.x + q0.y * q0.y) + (q0.z * q0.z + q0.w * q0.w) + (q1.x * q1.x + q1.y * q1.y) + (q1.z * q1.z + q1.w * q1.w);
        float sk = (k0.x * k0.x + k0.y * k0.y) + (k0.z * k0.z + k0.w * k0.w) + (k1.x * k1.x + k1.y * k1.y) + (k1.z * k1.z + k1.w * k1.w);
#pragma unroll
        for (int o = 1; o < 8; o <<= 1) { sq += __shfl_xor(sq, o); sk += __shfl_xor(sk, o); }
        const float rq = 0.125f / sqrtf(sq + EPS), rk = 1.0f / sqrtf(sk + EPS), be = sBeta[t], eg = __expf(sG[t]);
        q0 = q0 * rq; q1 = q1 * rq; k0 = k0 * rk; k1 = k1 * rk;
        *(LAS f32x4*)qp = q0; *(LAS f32x4*)(qp + 4) = q1; *(LAS f32x4*)kp = k0; *(LAS f32x4*)(kp + 4) = k1;
        const float kw[8] = {k0.x, k0.y, k0.z, k0.w, k1.x, k1.y, k1.z, k1.w};
#pragma unroll
        for (int e = 0; e < 8; ++e) { WT[(8 * p + e) * LD + t] = kw[e] * (be * eg); UT[(8 * p + e) * LD + t] *= be; } }
    __syncthreads();
    { const int lr = F.lane & 15, lg = F.lane >> 4;
        for (int tl = F.wave; tl < 32; tl += NWAVES) { const int mat = tl >> 4, mi = (tl >> 2) & 3, ni = tl & 3; LAS float* dst = mat ? AQ : A;
            f32x4 acc = (f32x4){0.f, 0.f, 0.f, 0.f};
            if (mi >= ni) acc = mm16b<false, true>(mat ? Q : Kk, LD, Kk, LD, 16 * mi, 16 * ni, 64, acc, F.lane);
#pragma unroll
            for (int r = 0; r < 4; ++r) { const int i = 16 * mi + 4 * lg + r, j = 16 * ni + lr; float v = 0.f;
                if (mat ? (i >= j) : (i > j)) v = acc[r] * __expf(sG[i] - sG[j]) * (mat ? 1.0f : sBeta[i]);
                dst[i * LD + j] = v; } } }
    __syncthreads();
    { LAS float* TI = sG + 64; constexpr int TLD = 20;
        if (F.wave == 0) { const int blk = F.lane >> 4, c = F.lane & 15; float x[16];
#pragma unroll
            for (int r = 0; r < 16; ++r) { float v = (r == c) ? 1.0f : 0.0f;
#pragma unroll
                for (int c2 = 0; c2 < r; ++c2) v -= A[(16 * blk + r) * LD + 16 * blk + c2] * x[c2];
                x[r] = v; TI[(blk * 16 + r) * TLD + c] = v; } }
        __syncthreads();
        LAS float* XT = F.wave < 4 ? UT : WT; const int j0 = 16 * (F.wave & 3), lr = F.lane & 15, lg = F.lane >> 4;
        for (int bi = 0; bi < 4; ++bi) { LAS f32x4* xp = (LAS f32x4*)(XT + (j0 + lr) * LD + 16 * bi + 4 * lg);
            if (bi > 0) { const f32x4 acc = mm16b<false, true>(A, LD, XT, LD, 16 * bi, j0, 16 * bi, (f32x4){0.f, 0.f, 0.f, 0.f}, F.lane); *xp = *xp - acc; }
            const f32x4 xs = mm16b<false, true>(TI + bi * 16 * TLD, TLD, XT + 16 * bi, LD, 0, j0, 16, (f32x4){0.f, 0.f, 0.f, 0.f}, F.lane);
            *xp = xs; }
        __syncthreads(); }
    { const int t = F.tid >> 3, p = F.tid & 7; const float gl = sG[63], gt = sG[t], e1 = __expf(gl - gt), e2 = __expf(gt);
        LAS float* qp = Q + t * LD + 8 * p; const LAS float* kp = Kk + t * LD + 8 * p;
        *(LAS f32x4*)qp = *(LAS f32x4*)qp * e2; *(LAS f32x4*)(qp + 4) = *(LAS f32x4*)(qp + 4) * e2;
        const f32x4 k0 = *(const LAS f32x4*)kp, k1 = *(const LAS f32x4*)(kp + 4); const float kw[8] = {k0.x, k0.y, k0.z, k0.w, k1.x, k1.y, k1.z, k1.w};
#pragma unroll
        for (int e = 0; e < 8; ++e) KDT[(8 * p + e) * LD + t] = kw[e] * e1; }
    __syncthreads();
    { const int lr = F.lane & 15, lg = F.lane >> 4; const float dl = __expf(sG[63]);
        float* GM = (float*)(F.ws + WS_GM) + (size_t)ch * 4096; float* GN = (float*)(F.ws + WS_GN) + (size_t)ch * 4096;
        float* GQ = (float*)(F.ws + WS_GQ) + (size_t)ch * 4096; float* GO = (float*)(F.ws + WS_GO) + (size_t)ch * 4096;
        for (int tl = F.wave; tl < 16; tl += NWAVES) { const int mi = tl >> 2, ni = tl & 3;
            const f32x4 acc = mm16b<false, true>(KDT, LD, WT, LD, 16 * mi, 16 * ni, 64, (f32x4){0.f, 0.f, 0.f, 0.f}, F.lane);
#pragma unroll
            for (int r = 0; r < 4; ++r) { const int i = 16 * mi + 4 * lg + r, j = 16 * ni + lr, ks = j >> 2; const float v = (i == j ? dl : 0.f) - acc[r];
                GM[((mi * 4 + (ks >> 2)) * 64 + (i & 15) + 16 * (j & 3)) * 4 + (ks & 3)] = v; } }
        for (int tl = F.wave; tl < 16; tl += NWAVES) { const int mi = tl >> 2, ni = tl & 3;
            const f32x4 acc = mm16b<false, true>(KDT, LD, UT, LD, 16 * mi, 16 * ni, 64, (f32x4){0.f, 0.f, 0.f, 0.f}, F.lane);
#pragma unroll
            for (int r = 0; r < 4; ++r) GN[(16 * mi + 4 * lg + r) * 64 + 16 * ni + lr] = acc[r]; }
        for (int tl = F.wave; tl < 16; tl += NWAVES) { const int mi = tl >> 2, ni = tl & 3;
            const f32x4 acc = mm16b<false, true>(AQ, LD, WT, LD, 16 * mi, 16 * ni, 64, (f32x4){0.f, 0.f, 0.f, 0.f}, F.lane);
#pragma unroll
            for (int r = 0; r < 4; ++r) { const int i = 16 * mi + 4 * lg + r, j = 16 * ni + lr; GQ[i * 64 + j] = Q[i * LD + j] - acc[r]; } }
        for (int tl = F.wave; tl < 16; tl += NWAVES) { const int mi = tl >> 2, ni = tl & 3;
            const f32x4 acc = mm16b<false, true>(AQ, LD, UT, LD, 16 * mi, 16 * ni, 64, (f32x4){0.f, 0.f, 0.f, 0.f}, F.lane);
#pragma unroll
            for (int r = 0; r < 4; ++r) GO[(16 * mi + 4 * lg + r) * 64 + 16 * ni + lr] = acc[r]; } }
    __syncthreads();
}

__device__ __forceinline__ void gla_prep(const Frame& F0, int l, int b, int n, int h, const GlaIn& gin, bool load_w) { Frame F = opq(F0);
    constexpr int L3 = 36;
    LAS float* QE = (LAS float*)F.lds; LAS float* KE = QE + 64 * L3; LAS float* KDm = KE + 64 * L3; LAS float* Gm = KDm + 64 * L3; LAS float* V = Gm + 64 * L3; LAS float* AIN = V + MATF;
    LAS float* LR = AIN + MATF; LAS float* WL = LR + 64 * 16; LAS float* Qr = WL + 16 * 32; LAS float* Kr = Qr + 64 * L3;
    const bf16* PROJ = (const bf16*)(F.ws + WS_PROJ); const float* SM = (const float*)(F.ws + WS_SMALL);
    const int tok0 = b * SEQ + n * CH, ch = ((b * NCH + n) * 4 + h);
    { const int t = F.tid >> 3, p = F.tid & 7; float xv[8];
        unpack8(gin.v, xv);
        *(LAS f32x4*)(V + t * LD + 8 * p) = (f32x4){xv[0], xv[1], xv[2], xv[3]}; *(LAS f32x4*)(V + t * LD + 8 * p + 4) = (f32x4){xv[4], xv[5], xv[6], xv[7]};
        unpack8(gin.qk, xv);
        { LAS float* dst = (p < 4 ? Qr : Kr) + t * L3 + 8 * (p & 3); *(LAS f32x4*)dst = (f32x4){xv[0], xv[1], xv[2], xv[3]}; *(LAS f32x4*)(dst + 4) = (f32x4){xv[4], xv[5], xv[6], xv[7]}; }
        if (F.tid < 256) { const int t2 = F.tid >> 2, q4 = F.tid & 3; *(LAS f32x4*)(LR + t2 * 16 + 4 * q4) = gin.lr; }
        if (load_w) { const int r = F.tid >> 5, d = F.tid & 31; WL[r * 32 + d] = F.in[17][(size_t)l * 16 * 128 + r * 128 + h * 32 + d]; } }
    __syncthreads();
    { const int t = F.lane;
#pragma unroll
        for (int c = 0; c < 4; ++c) { const int d = F.wave * 4 + c; float s = F.in[18][l * 128 + h * 32 + d];
#pragma unroll
            for (int r = 0; r < 16; ++r) s += LR[t * 16 + r] * WL[r * 32 + d];
            float la = -softplusf_(-s) * (1.0f / 16.0f);
#pragma unroll
            for (int o = 1; o < 64; o <<= 1) { const float up = __shfl_up(la, o); if (t >= o) la += up; }
            Gm[t * L3 + d] = la; } }
    __syncthreads();
    { float* LQG = (float*)(F.ws + WS_LQG) + (size_t)ch * 2048; float* LDL = (float*)(F.ws + WS_LDL) + (size_t)ch * 32;
        const float sc = 0.17677669529663687f;
        for (int u = F.tid; u < 2048; u += NTHR) { const int t = u >> 5, d = u & 31; const float G = Gm[t * L3 + d], Gr = Gm[32 * L3 + d], Gl = Gm[63 * L3 + d];
            const float q = Qr[t * L3 + d] * sc, k = Kr[t * L3 + d];
            QE[t * L3 + d] = q * __expf(G - Gr); KE[t * L3 + d] = k * __expf(Gr - G); KDm[t * L3 + d] = k * __expf(Gl - G);
            LQG[t * 32 + d] = q * __expf(G); if (t == 63) LDL[d] = __expf(Gl); } }
    __syncthreads();
    { const int lr = F.lane & 15, lg = F.lane >> 4;
        for (int tl = F.wave; tl < 16; tl += NWAVES) { const int mi = tl >> 2, ni = tl & 3; f32x4 acc = (f32x4){0.f, 0.f, 0.f, 0.f};
            if (mi >= ni) acc = mm16b<false, true>(QE, L3, KE, L3, 16 * mi, 16 * ni, 32, acc, F.lane);
#pragma unroll
            for (int r = 0; r < 4; ++r) { const int i = 16 * mi + 4 * lg + r, j = 16 * ni + lr; AIN[i * LD + j] = (i >= j) ? acc[r] : 0.f; } } }
    __syncthreads();
    { const int lr = F.lane & 15, lg = F.lane >> 4; float* LOI = (float*)(F.ws + WS_LOI) + (size_t)ch * 4096; float* LKV = (float*)(F.ws + WS_LKV) + (size_t)ch * 2048;
        for (int tl = F.wave; tl < 16; tl += NWAVES) { const int mi = tl >> 2, ni = tl & 3;
            const f32x4 acc = mm16b<false, false>(AIN, LD, V, LD, 16 * mi, 16 * ni, 64, (f32x4){0.f, 0.f, 0.f, 0.f}, F.lane);
#pragma unroll
            for (int r = 0; r < 4; ++r) LOI[(16 * mi + 4 * lg + r) * 64 + 16 * ni + lr] = acc[r]; }
        { const int mi = F.wave >> 2, ni = F.wave & 3;
            const f32x4 acc = mm16b<true, false>(KDm, L3, V, LD, 16 * mi, 16 * ni, 64, (f32x4){0.f, 0.f, 0.f, 0.f}, F.lane);
#pragma unroll
            for (int r = 0; r < 4; ++r) LKV[(16 * mi + 4 * lg + r) * 64 + 16 * ni + lr] = acc[r]; } }
    __syncthreads();
}

__device__ __forceinline__ void rg_prep(const Frame& F0, int l, int b, int n, int nb, const u32x4 (&rows)[4], bool load_w) { Frame F = opq(F0);
    LAS float* XCm = (LAS float*)F.lds; LAS float* WA = XCm + MATF; LAS float* WX = WA + MATF; LAS float* AA = WX + MATF; LAS float* segA = AA + MATF; LAS float* segH = segA + 512;
    const bf16* PROJ = (const bf16*)(F.ws + WS_PROJ);
    const int tok0 = b * SEQ + n * CH;
    { const int t = F.tid >> 3, p = F.tid & 7, c0 = nb * 64 + 8 * p; float y[8];
        conv8r(rows, F.in[10] + (size_t)l * 4 * 256, 256, c0, y);
        const float* cb = F.in[11] + l * 256 + c0;
        *(LAS f32x4*)(XCm + t * LD + 8 * p) = (f32x4){y[0] + cb[0], y[1] + cb[1], y[2] + cb[2], y[3] + cb[3]}; *(LAS f32x4*)(XCm + t * LD + 8 * p + 4) = (f32x4){y[4] + cb[4], y[5] + cb[5], y[6] + cb[6], y[7] + cb[7]};
        const float* wa = F.in[12] + ((size_t)l * 4 + nb) * 4096; const float* wx = F.in[14] + ((size_t)l * 4 + nb) * 4096;
        if (load_w)
#pragma unroll
        for (int i = 0; i < 2; ++i) { const int e = F.tid + NTHR * i, r = e >> 4, c4 = (e & 15) * 4;
            *(LAS f32x4*)(WA + r * LD + c4) = *(const f32x4*)(wa + r * 64 + c4); *(LAS f32x4*)(WX + r * LD + c4) = *(const f32x4*)(wx + r * 64 + c4); } }
    __syncthreads();
    { const int lr = F.lane & 15, lg = F.lane >> 4; f32x4 ga[2], gx[2];
#pragma unroll
        for (int q = 0; q < 2; ++q) { const int tl = F.wave + 8 * q, mi = tl >> 2, ni = tl & 3;
            ga[q] = mm16b<false, false>(XCm, LD, WA, LD, 16 * mi, 16 * ni, 64, (f32x4){0.f, 0.f, 0.f, 0.f}, F.lane);
            gx[q] = mm16b<false, false>(XCm, LD, WX, LD, 16 * mi, 16 * ni, 64, (f32x4){0.f, 0.f, 0.f, 0.f}, F.lane); }
        __syncthreads();
#pragma unroll
        for (int q = 0; q < 2; ++q) { const int tl = F.wave + 8 * q, mi = tl >> 2, ni = tl & 3, j = 16 * ni + lr, cg = nb * 64 + j;
            const float ba = F.in[13][l * 256 + cg], bx = F.in[15][l * 256 + cg], sp = softplusf_(F.in[16][l * 256 + cg]);
#pragma unroll
            for (int r = 0; r < 4; ++r) { const int i = 16 * mi + 4 * lg + r; const float la = -8.0f * sigmoidf_(ga[q][r] + ba) * sp, a = __expf(la);
                const float mult = sqrtf(fmaxf(-expm1f(2.0f * la), 0.f)); const float xc = XCm[i * LD + j];
                AA[i * LD + j] = a; XCm[i * LD + j] = xc * sigmoidf_(gx[q][r] + bx) * mult; } } }
    __syncthreads();
    { const int c = F.tid & 63, sg = F.tid >> 6; float hh = 0.f, pp = 1.f; float hl[8], pl[8];
#pragma unroll
        for (int tt = 0; tt < 8; ++tt) { const int t = 8 * sg + tt; const float a = AA[t * LD + c], u = XCm[t * LD + c]; hh = a * hh + u; pp = pp * a; hl[tt] = hh; pl[tt] = pp; }
        segA[sg * 64 + c] = pp; segH[sg * 64 + c] = hh;
        __syncthreads();
        float hin = 0.f, pin = 1.f;
        for (int s2 = 0; s2 < sg; ++s2) { const float a = segA[s2 * 64 + c]; hin = a * hin + segH[s2 * 64 + c]; pin *= a; }
        bf16* RHL = (bf16*)(F.ws + WS_RHL); bf16* RP = (bf16*)(F.ws + WS_RP);
#pragma unroll
        for (int tt = 0; tt < 8; ++tt) { const int t = 8 * sg + tt; const float hv = hl[tt] + pl[tt] * hin, pv = pl[tt] * pin;
            RHL[(size_t)(tok0 + t) * 256 + nb * 64 + c] = (bf16)f2bf(hv); RP[(size_t)(tok0 + t) * 256 + nb * 64 + c] = (bf16)f2bf(pv);
            if (t == 63) { ((float*)(F.ws + WS_RAT))[(b * NCH + n) * 256 + nb * 64 + c] = pv; ((float*)(F.ws + WS_RHE))[(b * NCH + n) * 256 + nb * 64 + c] = hv; } } }
    __syncthreads();
}
__device__ __forceinline__ void prep_phase(Frame& F, int l) {
    { u32x4 nx[3][4]; int idx = F.bid;
        if (idx < 2048) gdn_fetch(F, (idx >> 2) >> 6, (idx >> 2) & 63, idx & 3, nx);
        for (; idx < 2048; idx += F.G) { u32x4 cur[3][4];
#pragma unroll
            for (int i = 0; i < 3; ++i)
#pragma unroll
                for (int j = 0; j < 4; ++j) cur[i][j] = nx[i][j];
            const int ni = idx + F.G; if (ni < 2048) gdn_fetch(F, (ni >> 2) >> 6, (ni >> 2) & 63, ni & 3, nx);
            gdn_prep(F, l, (idx >> 2) >> 6, (idx >> 2) & 63, idx & 3, cur); } }
    { GlaIn nx; int idx = F.bid, hw = -1;
        if (idx < 2048) gla_fetch(F, (idx >> 2) >> 6, (idx >> 2) & 63, idx & 3, nx);
        for (; idx < 2048; idx += F.G) { const GlaIn cur = nx;
            const int ni = idx + F.G; if (ni < 2048) gla_fetch(F, (ni >> 2) >> 6, (ni >> 2) & 63, ni & 3, nx);
            gla_prep(F, l, (idx >> 2) >> 6, (idx >> 2) & 63, idx & 3, cur, (idx & 3) != hw); hw = idx & 3; } }
    { u32x4 nx[4]; int idx = F.bid, bw = -1;
        if (idx < 2048) rg_fetch(F, (idx >> 2) >> 6, (idx >> 2) & 63, idx & 3, nx);
        for (; idx < 2048; idx += F.G) { u32x4 cur[4];
#pragma unroll
            for (int j = 0; j < 4; ++j) cur[j] = nx[j];
            const int ni = idx + F.G; if (ni < 2048) rg_fetch(F, (ni >> 2) >> 6, (ni >> 2) & 63, ni & 3, nx);
            rg_prep(F, l, (idx >> 2) >> 6, (idx >> 2) & 63, idx & 3, cur, (idx & 3) != bw); bw = idx & 3; } }
}

__device__ __forceinline__ f32x16 mfma32(bf16x8 a, bf16x8 b, f32x16 c) { return __builtin_amdgcn_mfma_f32_32x32x16_bf16(a, b, c, 0, 0, 0); }
typedef short v4i16_t __attribute__((ext_vector_type(4)));
__device__ __forceinline__ s16x4 vtr(const LAS unsigned char* p) { return __builtin_bit_cast(s16x4, __builtin_amdgcn_ds_read_tr16_b64_v4i16((LAS v4i16_t*)p)); }

__device__ __forceinline__ void attn_item(const Frame& F0, int l, int b, int h, int qb) { Frame F = opq(F0);
    constexpr int KP = 144, KT_BYTES = 64 * KP;
    LAS unsigned char* Kt = F.lds; LAS unsigned char* Vt = F.lds + 4 * KT_BYTES;
    LAS float* LUT = (LAS float*)(F.lds + 8 * KT_BYTES); LAS float* sLam = LUT + 256; LAS float* ML = sLam + 64;
    LAS float* MO = (LAS float*)F.lds;
    const bf16* PROJ = (const bf16*)(F.ws + WS_PROJ); bf16* MIX = (bf16*)(F.ws + WS_HM);
    const float lam_init = l == 0 ? 0.2f : 0.35550906759096926f;
    if (F.tid < 256) { const int delta = F.tid - 191, na = delta < 0 ? -delta : delta;
        int bk = na < 8 ? na : na < 12 ? 8 : na < 16 ? 9 : na < 23 ? 10 : na < 32 ? 11 : na < 46 ? 12 : na < 64 ? 13 : na < 91 ? 14 : 15;
        if (delta > 0) bk += 16;
        LUT[F.tid] = F.in[9][bk * 4 + h] * LOG2E; }
    if (F.wave == 4) { const float* lv = F.in[7] + l * 128; const int i = F.lane & 31;
        float p = F.lane < 32 ? lv[i] * lv[32 + i] : lv[64 + i] * lv[96 + i];
#pragma unroll
        for (int o = 1; o < 32; o <<= 1) p += __shfl_xor(p, o);
        const float e = __expf(p), e2 = __shfl_xor(e, 32);
        if (F.lane == 0) sLam[0] = e - e2 + lam_init; }
    __syncthreads();
    const float lam = sLam[0];
    const int w = F.wave, w4 = w & 3, half = w >> 2, cq = qb * 2 + (w4 >> 1), r32 = F.lane & 31, hh = F.lane >> 5, qoff = 32 * (w4 & 1) + r32;
    const size_t t0 = (size_t)b * SEQ + qb * 128 + 32 * w4 + r32;
    bf16x8 qf[2][2];
#pragma unroll
    for (int c = 0; c < 2; ++c)
#pragma unroll
        for (int s = 0; s < 2; ++s) qf[c][s] = *(const bf16x8*)(PROJ + t0 * PP + QB + h * 64 + c * 32 + 16 * s + 8 * hh);
    f32x16 O[2][2]; float mrun[2], lrun[2];
#pragma unroll
    for (int c = 0; c < 2; ++c) { mrun[c] = -1.0e30f; lrun[c] = 0.f;
#pragma unroll
        for (int mt = 0; mt < 2; ++mt)
#pragma unroll
            for (int i = 0; i < 16; ++i) O[c][mt][i] = 0.f; }
    const int skey = F.tid >> 3, sseg = F.tid & 7, nstep = qb + 1;
    const bf16* kg = PROJ + ((size_t)b * SEQ + skey) * PP + KB + h * 64 + sseg * 8; const bf16* vg = PROJ + ((size_t)b * SEQ + skey) * PP + VB + h * 64 + sseg * 8;
    u32x4 kreg0 = *(const u32x4*)kg, vreg0 = *(const u32x4*)vg, kreg1 = *(const u32x4*)(kg + (size_t)64 * PP), vreg1 = *(const u32x4*)(vg + (size_t)64 * PP);
    const float SC = 0.17677669529663687f * LOG2E;
    for (int j = 0; j < nstep; ++j) {
        const int buf = j & 1, kt = 2 * j + half;
        *(LAS u32x4*)(Kt + (buf * 2 + 0) * KT_BYTES + skey * KP + sseg * 16) = kreg0; *(LAS u32x4*)(Vt + (buf * 2 + 0) * KT_BYTES + skey * KP + sseg * 16) = vreg0;
        *(LAS u32x4*)(Kt + (buf * 2 + 1) * KT_BYTES + skey * KP + sseg * 16) = kreg1; *(LAS u32x4*)(Vt + (buf * 2 + 1) * KT_BYTES + skey * KP + sseg * 16) = vreg1;
        __syncthreads();
        if (j + 1 < nstep) { const size_t o0 = (size_t)(2 * j + 2) * 64 * PP, o1 = o0 + (size_t)64 * PP;
            kreg0 = *(const u32x4*)(kg + o0); vreg0 = *(const u32x4*)(vg + o0); kreg1 = *(const u32x4*)(kg + o1); vreg1 = *(const u32x4*)(vg + o1); }
        if (kt <= cq) {
            const int lutbase = (kt - cq) * 64 - qoff + 191;
            const LAS unsigned char* Kb = Kt + (buf * 2 + half) * KT_BYTES; const LAS unsigned char* Vb = Vt + (buf * 2 + half) * KT_BYTES;
#pragma unroll
            for (int kb = 0; kb < 2; ++kb) {
                f32x16 S[2];
#pragma unroll
                for (int c = 0; c < 2; ++c) { f32x16 z;
#pragma unroll
                    for (int i = 0; i < 16; ++i) z[i] = 0.f;
                    const bf16x8 k0 = *(const LAS bf16x8*)(Kb + (32 * kb + r32) * KP + (c * 32 + 8 * hh) * 2), k1 = *(const LAS bf16x8*)(Kb + (32 * kb + r32) * KP + (c * 32 + 16 + 8 * hh) * 2);
                    z = mfma32(k0, qf[c][0], z); S[c] = mfma32(k1, qf[c][1], z); }
                float bias[16];
#pragma unroll
                for (int i = 0; i < 16; ++i) { const int idx = lutbase + 32 * kb + (i & 3) + 8 * (i >> 2) + 4 * hh; bias[i] = LUT[idx > 0 ? idx : 0]; }
                bf16x8 pb[2][2];
#pragma unroll
                for (int c = 0; c < 2; ++c) {
                    float mx = -1.0e30f;
#pragma unroll
                    for (int i = 0; i < 16; ++i) { S[c][i] = S[c][i] * SC + bias[i]; mx = fmaxf(mx, S[c][i]); }
                    mx = fmaxf(mx, __shfl_xor(mx, 32));
                    if (__any(mx > mrun[c] + 8.0f)) {
                        const float mn = fmaxf(mrun[c], mx), alpha = __builtin_amdgcn_exp2f(mrun[c] - mn); mrun[c] = mn; lrun[c] *= alpha;
#pragma unroll
                        for (int mt = 0; mt < 2; ++mt)
#pragma unroll
                            for (int i = 0; i < 16; ++i) O[c][mt][i] *= alpha; }
                    const float mr = mrun[c]; float ps = 0.f;
#pragma unroll
                    for (int i = 0; i < 16; ++i) { S[c][i] = __builtin_amdgcn_exp2f(S[c][i] - mr); ps += S[c][i]; }
                    lrun[c] += ps;
#pragma unroll
                    for (int s = 0; s < 2; ++s) { u32x4 pw; pw.x = pg8::cvt_pk_bf16(S[c][8 * s + 0], S[c][8 * s + 1]); pw.y = pg8::cvt_pk_bf16(S[c][8 * s + 2], S[c][8 * s + 3]); pw.z = pg8::cvt_pk_bf16(S[c][8 * s + 4], S[c][8 * s + 5]); pw.w = pg8::cvt_pk_bf16(S[c][8 * s + 6], S[c][8 * s + 7]);
                        pb[c][s] = __builtin_bit_cast(bf16x8, pw); }
                }
#pragma unroll
                for (int mt = 0; mt < 2; ++mt)
#pragma unroll
                    for (int s = 0; s < 2; ++s) {
                        const LAS unsigned char* vp = Vb + (32 * kb + 16 * s + 4 * hh + ((F.lane & 15) >> 2)) * KP + (32 * mt + 16 * ((F.lane >> 4) & 1) + 4 * (F.lane & 3)) * 2;
                        const s16x4 v0 = vtr(vp), v1 = vtr(vp + 8 * KP);
                        bf16x8 vf; vf[0] = v0[0]; vf[1] = v0[1]; vf[2] = v0[2]; vf[3] = v0[3]; vf[4] = v1[0]; vf[5] = v1[1]; vf[6] = v1[2]; vf[7] = v1[3];
                        O[0][mt] = mfma32(vf, pb[0][s], O[0][mt]); O[1][mt] = mfma32(vf, pb[1][s], O[1][mt]); }
            }
        }
    }
    __syncthreads();
    if (half) {
#pragma unroll
        for (int c = 0; c < 2; ++c) { ML[(w4 * 4 + c) * 64 + F.lane] = mrun[c]; ML[(w4 * 4 + 2 + c) * 64 + F.lane] = lrun[c];
#pragma unroll
            for (int mt = 0; mt < 2; ++mt)
#pragma unroll
                for (int i = 0; i < 16; ++i) MO[(w4 * 64 + c * 32 + mt * 16 + i) * 64 + F.lane] = O[c][mt][i]; } }
    __syncthreads();
    if (!half) {
#pragma unroll
        for (int c = 0; c < 2; ++c) { const float m2 = ML[(w4 * 4 + c) * 64 + F.lane], l2 = ML[(w4 * 4 + 2 + c) * 64 + F.lane];
            const float mn = fmaxf(mrun[c], m2), a1 = __builtin_amdgcn_exp2f(mrun[c] - mn), a2 = __builtin_amdgcn_exp2f(m2 - mn);
            lrun[c] = lrun[c] * a1 + l2 * a2;
#pragma unroll
            for (int mt = 0; mt < 2; ++mt)
#pragma unroll
                for (int i = 0; i < 16; ++i) O[c][mt][i] = O[c][mt][i] * a1 + MO[(w4 * 64 + c * 32 + mt * 16 + i) * 64 + F.lane] * a2; } const float i0 = 1.0f / (lrun[0] + __shfl_xor(lrun[0], 32)), i1 = lam / (lrun[1] + __shfl_xor(lrun[1], 32));
        float ss = 0.f;
#pragma unroll
        for (int mt = 0; mt < 2; ++mt)
#pragma unroll
            for (int i = 0; i < 16; ++i) { const float a = O[0][mt][i] * i0 - O[1][mt][i] * i1; O[0][mt][i] = a; ss += a * a; }
        ss += __shfl_xor(ss, 32);
        const float rs = (1.0f - lam_init) / sqrtf(ss * (1.0f / 64.0f) + EPS);
        const float* bn = F.in[8] + l * 64;
#pragma unroll
        for (int mt = 0; mt < 2; ++mt)
#pragma unroll
            for (int g4 = 0; g4 < 4; ++g4) { const int dv0 = 32 * mt + 8 * g4 + 4 * hh; const f32x4 gn = *(const f32x4*)(bn + dv0);
                u32x2 o; o.x = pk2(O[0][mt][4 * g4 + 0] * rs * gn.x, O[0][mt][4 * g4 + 1] * rs * gn.y); o.y = pk2(O[0][mt][4 * g4 + 2] * rs * gn.z, O[0][mt][4 * g4 + 3] * rs * gn.w);
                if (ABL & 8) { o.x = 0u; o.y = 0u; }
                *(u32x2*)(MIX + t0 * D + 256 + h * 64 + dv0) = o; } }
    __syncthreads();
}

__device__ __forceinline__ void gdn_chain_item(const Frame& F0, int b, int h, int pair) { Frame F = opq(F0);
    const int w = F.wave, chain = w >> 2, cg = 2 * pair + chain, mi = w & 3, lr = F.lane & 15, lg = F.lane >> 4;
    LAS float* Sb = (LAS float*)F.lds + chain * 2048;
    const f32x4* GMv = (const f32x4*)(F.ws + WS_GM); float* GN = (float*)(F.ws + WS_GN);
    f32x4 s_cur = (f32x4){0.f, 0.f, 0.f, 0.f};
#pragma unroll
    for (int r = 0; r < 4; ++r) Sb[(16 * mi + 4 * lg + r) * 16 + lr] = 0.f;
    __syncthreads();
    f32x4 mq[4][4], nq[4];
#define GDN_LOAD(slot, n_) do { const size_t _ch = (size_t)((b * NCH + (n_)) * 4 + h); \
        _Pragma("unroll") for (int _q = 0; _q < 4; ++_q) mq[slot][_q] = GMv[_ch * 1024 + (mi * 4 + _q) * 64 + F.lane]; \
        _Pragma("unroll") for (int _r = 0; _r < 4; ++_r) nq[slot][_r] = GN[_ch * 4096 + (16 * mi + 4 * lg + _r) * 64 + 16 * cg + lr]; } while (0)
    GDN_LOAD(0, 0); GDN_LOAD(1, 1); GDN_LOAD(2, 2); GDN_LOAD(3, 3);
    for (int n0 = 0; n0 < NCH; n0 += 4) {
#pragma unroll
        for (int u = 0; u < 4; ++u) { const int n = n0 + u, buf = u & 1; const size_t ch = (size_t)((b * NCH + n) * 4 + h);
            f32x4 acc = nq[u];
#pragma unroll
            for (int r = 0; r < 4; ++r) GN[ch * 4096 + (16 * mi + 4 * lg + r) * 64 + 16 * cg + lr] = s_cur[r];
#pragma unroll
            for (int ks = 0; ks < 16; ++ks) { const float a = mq[u][ks >> 2][ks & 3], bv = Sb[buf * 1024 + (4 * ks + lg) * 16 + lr]; acc = __builtin_amdgcn_mfma_f32_16x16x4f32(a, bv, acc, 0, 0, 0); }
            asm volatile("s_nop 15\n\ts_nop 7" : "+v"(acc));
            s_cur = acc;
#pragma unroll
            for (int r = 0; r < 4; ++r) Sb[(buf ^ 1) * 1024 + (16 * mi + 4 * lg + r) * 16 + lr] = acc[r];
            if (n + 4 < NCH) GDN_LOAD(u, n + 4);
            __syncthreads(); }
    }
#undef GDN_LOAD
}
__device__ __forceinline__ void gla_prefix_item(const Frame& F0, int b, int h) { Frame F = opq(F0);
    f32x4* LKV = (f32x4*)(F.ws + WS_LKV); const float* LDL = (const float*)(F.ws + WS_LDL); const int dk = F.tid >> 4;
    f32x4 s = (f32x4){0.f, 0.f, 0.f, 0.f}, kvq[8]; float dq[8];
#pragma unroll
    for (int u = 0; u < 8; ++u) { const size_t ch = (size_t)((b * NCH + u) * 4 + h); kvq[u] = LKV[ch * 512 + F.tid]; dq[u] = LDL[ch * 32 + dk]; }
    for (int n0 = 0; n0 < NCH; n0 += 8) {
#pragma unroll
        for (int u = 0; u < 8; ++u) { const int n = n0 + u; const size_t ch = (size_t)((b * NCH + n) * 4 + h);
            const f32x4 kv = kvq[u]; const float d = dq[u];
            LKV[ch * 512 + F.tid] = s; s = s * d + kv;
            if (n + 8 < NCH) { const size_t c2 = (size_t)((b * NCH + n + 8) * 4 + h); kvq[u] = LKV[c2 * 512 + F.tid]; dq[u] = LDL[c2 * 32 + dk]; } }
    }
}
__device__ __forceinline__ void rg_carry_item(const Frame& F0, int j) { Frame F = opq(F0);
    const int gid = j * NTHR + F.tid, b = gid >> 8, c = gid & 255;
    const float* RAT = (const float*)(F.ws + WS_RAT); const float* RHE = (const float*)(F.ws + WS_RHE); float* RCA = (float*)(F.ws + WS_RCA);
    float carry = 0.f;
#pragma unroll 8
    for (int n = 0; n < NCH; ++n) { const int ci = (b * NCH + n) * 256 + c; const float a = RAT[ci], hn = RHE[ci]; RCA[ci] = carry; carry = a * carry + hn; }
}
constexpr int Q_GDN = 64, Q_GLA = 32, Q_RG = 4, Q_ATT = 1024, Q_ITEMS = Q_GDN + Q_GLA + Q_RG + Q_ATT;
__device__ __forceinline__ void scan_attn_phase(Frame& F, int l) {
    for (;;) {
        __syncthreads();
        if (F.tid == 0) F.MISC[16] = __hip_atomic_fetch_add(F.ctl + CW_QUEUE + 64 * l, 1u, __ATOMIC_RELAXED, __HIP_MEMORY_SCOPE_AGENT);
        __syncthreads();
        const int it = (int)F.MISC[16];
        if (it >= Q_ITEMS) break;
        if (it < Q_GDN) gdn_chain_item(F, it >> 3, (it >> 1) & 3, it & 1);
        else if (it < Q_GDN + Q_GLA) { const int q = it - Q_GDN; gla_prefix_item(F, q >> 2, q & 3); }
        else if (it < Q_GDN + Q_GLA + Q_RG) rg_carry_item(F, it - Q_GDN - Q_GLA);
        else { const int a = it - (Q_GDN + Q_GLA + Q_RG), qb = 31 - (a >> 5), bh = a & 31; attn_item(F, l, bh >> 2, bh & 3, qb); }
    }
    if (REPEAT & 4) for (;;) {
        __syncthreads();
        if (F.tid == 0) F.MISC[16] = __hip_atomic_fetch_add(F.ctl + CW_QUEUE + 64 * (2 + l), 1u, __ATOMIC_RELAXED, __HIP_MEMORY_SCOPE_AGENT);
        __syncthreads();
        const int a = (int)F.MISC[16];
        if (a >= Q_ATT) break;
        const int qb = 31 - (a >> 5), bh = a & 31; attn_item(F, l, bh >> 2, bh & 3, qb);
    }
}

__device__ __forceinline__ void norm_gate_store(Frame& F, const LAS float* OUT, const float* gain, const bf16* gate  , bf16* dst, bool silu_gate) {
    const int t = F.tid >> 3, p = F.tid & 7; const f32x4 a = *(const LAS f32x4*)(OUT + t * LD + 8 * p), c = *(const LAS f32x4*)(OUT + t * LD + 8 * p + 4);
    float ss = (a.x * a.x + a.y * a.y) + (a.z * a.z + a.w * a.w) + (c.x * c.x + c.y * c.y) + (c.z * c.z + c.w * c.w);
#pragma unroll
    for (int o = 1; o < 8; o <<= 1) ss += __shfl_xor(ss, o);
    const float rs = 1.0f / sqrtf(ss * (1.0f / 64.0f) + EPS);
    float gv[8]; ld8(gate + (size_t)t * PP + 8 * p, gv);
    const f32x4 g0 = *(const f32x4*)(gain + 8 * p), g1 = *(const f32x4*)(gain + 8 * p + 4);
    float o[8] = {a.x * rs * g0.x, a.y * rs * g0.y, a.z * rs * g0.z, a.w * rs * g0.w, c.x * rs * g1.x, c.y * rs * g1.y, c.z * rs * g1.z, c.w * rs * g1.w};
#pragma unroll
    for (int e = 0; e < 8; ++e) o[e] *= siluf_(gv[e]) * (((ABL & 512) && gain == F.in[6] + 0) ? 2.0f : 1.0f);
    u32x4 w; w.x = pk2(o[0], o[1]); w.y = pk2(o[2], o[3]); w.z = pk2(o[4], o[5]); w.w = pk2(o[6], o[7]);
    if (!silu_gate) w = (u32x4){0u, 0u, 0u, 0u};
    *(u32x4*)(dst + (size_t)t * D + 8 * p) = w;
}
struct FinIn { f32x4 a0, a1, b0, b1, c0, c1; u32x4 gate; };
__device__ __forceinline__ void fin_fetch(const Frame& F, int it, int hj, FinIn& x) {
    const int b = it >> 6, n = it & 63, h = hj & 3, lr = F.lane & 15, lg = F.lane >> 4; const size_t ch = (size_t)((b * NCH + n) * 4 + h), tok0 = (size_t)b * SEQ + n * CH;
    const bf16* PROJ = (const bf16*)(F.ws + WS_PROJ); const float* ini;
    if (hj < 4) { const f32x4* GQ = (const f32x4*)(F.ws + WS_GQ) + ch * 1024; const f32x4* GS = (const f32x4*)(F.ws + WS_GN) + ch * 1024; ini = (const float*)(F.ws + WS_GO) + ch * 4096;
        x.a0 = GQ[F.tid]; x.a1 = GQ[F.tid + NTHR]; x.b0 = GS[F.tid]; x.b1 = GS[F.tid + NTHR]; }
    else { const f32x4* LQG = (const f32x4*)(F.ws + WS_LQG) + ch * 512; const f32x4* LS = (const f32x4*)(F.ws + WS_LKV) + ch * 512; ini = (const float*)(F.ws + WS_LOI) + ch * 4096;
        x.a0 = LQG[F.tid]; x.b0 = LS[F.tid]; x.a1 = x.a0; x.b1 = x.b0; }
#pragma unroll
    for (int r = 0; r < 4; ++r) { const int t0 = F.wave, t1 = F.wave + 8; x.c0[r] = ini[(16 * (t0 >> 2) + 4 * lg + r) * 64 + 16 * (t0 & 3) + lr]; x.c1[r] = ini[(16 * (t1 >> 2) + 4 * lg + r) * 64 + 16 * (t1 & 3) + lr]; }
    x.gate = *(const u32x4*)(PROJ + (tok0 + (F.tid >> 3)) * PP + (hj < 4 ? GA : RD) + h * 64 + 8 * (F.tid & 7));
}
__device__ __forceinline__ void finalize_phase(const Frame& F0, int l) { Frame F = opq(F0);
    LAS float* QP = (LAS float*)F.lds; LAS float* SPT = QP + MATF; LAS float* OUT = SPT + MATF;
    const bf16* PROJ = (const bf16*)(F.ws + WS_PROJ); bf16* MIX = (bf16*)(F.ws + WS_HM);
    const int lr = F.lane & 15, lg = F.lane >> 4;
    FinIn nx; if (F.bid < NB * NCH) fin_fetch(F, F.bid, 0, nx);
    for (int it = F.bid; it < NB * NCH; it += F.G) { const int b = it >> 6, n = it & 63; const size_t tok0 = (size_t)b * SEQ + n * CH;
        for (int hj = 0; hj < 8; ++hj) { const FinIn cur = nx; const int h = hj & 3;
            if (hj < 4) {
#pragma unroll
                for (int i = 0; i < 2; ++i) { const int e = F.tid + NTHR * i, r = e >> 4, c4 = (e & 15) * 4; const f32x4 qv = i ? cur.a1 : cur.a0, sv = i ? cur.b1 : cur.b0;
                    *(LAS f32x4*)(QP + r * LD + c4) = qv; SPT[(c4 + 0) * LD + r] = sv.x; SPT[(c4 + 1) * LD + r] = sv.y; SPT[(c4 + 2) * LD + r] = sv.z; SPT[(c4 + 3) * LD + r] = sv.w; } }
            else { const int r = F.tid >> 3, c4 = (F.tid & 7) * 4; *(LAS f32x4*)(QP + r * 36 + c4) = cur.a0;
                const int r2 = F.tid >> 4, c42 = (F.tid & 15) * 4; SPT[(c42 + 0) * LD + r2] = cur.b0.x; SPT[(c42 + 1) * LD + r2] = cur.b0.y; SPT[(c42 + 2) * LD + r2] = cur.b0.z; SPT[(c42 + 3) * LD + r2] = cur.b0.w; }
            __syncthreads();
            { int nit = it, nhj = hj + 1; if (nhj == 8) { nhj = 0; nit = it + F.G; } if (nit < NB * NCH) fin_fetch(F, nit, nhj, nx); }
#pragma unroll
            for (int q = 0; q < 2; ++q) { const int tl = F.wave + 8 * q, mi = tl >> 2, ni = tl & 3; f32x4 acc = q ? cur.c1 : cur.c0;
                if (hj < 4) { if (!(ABL & 128)) acc = mm16b<false, true>(QP, LD, SPT, LD, 16 * mi, 16 * ni, 64, acc, F.lane); }
                else acc = mm16b<false, true>(QP, 36, SPT, LD, 16 * mi, 16 * ni, 32, acc, F.lane);
#pragma unroll
                for (int r = 0; r < 4; ++r) OUT[(16 * mi + 4 * lg + r) * LD + 16 * ni + lr] = acc[r]; }
            __syncthreads();
            { const int t = F.tid >> 3, p = F.tid & 7; const f32x4 a = *(const LAS f32x4*)(OUT + t * LD + 8 * p), c = *(const LAS f32x4*)(OUT + t * LD + 8 * p + 4);
                float ss = (a.x * a.x + a.y * a.y) + (a.z * a.z + a.w * a.w) + (c.x * c.x + c.y * c.y) + (c.z * c.z + c.w * c.w);
#pragma unroll
                for (int o = 1; o < 8; o <<= 1) ss += __shfl_xor(ss, o);
                const float rs = 1.0f / sqrtf(ss * (1.0f / 64.0f) + EPS);
                float gv[8]; unpack8(cur.gate, gv);
                const float* gain = (hj < 4 ? F.in[6] : F.in[19]) + l * 64;
                const f32x4 g0 = *(const f32x4*)(gain + 8 * p), g1 = *(const f32x4*)(gain + 8 * p + 4);
                float o[8] = {a.x * rs * g0.x, a.y * rs * g0.y, a.z * rs * g0.z, a.w * rs * g0.w, c.x * rs * g1.x, c.y * rs * g1.y, c.z * rs * g1.z, c.w * rs * g1.w};
#pragma unroll
                for (int e = 0; e < 8; ++e) o[e] *= siluf_(gv[e]);
                u32x4 w; w.x = pk2(o[0], o[1]); w.y = pk2(o[2], o[3]); w.z = pk2(o[4], o[5]); w.w = pk2(o[6], o[7]);
                *(u32x4*)(MIX + (tok0 + t) * D + (hj < 4 ? 0 : 768) + h * 64 + 8 * p) = w; }
        }
        { const int t = F.tid >> 3, c0 = (F.tid & 7) * 32; const size_t tok = tok0 + t;
            const bf16* RHL = (const bf16*)(F.ws + WS_RHL) + tok * 256; const bf16* RP = (const bf16*)(F.ws + WS_RP) + tok * 256; const float* RCA = (const float*)(F.ws + WS_RCA) + (b * NCH + n) * 256;
#pragma unroll
            for (int q = 0; q < 4; ++q) { const int c = c0 + 8 * q; float hl[8], pv[8], gc[8]; ld8(RHL + c, hl); ld8(RP + c, pv); ld8(PROJ + tok * PP + GC + c, gc);
                const f32x4 ca0 = *(const f32x4*)(RCA + c), ca1 = *(const f32x4*)(RCA + c + 4); const float ca[8] = {ca0.x, ca0.y, ca0.z, ca0.w, ca1.x, ca1.y, ca1.z, ca1.w};
                float o[8];
#pragma unroll
                for (int e = 0; e < 8; ++e) o[e] = (hl[e] + pv[e] * ca[e]) * gelu_tanh(gc[e]);
                u32x4 w; w.x = pk2(o[0], o[1]); w.y = pk2(o[2], o[3]); w.z = pk2(o[4], o[5]); w.w = pk2(o[6], o[7]);
                *(u32x4*)(MIX + tok * D + 512 + c) = w; } }
    }
    __syncthreads();
}

__device__ __forceinline__ void dbg_gdn_check(const Frame& F0, int l, int bsel, int hsel, int msel, float* dbgout) { Frame F = opq(F0);
    if (F.bid != 0) return;
    constexpr int NT = 512;
    LAS float* S = (LAS float*)F.lds;
    LAS float* qv = S + 4096; LAS float* kv = qv + 64; LAS float* vv = kv + 64; LAS float* tmp = vv + 64; LAS float* ov = tmp + 64; LAS float* sc = ov + 64;
    const bf16* PROJ = (const bf16*)(F.ws + WS_PROJ); const float* SM = (const float*)(F.ws + WS_SMALL); const bf16* MIX = (const bf16*)(F.ws + WS_HM);
    const float* cw = F.in[3] + (size_t)l * 4 * 768;
    for (int i = F.tid; i < 4096; i += NTHR) S[i] = 0.f;
    float errsum = 0.f, refsum = 0.f;
    __syncthreads();
    for (int t = 0; t < NT; ++t) {
        const size_t tok = (size_t)bsel * SEQ + t;
        if (F.tid < 192) { const int which = F.tid >> 6, d = F.tid & 63, c = which * 256 + hsel * 64 + d; float y = 0.f;
            for (int j = 0; j < 4; ++j) { const int tp = t - 3 + j; if (tp >= 0) y += bf2f(PROJ[((size_t)bsel * SEQ + tp) * PP + c]) * cw[j * 768 + c]; }
            y = y / (1.0f + expf(-y)); (which == 0 ? qv : which == 1 ? kv : vv)[d] = y; }
        __syncthreads();
        if (F.tid == 0) { float sq = 0.f, sk = 0.f; for (int d = 0; d < 64; ++d) { sq += qv[d] * qv[d]; sk += kv[d] * kv[d]; }
            sc[0] = 0.125f / sqrtf(sq + EPS); sc[1] = 1.0f / sqrtf(sk + EPS);
            sc[2] = 1.0f / (1.0f + expf(-SM[tok * 32 + hsel]));
            const float x = SM[tok * 32 + 4 + hsel] + F.in[5][l * 4 + hsel]; const float sp = fmaxf(x, 0.f) + log1pf(expf(-fabsf(x)));
            sc[3] = expf(-expf(F.in[4][l * 4 + hsel]) * sp); }
        __syncthreads();
        if (F.tid < 64) { qv[F.tid] *= sc[0]; kv[F.tid] *= sc[1]; }
        for (int i = F.tid; i < 4096; i += NTHR) S[i] *= sc[3];
        __syncthreads();
        if ((ABL & (1 << 21)) && t < 64 && F.tid < 64) { const float* dq = (const float*)(F.ctl + 8192); const int which = msel; if (which < 3) { const float r = which == 0 ? qv[F.tid] : which == 1 ? kv[F.tid] : vv[F.tid] * sc[2];
            const float m = dq[which * 4096 + t * 64 + F.tid]; errsum += (m - r) * (m - r); refsum += r * r; } }
        if ((ABL & (1 << 22)) && t < 64) { LAS float* KH = sc + 16; LAS float* GH = KH + 4096;
            if (F.tid < 64) KH[t * 64 + F.tid] = kv[F.tid];
            if (F.tid == 0) GH[t] = (t ? GH[t - 1] : 0.f) + logf(sc[3]);
            __syncthreads();
            if (F.tid <= t && msel < 2) { const int j = F.tid; float d = 0.f; for (int dk = 0; dk < 64; ++dk) d += (msel == 0 ? qv[dk] : kv[dk]) * KH[j * 64 + dk];
                float r = d * expf(GH[t] - GH[j]) * (msel == 0 ? 1.0f : sc[2]); if (msel == 1 && j == t) r = 0.f;
                const float m = ((const float*)(F.ctl + 8192 + 3 * 4096))[(msel == 0 ? 4096 : 0) + t * 64 + j]; errsum += (m - r) * (m - r); refsum += r * r; }
            __syncthreads(); }
        if (F.tid < 64) { float a = 0.f; for (int dk = 0; dk < 64; ++dk) a += S[dk * 64 + F.tid] * kv[dk]; tmp[F.tid] = sc[2] * (vv[F.tid] - a); }
        __syncthreads();
        if ((ABL & (1 << 22)) && msel == 2 && t < 64 && F.tid < 64) { const float m = ((const float*)(F.ctl + 8192 + 5 * 4096))[t * 64 + F.tid], r = tmp[F.tid]; errsum += (m - r) * (m - r); refsum += r * r; }
        for (int i = F.tid; i < 4096; i += NTHR) S[i] += kv[i >> 6] * tmp[i & 63];
        __syncthreads();
        if (F.tid < 64) { float a = 0.f; for (int dk = 0; dk < 64; ++dk) a += S[dk * 64 + F.tid] * qv[dk]; ov[F.tid] = a; }
        __syncthreads();
        if ((ABL & (1 << 21)) && msel == 3 && t < 64 && F.tid < 64) { const float* GO = (const float*)(F.ws + WS_GO) + (size_t)((bsel * NCH + 0) * 4 + hsel) * 4096;
            const float m = (ABL & (1 << 23)) ? ((const float*)(F.ctl + 8192 + 6 * 4096))[t * 64 + F.tid] : GO[t * 64 + F.tid], r = ov[F.tid]; errsum += (m - r) * (m - r); refsum += r * r; }
        if (F.tid == 0) { float ss = 0.f; for (int d = 0; d < 64; ++d) ss += ov[d] * ov[d]; sc[4] = 1.0f / sqrtf(ss / 64.0f + EPS); }
        __syncthreads();
        if (F.tid < 64) { const float gt = bf2f(PROJ[tok * PP + GA + hsel * 64 + F.tid]); const float r = ov[F.tid] * sc[4] * F.in[6][l * 64 + F.tid] * (gt / (1.0f + expf(-gt)));
            const float m = bf2f(MIX[tok * D + hsel * 64 + F.tid]);
            const bool use = msel == 0 ? true : msel == 1 ? ((t & 63) < 16) : msel == 2 ? (t < 64) : (t >= 64);
            if (use && !(ABL & (3 << 21))) { errsum += (m - r) * (m - r); refsum += r * r; } }
        __syncthreads();
    }
    if (F.tid < 64) { errsum = wave_sum(errsum); refsum = wave_sum(refsum); if (F.tid == 0) dbgout[0] = 1000.0f * sqrtf(errsum / fmaxf(refsum, 1e-30f)); }
}
#define IN_PH (lo <= ph && ph < hi)
#define END_PH do { if (IN_PH && ph + 1 < hi) xcd_barrier(bar); if (PROBE_A >= 0 && F.bid == 0 && F.tid == 0) ((volatile LAS unsigned long long*)(F.lds + MISC_OFF + 512))[ph + 1] = __builtin_amdgcn_s_memrealtime(); ++ph; } while (0)
template <int l>
__device__ __forceinline__ void layer_phases(Frame& F, const XcdBarrier& bar, const int lo, const int hi, int& ph) {
    LAS unsigned char* ring = F.lds;
    bf16* HM = (bf16*)(F.ws + WS_HM); bf16* PROJ = (bf16*)(F.ws + WS_PROJ); float* X = F.out;
        if (PHON(1) && IN_PH) {
            pg8::StaticOrder S; S.init(T, NIN, F.G, F.bid); pg8::EpiProj E{PROJ, (float*)(F.ws + WS_SMALL)};
            pg8::gemm_phase<pg8::EpiProj, pg8::StaticOrder, false>(ring, HM, (const bf16*)(F.ws + WS_WIN) + (size_t)l * NIN * D, D, S, E, nullptr); }
        END_PH;
        if (PHON(2) && IN_PH) { prep_phase(F, l); if (REPEAT & 1) { __syncthreads(); prep_phase(F, l); } }
        END_PH;
        if ((ABL & 4096) && (ABL & (1 << 24)) && l == ((ABL >> 15) & 1)) { if (IN_PH) dbg_gdn_check(F, l, (ABL >> 18) & 7, (ABL >> 16) & 3, (ABL >> 13) & 3, (float*)(F.ctl + 2048)); END_PH; }
        if (PHON(3) && IN_PH) scan_attn_phase(F, l);
        END_PH;
        if ((ABL & 4096) && (ABL & (1 << 25)) && l == ((ABL >> 15) & 1)) { if (IN_PH) dbg_gdn_check(F, l, (ABL >> 18) & 7, (ABL >> 16) & 3, (ABL >> 13) & 3, (float*)(F.ctl + 2048)); END_PH; }
        if (PHON(4) && IN_PH) { finalize_phase(F, l); if (REPEAT & 2) { __syncthreads(); finalize_phase(F, l); } }
        END_PH;
        if ((ABL & 4096) && !(ABL & (3 << 24)) && l == ((ABL >> 15) & 1)) { if (IN_PH) dbg_gdn_check(F, l, (ABL >> 18) & 7, (ABL >> 16) & 3, (ABL >> 13) & 3, (float*)(F.ctl + 2048)); END_PH; }
        if (PHON(5) && IN_PH) {
            pg8::StaticOrder S; S.init(T, D, F.G, F.bid); pg8::EpiResid E{l == 0 ? F.in[0] : (const float*)X, X};
            pg8::gemm_phase<pg8::EpiResid, pg8::StaticOrder, false>(ring, HM, (const bf16*)(F.ws + WS_WOUT) + (size_t)l * D * D, D, S, E, nullptr); }
        END_PH;
        if (l == 0) {
            if (PHON(6) && IN_PH) norm_phase(F, X, F.in[21]);
            END_PH;
            if (PHON(7) && !(ABL & 4) && IN_PH) { pg8::StaticOrder S; S.init(T, 2 * DFF, F.G, F.bid); pg8::EpiSwiglu E{PROJ, DFF, 22};
                pg8::gemm_phase<pg8::EpiSwiglu, pg8::StaticOrder, false>(ring, HM, (const bf16*)(F.ws + WS_WGU), D, S, E, nullptr); }
            END_PH;
            if (PHON(8) && !(ABL & 4) && IN_PH) { pg8::StaticOrder S; S.init(T, D, F.G, F.bid); pg8::EpiResid E{X, X};
                pg8::gemm_phase<pg8::EpiResid, pg8::StaticOrder, false>(ring, PROJ, (const bf16*)(F.ws + WS_WD), DFF, S, E, nullptr); }
            END_PH;
            if (PHON(6) && IN_PH) norm_phase(F, X, F.in[1] + D);
            END_PH;
        } else {
            if (PHON(9) && IN_PH) { norm_router_phase(F, X, F.in[21] + D, F.in[25]); __syncthreads();
                if (PROBE_A >= 0 && F.bid == 0 && F.tid == 0) ((volatile LAS unsigned long long*)(F.lds + MISC_OFF + 512))[30] = __builtin_amdgcn_s_memrealtime();
                moe_convert(F); }
            END_PH;
#define MOE_PASS(k) do {\
                const int* stok = (const int*)(F.ws + WS_STOK) + (size_t)k * NE * T; const float* sw = (const float*)(F.ws + WS_SW) + (size_t)k * NE * T;\
                if (PHON(10) && IN_PH) { pg8::MoeOrder S; S.init(F.ctl + CW_MOECNT + 8 * k, 28, F.G, F.bid); pg8::EpiSwiglu E{PROJ, DFE, 28};\
                    pg8::gemm_phase<pg8::EpiSwiglu, pg8::MoeOrder, true>(ring, HM, (const bf16*)(F.ws + WS_MOEW_GU), D, S, E, stok); }\
                END_PH;\
                if (PHON(11) && IN_PH) { pg8::MoeOrder S; S.init(F.ctl + CW_MOECNT + 8 * k, 4, F.G, F.bid); pg8::EpiScatter E{X, stok, sw, 4};\
                    pg8::gemm_phase<pg8::EpiScatter, pg8::MoeOrder, false>(ring, PROJ, (const bf16*)(F.ws + WS_MOEW_D), DFE, S, E, nullptr); }\
                END_PH; } while (0)
            MOE_PASS(0);
            MOE_PASS(1);
#undef MOE_PASS
            if (PHON(12) && IN_PH) final_norm_phase(F, X, F.in[29]);
            END_PH;
            if (ABL & 4096) { if (IN_PH) { for (size_t i = (size_t)F.bid * NTHR + F.tid; i < (size_t)T * D; i += (size_t)F.G * NTHR) X[i] = (i == 0) ? ((const float*)(F.ctl + 2048))[0] : 0.f; } END_PH; }
        }
}
#undef IN_PH
#undef END_PH
struct Args { const float* in[30]; float* out; unsigned char* ws; int ph_lo, ph_hi; };
constexpr int N_PHASES = 21 + ((ABL & 4096) ? 2 : 0);
__global__ void __launch_bounds__(NTHR, 2) fwd(Args args) {
    extern __shared__ __attribute__((aligned(16))) unsigned char lds[];
    Frame F;
    F.lds = (LAS unsigned char*)lds; F.MISC = (volatile LAS unsigned*)(F.lds + MISC_OFF);
    F.tid = threadIdx.x; F.lane = F.tid & 63; F.wave = __builtin_amdgcn_readfirstlane(F.tid >> 6);
    F.G = gridDim.x; F.bid = blockIdx.x; F.in = args.in; F.out = args.out; F.ws = args.ws; F.ctl = (unsigned*)(args.ws + WS_CTL);
    for (int u = F.tid; u < 64; u += NTHR) F.MISC[u] = 0u;
    __syncthreads();
    const int lo = args.ph_lo, hi = args.ph_hi;
    XcdBarrier bar; bar.bar = F.ctl + CW_BAR; bar.x = 0; bar.st = nullptr;
    if (hi - lo > 1) bar = xcd_barrier_post(F.ctl + CW_BAR, F.MISC + 8);
    int ph = 0;
#define IN_PH (lo <= ph && ph < hi)
#define END_PH do { if (IN_PH && ph + 1 < hi) xcd_barrier(bar); if (PROBE_A >= 0 && F.bid == 0 && F.tid == 0) ((volatile LAS unsigned long long*)(F.lds + MISC_OFF + 512))[ph + 1] = __builtin_amdgcn_s_memrealtime(); ++ph; } while (0)
    LAS unsigned char* ring = F.lds;
    bf16* HM = (bf16*)(F.ws + WS_HM); bf16* PROJ = (bf16*)(F.ws + WS_PROJ); float* X = F.out;

    if (PROBE_A >= 0 && F.bid == 0 && F.tid == 0) ((volatile LAS unsigned long long*)(F.lds + MISC_OFF + 512))[0] = __builtin_amdgcn_s_memrealtime();
    if (PHON(0) && IN_PH) p0_prologue(F);
    END_PH;
    layer_phases<0>(F, bar, lo, hi, ph);
    layer_phases<1>(F, bar, lo, hi, ph);
    if (PROBE_A >= 0 && F.bid == 0 && F.tid == 0) { volatile LAS unsigned long long* st = (volatile LAS unsigned long long*)(F.lds + MISC_OFF + 512);
        const unsigned long long d = (st[PROBE_B] - st[PROBE_A]) * 4ull, t0 = __builtin_amdgcn_s_memrealtime();
        while (__builtin_amdgcn_s_memrealtime() - t0 < d) __builtin_amdgcn_s_sleep(8); }
#undef IN_PH
#undef END_PH
}

extern "C" void kernel_launch(void* const* d_in, const int* in_sizes, int n_in, void* d_out, int out_size, void* d_ws, size_t ws_size, hipStream_t stream) {
    static int grid = 0;
    if (grid == 0) {
        if (n_in != 30 || in_sizes[0] != T * D || out_size != T * D || ws_size < WS_NEED) { fprintf(stderr, "kernel_launch: unexpected shapes (n_in %d, in0 %d, out %d, ws %zu < %zu); nothing launched\n", n_in, n_in > 0 ? in_sizes[0] : -1, out_size, ws_size, (size_t)WS_NEED); grid = -1; return; }
        int dev = 0, cus = 0, per_cu = 0;
        if (hipGetDevice(&dev) != hipSuccess || hipDeviceGetAttribute(&cus, hipDeviceAttributeMultiprocessorCount, dev) != hipSuccess) { grid = -1; return; }
        if (hipFuncSetAttribute((const void*)fwd, hipFuncAttributeMaxDynamicSharedMemorySize, LDS_BYTES) != hipSuccess) { fprintf(stderr, "kernel_launch: hipFuncSetAttribute failed\n"); grid = -1; return; }
        if (hipOccupancyMaxActiveBlocksPerMultiprocessor(&per_cu, (const void*)fwd, NTHR, LDS_BYTES) != hipSuccess || per_cu < 1) fprintf(stderr, "kernel_launch: occupancy query says %d\n", per_cu);
        (void)hipGetLastError();
        grid = cus;
    }
    if (grid < 0) return;
    if (hipMemsetAsync((char*)d_ws + WS_CTL, 0, CTL_ZERO_BYTES, stream) != hipSuccess) return;
    Args a{};
    for (int i = 0; i < 30; ++i) a.in[i] = (const float*)d_in[i];
    a.out = (float*)d_out; a.ws = (unsigned char*)d_ws;
#if MK_ONE_LAUNCH
    a.ph_lo = 0; a.ph_hi = N_PHASES;
    hipLaunchKernelGGL(fwd, dim3(grid), dim3(NTHR), LDS_BYTES, stream, a);
#else
    for (int p = 0; p < N_PHASES; ++p) { a.ph_lo = p; a.ph_hi = p + 1; hipLaunchKernelGGL(fwd, dim3(grid), dim3(NTHR), LDS_BYTES, stream, a); }
#endif
}
```

```cpp
#include <hip/hip_runtime.h>
#include <cstdio>
#include <cstdint>

#ifndef PHMASK
#define PHMASK 0xffff
#endif
#define PHON(k) ((PHMASK >> (k)) & 1)
#ifndef PROBE_A
#define PROBE_A -1
#endif
#ifndef PROBE_B
#define PROBE_B -1
#endif
#ifndef REPEAT
#define REPEAT 0
#endif
#ifndef DUMPS
#define DUMPS 0
#endif
#ifndef FINPARTS
#define FINPARTS 7
#endif
#ifndef ABL
#define ABL 0
#endif
#ifndef MK_ONE_LAUNCH
#define MK_ONE_LAUNCH 1
#endif

#define LAS __attribute__((address_space(3)))
#define GAS __attribute__((address_space(1)))
typedef unsigned short bf16;
typedef short bf16x8 __attribute__((ext_vector_type(8)));
typedef short s16x4 __attribute__((ext_vector_type(4)));
typedef float f32x4 __attribute__((ext_vector_type(4)));
typedef float f32x16 __attribute__((ext_vector_type(16)));
typedef unsigned u32x4 __attribute__((ext_vector_type(4)));
typedef unsigned u32x2 __attribute__((ext_vector_type(2)));

constexpr int T = 32768, D = 1024, SEQ = 4096, NB = 8, NCH = 64, CH = 64;
constexpr int PP = 3072;
constexpr int QA = 0, KA = 256, VA = 512, GA = 768, QB = 1024, KB = 1280, VB = 1536, XC = 1792, GC = 2048, QD = 2304, KD = 2432, VD = 2560, RD = 2816;
constexpr int NIN = 3328;
constexpr int DFF = 2816, DFE = 3584, NE = 8;
constexpr float EPS = 1e-6f;
constexpr float LOG2E = 1.4426950408889634f;

constexpr size_t MiB = 1u << 20;
constexpr size_t WS_CTL = 0, CTL_ZERO_BYTES = 1 * MiB;
constexpr size_t WS_STOK = 1 * MiB;
constexpr size_t WS_SW = 3 * MiB;
constexpr size_t WS_WIN = 5 * MiB;
constexpr size_t WS_WOUT = 18 * MiB;
constexpr size_t WS_WGU = 22 * MiB;
constexpr size_t WS_WD = 33 * MiB;
constexpr size_t WS_HM = 39 * MiB;
constexpr size_t WS_SMALL = 103 * MiB;
constexpr size_t WS_PROJ = 107 * MiB;
constexpr size_t WS_TMP = 299 * MiB;
constexpr size_t WS_GM = WS_TMP;
constexpr size_t WS_GN = WS_GM + 32 * MiB;
constexpr size_t WS_GQ = WS_GN + 32 * MiB;
constexpr size_t WS_GO = WS_GQ + 32 * MiB;
constexpr size_t WS_LOI = WS_GO + 32 * MiB;
constexpr size_t WS_LQG = WS_LOI + 32 * MiB;
constexpr size_t WS_LKV = WS_LQG + 16 * MiB;
constexpr size_t WS_RHL = WS_LKV + 16 * MiB;
constexpr size_t WS_RP = WS_RHL + 16 * MiB;
constexpr size_t WS_MISC = WS_RP + 16 * MiB;
constexpr size_t WS_LDL = WS_MISC;
constexpr size_t WS_RAT = WS_MISC + 512 * 1024;
constexpr size_t WS_RHE = WS_RAT + 512 * 1024;
constexpr size_t WS_RCA = WS_RHE + 512 * 1024;
constexpr size_t WS_TMP_END = WS_MISC + 2 * MiB;
constexpr size_t WS_MOEW_GU = 345 * MiB;
constexpr size_t WS_MOEW_D = 457 * MiB;
constexpr size_t WS_END = 513 * MiB;
constexpr size_t WS_NEED = 525 * MiB;
static_assert(WS_TMP_END <= WS_NEED && WS_END <= WS_NEED, "ws map");
static_assert(WS_PROJ + (size_t)34816 * DFE * 2 <= WS_MOEW_GU, "moe act fits under moe weights");
constexpr int CW_TMO = 0;
constexpr int CW_QUEUE = 64;
constexpr int CW_MOECNT = 1024;
constexpr int CW_BAR = 4096;

constexpr int RING_BYTES = 131072;
constexpr int MISC_OFF = RING_BYTES;
constexpr int LDS_BYTES = RING_BYTES + 4096;
constexpr int NWAVES = 8, NTHR = 512;

__device__ __forceinline__ unsigned f2bf(float f) { unsigned u = __builtin_bit_cast(unsigned, f); return (u + 0x7fffu + ((u >> 16) & 1u)) >> 16; }
__device__ __forceinline__ unsigned pk2(float lo, float hi) { return f2bf(lo) | (f2bf(hi) << 16); }
__device__ __forceinline__ float bflo(unsigned w) { return __builtin_bit_cast(float, w << 16); }
__device__ __forceinline__ float bfhi(unsigned w) { return __builtin_bit_cast(float, w & 0xffff0000u); }
__device__ __forceinline__ float bf2f(bf16 b) { return __builtin_bit_cast(float, ((unsigned)b) << 16); }
__device__ __forceinline__ float wave_sum(float v) {
#pragma unroll
    for (int o = 1; o < 64; o <<= 1) v += __shfl_xor(v, o);
    return v;
}
__device__ __forceinline__ float fexp(float x) { return __builtin_amdgcn_exp2f(x * LOG2E); }
__device__ __forceinline__ float sigmoidf_(float x) { return 1.0f / (1.0f + __expf(-x)); }
__device__ __forceinline__ float siluf_(float x) { return x / (1.0f + __expf(-x)); }
__device__ __forceinline__ float softplusf_(float x) { return fmaxf(x, 0.f) + log1pf(__expf(-fabsf(x))); }
__device__ __forceinline__ float gelu_tanh(float x) { const float u = 0.7978845608028654f * (x + 0.044715f * x * x * x); return 0.5f * x * (1.0f + tanhf(u)); }
#define LDS_WAIT() asm volatile("s_waitcnt lgkmcnt(0)" ::: "memory")
#define VM_WAIT() asm volatile("s_waitcnt vmcnt(0)" ::: "memory")

namespace pg8 {
constexpr int BM = 256, BK = 64, HALF = 128, HTB = HALF * BK * 2, STAGE_BYTES = 8 * HTB, NXCD = 8, WGM = 8;
__host__ __device__ __forceinline__ int lds_byte(int r, int c) { const int st = (r >> 4) * 2 + (c >> 5), rr = r & 15, cc = c & 31, ob = rr * 64 + cc * 2; return st * 1024 + (ob ^ (((ob >> 9) & 1) << 5)); }
__host__ __device__ __forceinline__ void stage_rc(int b, int& R, int& C) { const int st = b / 1024, sb = b % 1024, swz = sb ^ (((sb >> 9) & 1) << 5); R = (st >> 1) * 16 + swz / 64; C = (st & 1) * 32 + (swz % 64) / 2; }
__host__ __device__ __forceinline__ int perm32(int rho) { const int n = rho >> 4, i = rho & 15; return 8 * (i >> 2) + 4 * n + (i & 3); }

struct Unit { int pm, pn, e, vr, lbase; };

struct StaticOrder {
    int nM, nN, nwg, G, c;
    __device__ void init(int M, int N, int G_, int c_) { nM = M / BM; nN = N / BM; nwg = nM * nN; G = G_; c = c_; }
    __device__ bool next(int i, Unit& u) const {
        const long L = (long)i * G + c; if (L >= nwg) return false;
        int wgid = (int)L; { const int q = nwg / NXCD, r = nwg % NXCD, xcd = wgid % NXCD, off = wgid / NXCD; wgid = (xcd < r ? xcd * (q + 1) : r * (q + 1) + (xcd - r) * q) + off; }
        const int nig = WGM * nN, gid = wgid / nig, fm = gid * WGM, gsz = (nM - fm) < WGM ? (nM - fm) : WGM;
        u.pm = fm + ((wgid % nig) % gsz); u.pn = (wgid % nig) / gsz; u.e = 0; u.vr = 256; u.lbase = 0; return true;
    }
};
struct MoeOrder {
    int pre[9], cnt[8], nN, G, c, total;
    __device__ void init(const unsigned* gcnt, int nN_, int G_, int c_) {
        int p = 0;
#pragma unroll
        for (int e = 0; e < 8; ++e) { cnt[e] = (int)__hip_atomic_load(gcnt + e, __ATOMIC_RELAXED, __HIP_MEMORY_SCOPE_AGENT); pre[e] = p; p += (cnt[e] + 255) >> 8; }
        pre[8] = p; nN = nN_; G = G_; c = c_; total = p * nN_;
    }
    __device__ bool next(int i, Unit& u) const {
        const long L = (long)i * G + c; if (L >= total) return false;
        const int pm = (int)(L / nN), pl = (int)(L % nN); int e = 0;
#pragma unroll
        for (int j = 1; j < 8; ++j) if (pm >= pre[j]) e = j;
        int pe = 0, ce = 0;
#pragma unroll
        for (int j = 0; j < 8; ++j) if (j == e) { pe = pre[j]; ce = cnt[j]; }
        const int lt = pm - pe, rem = ce - lt * 256;
        u.pm = pm; u.pn = e * nN + pl; u.e = e; u.vr = rem < 256 ? rem : 256; u.lbase = e * T + lt * 256; return true;
    }
};

__device__ __forceinline__ unsigned cvt_pk_bf16(float lo, float hi) { unsigned r; asm volatile("v_cvt_pk_bf16_f32 %0, %1, %2" : "=v"(r) : "v"(lo), "v"(hi)); return r; }

struct EpiProj {
    static constexpr bool PERM = true;
    bf16* P; float* SM;
    __device__ __forceinline__ void operator()(const f32x4 (&acc)[2][2][4][2], const Unit& u, int wr, int wc, int fr, int fq) const {
        const int row0 = u.pm * BM + wr * 64 + fr;
        if (u.pn < 12) {
            const int col0 = u.pn * BM + wc * 32 + 8 * fq;
#pragma unroll
            for (int ai = 0; ai < 2; ++ai)
#pragma unroll
                for (int m = 0; m < 4; ++m) { bf16* rowp = P + (size_t)(row0 + ai * HALF + m * 16) * PP + col0;
#pragma unroll
                    for (int bj = 0; bj < 2; ++bj) { const f32x4 v0 = acc[ai][bj][m][0], v1 = acc[ai][bj][m][1];
                        u32x4 w; w.x = cvt_pk_bf16(v0[0], v0[1]); w.y = cvt_pk_bf16(v0[2], v0[3]); w.z = cvt_pk_bf16(v1[0], v1[1]); w.w = cvt_pk_bf16(v1[2], v1[3]);
                        *(u32x4*)(rowp + bj * HALF) = w; } }
        } else if (wc == 0) {
#pragma unroll
            for (int ai = 0; ai < 2; ++ai)
#pragma unroll
                for (int m = 0; m < 4; ++m) { float* sp = SM + (size_t)(row0 + ai * HALF + m * 16) * 32 + 8 * fq;
                    *(f32x4*)sp = acc[ai][0][m][0]; *(f32x4*)(sp + 4) = acc[ai][0][m][1]; }
        }
    }
};
struct EpiResid {
    static constexpr bool PERM = false;
    const float* res; float* out;
    __device__ __forceinline__ void operator()(const f32x4 (&acc)[2][2][4][2], const Unit& u, int wr, int wc, int fr, int fq) const {
        const int row0 = u.pm * BM + wr * 64 + fr, col0 = u.pn * BM + wc * 32 + 4 * fq;
#pragma unroll
        for (int ai = 0; ai < 2; ++ai)
#pragma unroll
            for (int m = 0; m < 4; ++m) { const size_t off = (size_t)(row0 + ai * HALF + m * 16) * D + col0;
#pragma unroll
                for (int bj = 0; bj < 2; ++bj)
#pragma unroll
                    for (int n = 0; n < 2; ++n) { const size_t o = off + bj * HALF + n * 16; *(f32x4*)(out + o) = *(const f32x4*)(res + o) + acc[ai][bj][m][n]; }
                asm volatile("" ::: "memory"); }
    }
};
struct EpiSwiglu {
    static constexpr bool PERM = true;
    bf16* act; int ldc, nN;
    __device__ __forceinline__ void operator()(const f32x4 (&acc)[2][2][4][2], const Unit& u, int wr, int wc, int fr, int fq) const {
        const int pl = u.pn % nN;
        const int row0 = u.pm * BM + wr * 64 + fr, col0 = pl * HALF + wc * 32 + 8 * fq;
#pragma unroll
        for (int ai = 0; ai < 2; ++ai)
#pragma unroll
            for (int m = 0; m < 4; ++m) { bf16* rowp = act + (size_t)(row0 + ai * HALF + m * 16) * ldc + col0;
                float o[8];
#pragma unroll
                for (int n = 0; n < 2; ++n)
#pragma unroll
                    for (int j = 0; j < 4; ++j) { const float g = acc[ai][0][m][n][j], up = acc[ai][1][m][n][j];
                        o[4 * n + j] = g * up * __builtin_amdgcn_rcpf(1.0f + __builtin_amdgcn_exp2f(-g * LOG2E)); }
                u32x4 w; w.x = cvt_pk_bf16(o[0], o[1]); w.y = cvt_pk_bf16(o[2], o[3]); w.z = cvt_pk_bf16(o[4], o[5]); w.w = cvt_pk_bf16(o[6], o[7]);
                *(u32x4*)rowp = w; asm volatile("" ::: "memory"); }
    }
};
struct EpiScatter {
    static constexpr bool PERM = false;
    float* x; const int* tok; const float* wgt; int nN;
    __device__ __forceinline__ void operator()(const f32x4 (&acc)[2][2][4][2], const Unit& u, int wr, int wc, int fr, int fq) const {
        const int pl = u.pn % nN;
        const int rl0 = wr * 64 + fr, col0 = pl * BM + wc * 32 + 4 * fq;
#pragma unroll
        for (int ai = 0; ai < 2; ++ai)
#pragma unroll
            for (int m = 0; m < 4; ++m) { const int rl = rl0 + ai * HALF + m * 16;
                if (rl < u.vr) { const int t = tok[u.lbase + rl]; const float w = wgt[u.lbase + rl]; float* xp = x + (size_t)t * D + col0;
#pragma unroll
                    for (int bj = 0; bj < 2; ++bj)
#pragma unroll
                        for (int n = 0; n < 2; ++n) { f32x4* p = (f32x4*)(xp + bj * HALF + n * 16); *p = *p + acc[ai][bj][m][n] * w; } }
                asm volatile("" ::: "memory"); }
    }
};

template <class Epi, class Sched, bool GATHER>
__device__ __forceinline__ void gemm_phase(LAS unsigned char* lds, const bf16* A, const bf16* Bt, const int K, const Sched& S, const Epi& E, const int* glist) {
    int tid_ = threadIdx.x; asm volatile("" : "+v"(tid_));
    const int tid = tid_, wid = __builtin_amdgcn_readfirstlane(tid >> 6), lane = tid & 63, wr = wid >> 2, wc = wid & 3, fr = lane & 15, fq = lane >> 4;
    const int nt = K / BK;
    unsigned voffA[2], voffB[2]; int gR[2], gC[2];
#pragma unroll
    for (int i = 0; i < 2; ++i) { int R, C; stage_rc(tid * 16 + i * 8192, R, C); const int Rb = Epi::PERM ? ((R & ~31) + perm32(R & 31)) : R;
        voffA[i] = (unsigned)(R * K + C) * 2u; voffB[i] = (unsigned)(Rb * K + C) * 2u; gR[i] = R; gC[i] = C; }
    const size_t kstep = (size_t)(BK * 2);
    const size_t hstep = (size_t)HALF * K * 2;
    const size_t tstep = 2 * hstep;
    const unsigned ldsw = (unsigned)wid * 1024u;
    const int aoff = lds_byte(wr * 64 + fr, fq * 8), boff = lds_byte(wc * 32 + fr, fq * 8);
#define PG8_SA(b, h) (((b) * 2 + (h)) * HTB)
#define PG8_SB(b, h) ((4 + (b) * 2 + (h)) * HTB)
#define PG8_STAGE(bufoff, gbase, voff) do { _Pragma("unroll") for (int _i = 0; _i < 2; ++_i) \
        __builtin_amdgcn_global_load_lds((const unsigned*)((const char*)(gbase) + (voff)[_i]), (LAS unsigned*)(lds + (bufoff) + ldsw + _i * 8192), 16, 0, 0); } while (0)
#define PG8_STAGE_A(b, h, ubase, koff, OFFS) do { if constexpr (GATHER) { PG8_STAGE(PG8_SA(b, h), (const char*)A + (koff), (OFFS)[h]); } \
        else { PG8_STAGE(PG8_SA(b, h), (ubase) + (size_t)(h) * hstep + (koff), voffA); } } while (0)
#define PG8_LDA(dst, b, h) do { _Pragma("unroll") for (int m = 0; m < 4; ++m) _Pragma("unroll") for (int k = 0; k < 2; ++k) dst[m][k] = *(const LAS bf16x8*)(lds + PG8_SA(b, h) + aoff + m * 2048 + k * 1024); } while (0)
#define PG8_LDB(dst, b, h) do { _Pragma("unroll") for (int n = 0; n < 2; ++n) _Pragma("unroll") for (int k = 0; k < 2; ++k) dst[n][k] = *(const LAS bf16x8*)(lds + PG8_SB(b, h) + boff + n * 2048 + k * 1024); } while (0)
#define PG8_MMA(ai, bj, At, Bt_) do { __builtin_amdgcn_s_setprio(1); _Pragma("unroll") for (int m = 0; m < 4; ++m) _Pragma("unroll") for (int n = 0; n < 2; ++n) _Pragma("unroll") for (int k = 0; k < 2; ++k) \
        acc[ai][bj][m][n] = __builtin_amdgcn_mfma_f32_16x16x32_bf16(Bt_[n][k], At[m][k], acc[ai][bj][m][n], 0, 0, 0); __builtin_amdgcn_s_setprio(0); } while (0)
#define PG8_WAIT_V(n) asm volatile("s_waitcnt vmcnt(" #n ")" ::: "memory")
#define PG8_WAIT_L(n) asm volatile("s_waitcnt lgkmcnt(" #n ")" ::: "memory")
#define PG8_BAR __builtin_amdgcn_s_barrier()
#define PG8_SCHED __builtin_amdgcn_sched_barrier(0)
#define PG8_GOFF(dst, U) do { _Pragma("unroll") for (int _h = 0; _h < 2; ++_h) _Pragma("unroll") for (int _i = 0; _i < 2; ++_i) { const int _row = _h * HALF + gR[_i]; \
        const int _tk = (_row < (U).vr) ? glist[(U).lbase + _row] : 0; dst[_h][_i] = (unsigned)(_tk * K + gC[_i]) * 2u; } } while (0)
    Unit cur, nxt; int ui = 0;
    if (!S.next(0, cur)) return;
    f32x4 acc[2][2][4][2];
#pragma unroll
    for (int a = 0; a < 2; ++a)
#pragma unroll
        for (int b = 0; b < 2; ++b)
#pragma unroll
            for (int m = 0; m < 4; ++m)
#pragma unroll
                for (int n = 0; n < 2; ++n) acc[a][b][m][n] = (f32x4){0.f, 0.f, 0.f, 0.f};
    bf16x8 At[4][2], B0[2][2], B1[2][2];
    unsigned gofc[2][2] = {{0u, 0u}, {0u, 0u}}, gofn[2][2] = {{0u, 0u}, {0u, 0u}};
    if constexpr (GATHER) { PG8_GOFF(gofc, cur); }
    const char* cA = (const char*)A + (size_t)cur.pm * tstep; const char* cB = (const char*)Bt + (size_t)cur.pn * tstep;
    PG8_STAGE(PG8_SB(0, 0), cB, voffB); PG8_STAGE(PG8_SB(0, 1), cB + hstep, voffB); PG8_STAGE_A(0, 0, cA, 0, gofc); PG8_STAGE_A(0, 1, cA, 0, gofc);
    if (wr == 1) PG8_BAR;
    PG8_WAIT_V(2); PG8_BAR;
    PG8_STAGE(PG8_SB(1, 0), cB + kstep, voffB); PG8_STAGE_A(1, 0, cA, kstep, gofc); PG8_STAGE(PG8_SB(1, 1), cB + hstep + kstep, voffB);
    PG8_WAIT_V(6); PG8_BAR;
    for (;;) {
        const bool has_next = S.next(ui + 1, nxt);
        const char* nA = has_next ? (const char*)A + (size_t)nxt.pm * tstep : cA; const char* nB = has_next ? (const char*)Bt + (size_t)nxt.pn * tstep : cB;
        if constexpr (GATHER) { if (has_next) { PG8_GOFF(gofn, nxt); } else {
#pragma unroll
            for (int h = 0; h < 2; ++h)
#pragma unroll
                for (int i = 0; i < 2; ++i) gofn[h][i] = gofc[h][i]; } }
        for (int t = 0; t < nt; t += 2) {
            const bool last = (t == nt - 2);
            const size_t k1 = (size_t)(t + 1) * kstep;
            const char* ua2 = last ? nA : cA; const size_t k2 = last ? 0 : (size_t)(t + 2) * kstep; const size_t k3 = k2 + kstep;
            const char* b2 = last ? nB : cB + (size_t)(t + 2) * kstep; const char* b3 = b2 + kstep;
            unsigned go2[2][2];
#pragma unroll
            for (int h = 0; h < 2; ++h)
#pragma unroll
                for (int i = 0; i < 2; ++i) go2[h][i] = last ? gofn[h][i] : gofc[h][i];
            PG8_LDB(B0, 0, 0); PG8_LDB(B1, 0, 1); PG8_SCHED; PG8_LDA(At, 0, 0); PG8_STAGE_A(1, 1, cA, k1, gofc);
            PG8_WAIT_V(8); PG8_WAIT_L(0); PG8_BAR; PG8_MMA(0, 0, At, B0); PG8_MMA(0, 1, At, B1); PG8_BAR; PG8_SCHED;
            PG8_LDA(At, 0, 1); PG8_STAGE(PG8_SB(0, 0), b2, voffB); PG8_STAGE(PG8_SB(0, 1), b2 + hstep, voffB); PG8_STAGE_A(0, 0, ua2, k2, go2);
            PG8_WAIT_V(8); PG8_WAIT_L(0); PG8_BAR; PG8_MMA(1, 0, At, B0); PG8_MMA(1, 1, At, B1); PG8_BAR; PG8_SCHED;
            PG8_LDB(B0, 1, 0); PG8_LDB(B1, 1, 1); PG8_SCHED; PG8_LDA(At, 1, 0); PG8_STAGE_A(0, 1, ua2, k2, go2);
            PG8_WAIT_V(8); PG8_WAIT_L(0); PG8_BAR; PG8_MMA(0, 0, At, B0); PG8_MMA(0, 1, At, B1); PG8_BAR; PG8_SCHED;
            PG8_LDA(At, 1, 1); PG8_STAGE(PG8_SB(1, 0), b3, voffB); PG8_STAGE(PG8_SB(1, 1), b3 + hstep, voffB); PG8_STAGE_A(1, 0, ua2, k3, go2);
            PG8_WAIT_V(8); PG8_WAIT_L(0); PG8_BAR; PG8_MMA(1, 0, At, B0); PG8_MMA(1, 1, At, B1); PG8_BAR; PG8_SCHED;
        }
        if (wr == 0) PG8_BAR;
        E(acc, cur, wr, wc, fr, fq);
        if (!has_next) break;
#pragma unroll
        for (int a = 0; a < 2; ++a)
#pragma unroll
            for (int b = 0; b < 2; ++b)
#pragma unroll
                for (int m = 0; m < 4; ++m)
#pragma unroll
                    for (int n = 0; n < 2; ++n) acc[a][b][m][n] = (f32x4){0.f, 0.f, 0.f, 0.f};
        cur = nxt; cA = nA; cB = nB; ++ui;
#pragma unroll
        for (int h = 0; h < 2; ++h)
#pragma unroll
            for (int i = 0; i < 2; ++i) gofc[h][i] = gofn[h][i];
        if (wr == 1) PG8_BAR;
    }
    PG8_WAIT_V(0);
    PG8_BAR;
#undef PG8_SA
#undef PG8_SB
#undef PG8_STAGE
#undef PG8_STAGE_A
#undef PG8_LDA
#undef PG8_LDB
#undef PG8_MMA
#undef PG8_WAIT_V
#undef PG8_WAIT_L
#undef PG8_BAR
#undef PG8_SCHED
#undef PG8_GOFF
}
}

#define XB_TMO      128
#define XB_XCNT(j)  (256  + 64 * (j))
#define XB_XSUB(j)  (1280 + 64 * (j))
#define XB_XGEN(j)  (2304 + 64 * (j))
#define XB_TOP      3328
#define XB_TOPGEN   3392
#define XCD_BAR_WORDS 3456
#define XB_SPIN_CAP (1u << 18)
__device__ __forceinline__ unsigned xb_ld(unsigned* p)              { return __hip_atomic_load(p, __ATOMIC_RELAXED, __HIP_MEMORY_SCOPE_AGENT); }
__device__ __forceinline__ unsigned xb_add(unsigned* p, unsigned v) { return __hip_atomic_fetch_add(p, v, __ATOMIC_RELAXED, __HIP_MEMORY_SCOPE_AGENT); }
__device__ __forceinline__ unsigned xb_xcc_id() { return (unsigned)__builtin_amdgcn_s_getreg((3 << 11) | 20) & 0xFu; }
#define XB_SPIN(cond, bar) do { unsigned _sp = 0; while (cond) { __builtin_amdgcn_s_sleep(1); \
    if ((++_sp & 255u) == 0u) { if (xb_ld(&(bar)[XB_TMO])) break; if (_sp > XB_SPIN_CAP) { atomicAdd(&(bar)[XB_TMO], 1u); break; } } } } while (0)
struct XcdBarrier { unsigned* bar; unsigned x; volatile LAS unsigned* st; };
__device__ __forceinline__ XcdBarrier xcd_barrier_post(unsigned* bar, volatile LAS unsigned* st) {
    XcdBarrier b; b.bar = bar; b.x = xb_xcc_id(); b.st = st;
    if (threadIdx.x == 0) (void)xb_add(&bar[XB_XCNT(b.x)], 1u);
    return b;
}
__device__ __forceinline__ void xcd_barrier_complete(unsigned* bar, unsigned x, unsigned& nloc, unsigned& nx) {
    const unsigned G = gridDim.x * gridDim.y * gridDim.z;
    unsigned sum, cnt, mine, sp = 0u;
    for (;;) {
        sum = 0u; cnt = 0u; mine = 0u;
#pragma unroll
        for (unsigned j = 0; j < 16; ++j) { const unsigned c = xb_ld(&bar[XB_XCNT(j)]); sum += c; cnt += (c > 0u) ? 1u : 0u; mine = (j == x) ? c : mine; }
        if (sum == G) break;
        __builtin_amdgcn_s_sleep(1);
        if ((++sp & 255u) == 0u) { if (xb_ld(&bar[XB_TMO])) break; if (sp > XB_SPIN_CAP) { atomicAdd(&bar[XB_TMO], 1u); break; } }
    }
    nloc = mine > 0u ? mine : 1u; nx = cnt > 0u ? cnt : 1u;
}
__device__ __forceinline__ void xcd_barrier(const XcdBarrier& b) {
    asm volatile("s_waitcnt vmcnt(0)" ::: "memory");
    __syncthreads();
    if (threadIdx.x == 0) {
        unsigned* bar = b.bar;
        __builtin_amdgcn_s_waitcnt(0);
        unsigned nloc = b.st[0], nx = b.st[1];
        if (nloc == 0u) { xcd_barrier_complete(bar, b.x, nloc, nx); b.st[0] = nloc; b.st[1] = nx; }
        const unsigned old = xb_add(&bar[XB_XSUB(b.x)], 1u);
        const unsigned gen = old / nloc;
        if (old + 1u == (gen + 1u) * nloc) {
            __builtin_amdgcn_fence(__ATOMIC_RELEASE, "agent");
            asm volatile("s_waitcnt vmcnt(0)" ::: "memory");
            const unsigned og = xb_add(&bar[XB_TOP], 1u);
            const unsigned tg = og / nx;
            if (og + 1u == (tg + 1u) * nx) xb_add(&bar[XB_TOPGEN], 1u);
            else XB_SPIN(xb_ld(&bar[XB_TOPGEN]) == tg, bar);
            __builtin_amdgcn_fence(__ATOMIC_ACQUIRE, "agent");
            xb_add(&bar[XB_XGEN(b.x)], 1u);
            asm volatile("s_waitcnt vmcnt(0)" ::: "memory");
        } else {
            XB_SPIN(xb_ld(&bar[XB_XGEN(b.x)]) == gen, bar);
            __builtin_amdgcn_fence(__ATOMIC_ACQUIRE, "agent");
            asm volatile("s_waitcnt vmcnt(0)" ::: "memory");
        }
    }
    __syncthreads();
}


struct Frame {
    LAS unsigned char* lds;
    volatile LAS unsigned* MISC;
    unsigned* ctl;
    int tid, lane, wave, G, bid;
    const float* const* in;
    float* out; unsigned char* ws;
};

template <class P> __device__ __forceinline__ P lptr(P p) { unsigned long long v = (unsigned long long)p; unsigned lo = (unsigned)v, hi = (unsigned)(v >> 32); asm volatile("" : "+v"(lo), "+v"(hi));
    lo = __builtin_amdgcn_readfirstlane(lo); hi = __builtin_amdgcn_readfirstlane(hi); return (P)(((unsigned long long)hi << 32) | lo); }
__device__ __forceinline__ Frame opq(Frame F) { asm volatile("" : "+v"(F.tid));  F.lane = F.tid & 63; F.wave = __builtin_amdgcn_readfirstlane(F.tid >> 6); return F; }

template <bool TA, bool TB>
__device__ __forceinline__ f32x4 mm16(const LAS float* A, int lda, const LAS float* B, int ldb, int i0, int j0, int K, f32x4 acc, int lane) {
    const int lr = lane & 15, lg = lane >> 4;
    for (int ks = 0; ks < K; ks += 4) {
        const int k = ks + lg;
        const float a = TA ? A[k * lda + i0 + lr] : A[(i0 + lr) * lda + k];
        const float b = TB ? B[(j0 + lr) * ldb + k] : B[k * ldb + j0 + lr];
        acc = __builtin_amdgcn_mfma_f32_16x16x4f32(a, b, acc, 0, 0, 0);
    }
    asm volatile("s_nop 15\n\ts_nop 7" : "+v"(acc));
    return acc;
}

template <bool TA, bool TB>
__device__ __forceinline__ f32x4 mm16b(const LAS float* A, int lda, const LAS float* B, int ldb, int i0, int j0, int K, f32x4 acc, int lane) {
    const int lr = lane & 15, lg = lane >> 4;
    for (int ks = 0; ks < K; ks += 32) {
        const int k0 = ks + 8 * lg; const bool in = k0 < K;
        f32x4 a0 = (f32x4){0.f, 0.f, 0.f, 0.f}, a1 = a0, b0 = a0, b1 = a0;
        if (in) {
            if (TA) { const LAS float* p = A + k0 * lda + i0 + lr; a0 = (f32x4){p[0], p[lda], p[2 * lda], p[3 * lda]}; a1 = (f32x4){p[4 * lda], p[5 * lda], p[6 * lda], p[7 * lda]}; }
            else { const LAS float* p = A + (i0 + lr) * lda + k0; a0 = *(const LAS f32x4*)p; a1 = *(const LAS f32x4*)(p + 4); }
            if (TB) { const LAS float* p = B + (j0 + lr) * ldb + k0; b0 = *(const LAS f32x4*)p; b1 = *(const LAS f32x4*)(p + 4); }
            else { const LAS float* p = B + k0 * ldb + j0 + lr; b0 = (f32x4){p[0], p[ldb], p[2 * ldb], p[3 * ldb]}; b1 = (f32x4){p[4 * ldb], p[5 * ldb], p[6 * ldb], p[7 * ldb]}; }
        }
        u32x4 aw, bw;
        aw.x = pg8::cvt_pk_bf16(a0.x, a0.y); aw.y = pg8::cvt_pk_bf16(a0.z, a0.w); aw.z = pg8::cvt_pk_bf16(a1.x, a1.y); aw.w = pg8::cvt_pk_bf16(a1.z, a1.w);
        bw.x = pg8::cvt_pk_bf16(b0.x, b0.y); bw.y = pg8::cvt_pk_bf16(b0.z, b0.w); bw.z = pg8::cvt_pk_bf16(b1.x, b1.y); bw.w = pg8::cvt_pk_bf16(b1.z, b1.w);
        acc = __builtin_amdgcn_mfma_f32_16x16x32_bf16(__builtin_bit_cast(bf16x8, aw), __builtin_bit_cast(bf16x8, bw), acc, 0, 0, 0);
    }
    asm volatile("s_nop 15\n\ts_nop 7" : "+v"(acc));
    return acc;
}

__device__ __forceinline__ void tr_item(const float* src, int ld, int scol, bf16* WT, int K, int r0, int k0, LAS float* scr, int lane) {
#pragma unroll 8
    for (int i = 0; i < 32; ++i) { const int kk = 2 * i + (lane >> 5); const float v = scol >= 0 ? src[(size_t)(k0 + kk) * ld + scol] : 0.f; scr[kk * 33 + (lane & 31)] = v; }
    LDS_WAIT(); asm volatile("" ::: "memory");
    const int c = lane & 7;
#pragma unroll
    for (int j = 0; j < 4; ++j) { const int n = (lane >> 3) + 8 * j; const LAS float* s = scr + (8 * c) * 33 + n;
        u32x4 o; o.x = pk2(s[0 * 33], s[1 * 33]); o.y = pk2(s[2 * 33], s[3 * 33]); o.z = pk2(s[4 * 33], s[5 * 33]); o.w = pk2(s[6 * 33], s[7 * 33]);
        *(u32x4*)(WT + (size_t)(r0 + n) * K + k0 + 8 * c) = o; }
    LDS_WAIT(); asm volatile("" ::: "memory");
}

__device__ __forceinline__ void tr_tile64(const float* src, int ld, int col0, bf16* WT, int K, int r0, int k0, LAS unsigned* scr, int lane) {
    const int kp = lane >> 4, n4 = (lane & 15) * 4;
    const float* p = src + (size_t)k0 * ld + col0 + n4;
    f32x4 va[8], vb[8];
#pragma unroll
    for (int i = 0; i < 8; ++i) { const int k = 2 * (4 * i + kp); va[i] = *(const f32x4*)(p + (size_t)k * ld); vb[i] = *(const f32x4*)(p + (size_t)(k + 1) * ld); }
#pragma unroll
    for (int i = 0; i < 8; ++i) { const int kk = 4 * i + kp;
        scr[(n4 + 0) * 33 + kk] = pk2(va[i].x, vb[i].x); scr[(n4 + 1) * 33 + kk] = pk2(va[i].y, vb[i].y); scr[(n4 + 2) * 33 + kk] = pk2(va[i].z, vb[i].z); scr[(n4 + 3) * 33 + kk] = pk2(va[i].w, vb[i].w); }
    LDS_WAIT(); asm volatile("" ::: "memory");
    const int c = lane & 7;
#pragma unroll
    for (int j = 0; j < 8; ++j) { const int n = 8 * j + (lane >> 3); const LAS unsigned* q = scr + n * 33 + 4 * c;
        u32x4 o; o.x = q[0]; o.y = q[1]; o.z = q[2]; o.w = q[3];
        *(u32x4*)(WT + (size_t)(r0 + n) * K + k0 + 8 * c) = o; }
    LDS_WAIT(); asm volatile("" ::: "memory");
}

__device__ __forceinline__ void norm_row(const float* xrow, const f32x4 (&g)[4], bf16* orow, f32x4 (&v)[4], int lane) {
    const f32x4* xr = (const f32x4*)xrow + lane; float s = 0.f;
#pragma unroll
    for (int j = 0; j < 4; ++j) { v[j] = xr[64 * j]; s += (v[j].x * v[j].x + v[j].y * v[j].y) + (v[j].z * v[j].z + v[j].w * v[j].w); }
    const float r = 1.0f / sqrtf(wave_sum(s) * (1.f / D) + EPS);
    unsigned long long* o8 = (unsigned long long*)orow + lane;
#pragma unroll
    for (int j = 0; j < 4; ++j) { v[j] = v[j] * r * g[j]; o8[64 * j] = (unsigned long long)pk2(v[j].x, v[j].y) | ((unsigned long long)pk2(v[j].z, v[j].w) << 32); }
}

__device__ __forceinline__ void p0_prologue(const Frame& F0) { Frame F = opq(F0);
    LAS float* scr = (LAS float*)(F.lds + F.wave * 16384);
    const int gw = F.bid * NWAVES + F.wave, NGW = F.G * NWAVES;
    const float* w_in = F.in[2]; const float* w_out = F.in[20]; const float* fg = F.in[22]; const float* fu = F.in[23]; const float* fd = F.in[24];
    bf16* Win = (bf16*)(F.ws + WS_WIN); bf16* Wout = (bf16*)(F.ws + WS_WOUT); bf16* Wgu = (bf16*)(F.ws + WS_WGU); bf16* Wd = (bf16*)(F.ws + WS_WD);
    constexpr int I_IN = 2 * 16 * 48, I_INT = 2 * 16 * 8, I_OUT = 2 * 16 * 16, I_GU = 16 * 88, I_D = 44 * 16;
    const int j = F.lane & 31; LAS unsigned* scru = (LAS unsigned*)scr;
    for (int it = gw; it < I_IN + I_INT + I_OUT + I_GU + I_D; it += NGW) {
        int r = it;
        if (r < I_IN) { const int l = r / (16 * 48), q = r % (16 * 48), kb = q / 48, nb = q % 48, n0 = 64 * nb;
            tr_tile64(w_in + (size_t)l * D * 3096, 3096, n0 < 1024 ? n0 : n0 + 8, Win + (size_t)l * NIN * D, D, n0, 64 * kb, scru, F.lane); continue; }
        r -= I_IN;
        if (r < I_INT) { const int l = r / (16 * 8), q = r % (16 * 8), kb = q / 8, nb = 96 + q % 8, n = 32 * nb + j;
            const int scol = n < 3080 ? n - 2048 : n < 3096 ? n : -1;
            tr_item(w_in + (size_t)l * D * 3096, 3096, scol, Win + (size_t)l * NIN * D, D, 32 * nb, 64 * kb, scr, F.lane); continue; }
        r -= I_INT;
        if (r < I_OUT) { const int l = r / 256, q = r % 256, kb = q / 16, nb = q % 16;
            tr_tile64(w_out + (size_t)l * D * D, D, 64 * nb, Wout + (size_t)l * D * D, D, 64 * nb, 64 * kb, scru, F.lane); continue; }
        r -= I_OUT;
        if (r < I_GU) { const int kb = r / 88, nb = r % 88, r0 = 64 * nb, pn = r0 >> 8, j0 = r0 & 255;
            tr_tile64(j0 < 128 ? fg : fu, DFF, pn * 128 + (j0 & 127), Wgu, D, r0, 64 * kb, scru, F.lane); continue; }
        r -= I_GU;
        { const int kb = r / 16, nb = r % 16; tr_tile64(fd, D, 64 * nb, Wd, DFF, 64 * nb, 64 * kb, scru, F.lane); }
    }
    f32x4 g[4];
#pragma unroll
    for (int q = 0; q < 4; ++q) g[q] = ((const f32x4*)F.in[1])[F.lane + 64 * q];
    bf16* H = (bf16*)(F.ws + WS_HM);
    for (int m = gw; m < T; m += NGW) { f32x4 v[4]; norm_row(F.in[0] + (size_t)m * D, g, H + (size_t)m * D, v, F.lane); }
}
__device__ __forceinline__ void moe_convert(const Frame& F0) { Frame F = opq(F0);
    LAS float* scr = (LAS float*)(F.lds + F.wave * 16384);
    const int gw = F.bid * NWAVES + F.wave, NGW = F.G * NWAVES;
    const float* mg = F.in[26]; const float* mu = F.in[27]; const float* md = F.in[28];
    bf16* Wgu = (bf16*)(F.ws + WS_MOEW_GU); bf16* Wd = (bf16*)(F.ws + WS_MOEW_D);
    constexpr int I_GU = 16 * 112, I_D = 56 * 16;
    LAS unsigned* scru = (LAS unsigned*)scr;
    for (int it = gw; it < NE * (I_GU + I_D); it += NGW) {
        const int e = it / (I_GU + I_D); int r = it % (I_GU + I_D);
        if (r < I_GU) { const int kb = r / 112, nb = r % 112, r0 = 64 * nb, pn = r0 >> 8, j0 = r0 & 255;
            tr_tile64((j0 < 128 ? mg : mu) + (size_t)e * D * DFE, DFE, pn * 128 + (j0 & 127), Wgu + (size_t)e * 7168 * D, D, r0, 64 * kb, scru, F.lane); continue; }
        r -= I_GU;
        { const int kb = r / 16, nb = r % 16; tr_tile64(md + (size_t)e * DFE * D, D, 64 * nb, Wd + (size_t)e * D * DFE, DFE, 64 * nb, 64 * kb, scru, F.lane); }
    }
}

__device__ __forceinline__ void norm_phase(const Frame& F0, const float* x, const float* gain) { Frame F = opq(F0);
    const int gw = F.bid * NWAVES + F.wave, NGW = F.G * NWAVES;
    f32x4 g[4];
#pragma unroll
    for (int q = 0; q < 4; ++q) g[q] = ((const f32x4*)gain)[F.lane + 64 * q];
    bf16* H = (bf16*)(F.ws + WS_HM);
    for (int m = gw; m < T; m += NGW) { f32x4 v[4]; norm_row(x + (size_t)m * D, g, H + (size_t)m * D, v, F.lane); }
}
__device__ __forceinline__ void norm_router_phase(const Frame& F0, const float* x, const float* gain, const float* wr) { Frame F = opq(F0);
    LAS float* WR = (LAS float*)F.lds;
    LAS int* lcnt = (LAS int*)(F.lds + 32768);
    LAS int* lbase = lcnt + 16;
    LAS int* rE = lbase + 16;
    LAS int* rP1 = rE + 128; LAS int* rP2 = rP1 + 128;
    LAS float* rW = (LAS float*)(rP2 + 128);
    f32x4 g[4];
#pragma unroll
    for (int q = 0; q < 4; ++q) g[q] = ((const f32x4*)gain)[F.lane + 64 * q];
    for (int i = F.tid; i < 2048; i += NTHR) ((LAS f32x4*)WR)[i] = ((const f32x4*)wr)[i];
    bf16* H = (bf16*)(F.ws + WS_HM);
    int* stok = (int*)(F.ws + WS_STOK); float* sw = (float*)(F.ws + WS_SW);
    unsigned* gcnt = F.ctl + CW_MOECNT;
    for (int blk = F.bid; blk < T / 128; blk += F.G) {
        if (F.tid < 16) lcnt[F.tid] = 0;
        __syncthreads();
        f32x4 nv[4];
        { const f32x4* xr = (const f32x4*)(x + (size_t)(blk * 128 + F.wave * 16) * D) + F.lane;
#pragma unroll
            for (int q = 0; q < 4; ++q) nv[q] = xr[64 * q]; }
        for (int rr = 0; rr < 16; ++rr) {
            const int rl = F.wave * 16 + rr, m = blk * 128 + rl;
            f32x4 v[4];
#pragma unroll
            for (int q = 0; q < 4; ++q) v[q] = nv[q];
            if (rr + 1 < 16) { const f32x4* xr = (const f32x4*)(x + (size_t)(m + 1) * D) + F.lane;
#pragma unroll
                for (int q = 0; q < 4; ++q) nv[q] = xr[64 * q]; }
            float ss = 0.f, lg[8];
#pragma unroll
            for (int e = 0; e < 8; ++e) lg[e] = 0.f;
#pragma unroll
            for (int q = 0; q < 4; ++q) { ss += (v[q].x * v[q].x + v[q].y * v[q].y) + (v[q].z * v[q].z + v[q].w * v[q].w); v[q] = v[q] * g[q];
#pragma unroll
                for (int c = 0; c < 4; ++c) { const int k = 4 * (F.lane + 64 * q) + c; const f32x4 w0 = *(const LAS f32x4*)(WR + k * 8), w1 = *(const LAS f32x4*)(WR + k * 8 + 4); const float hv = v[q][c];
                    lg[0] += hv * w0.x; lg[1] += hv * w0.y; lg[2] += hv * w0.z; lg[3] += hv * w0.w; lg[4] += hv * w1.x; lg[5] += hv * w1.y; lg[6] += hv * w1.z; lg[7] += hv * w1.w; } }
            const float rinv = 1.0f / sqrtf(wave_sum(ss) * (1.f / D) + EPS);
            { unsigned long long* o8 = (unsigned long long*)(H + (size_t)m * D) + F.lane;
#pragma unroll
                for (int q = 0; q < 4; ++q) { const f32x4 hq = v[q] * rinv; o8[64 * q] = (unsigned long long)pk2(hq.x, hq.y) | ((unsigned long long)pk2(hq.z, hq.w) << 32); } }
#pragma unroll
            for (int e = 0; e < 8; ++e) lg[e] = wave_sum(lg[e]) * rinv;
            if (F.lane == 0) {
                int e1 = 0; float l1 = lg[0];
#pragma unroll
                for (int e = 1; e < 8; ++e) if (lg[e] > l1) { l1 = lg[e]; e1 = e; }
                int e2 = -1; float l2 = -3.0e38f;
#pragma unroll
                for (int e = 0; e < 8; ++e) if (e != e1 && lg[e] > l2) { l2 = lg[e]; e2 = e; }
                const float w1 = 1.0f / (1.0f + __expf(l2 - l1));
                rE[rl] = e1 | (e2 << 8); rW[rl] = w1;
                rP1[rl] = __hip_atomic_fetch_add(lcnt + e1, 1, __ATOMIC_RELAXED, __HIP_MEMORY_SCOPE_WORKGROUP);
                rP2[rl] = __hip_atomic_fetch_add(lcnt + 8 + e2, 1, __ATOMIC_RELAXED, __HIP_MEMORY_SCOPE_WORKGROUP);
            }
        }
        __syncthreads();
        if (F.tid < 16) lbase[F.tid] = (int)__hip_atomic_fetch_add(gcnt + F.tid, (unsigned)lcnt[F.tid], __ATOMIC_RELAXED, __HIP_MEMORY_SCOPE_AGENT);
        __syncthreads();
        if (F.tid < 128) { const int m = blk * 128 + F.tid, e1 = rE[F.tid] & 255, e2 = rE[F.tid] >> 8; const float w1 = rW[F.tid];
            const int s1 = e1 * T + lbase[e1] + rP1[F.tid], s2 = (8 + e2) * T + lbase[8 + e2] + rP2[F.tid];
            stok[s1] = m; sw[s1] = w1; stok[s2] = m; sw[s2] = 1.0f - w1; }
        __syncthreads();
    }
}
__device__ __forceinline__ void final_norm_phase(const Frame& F0, float* x, const float* gain) { Frame F = opq(F0);
    const int gw = F.bid * NWAVES + F.wave, NGW = F.G * NWAVES;
    f32x4 g[4];
#pragma unroll
    for (int q = 0; q < 4; ++q) g[q] = ((const f32x4*)gain)[F.lane + 64 * q];
    for (int m = gw; m < T; m += NGW) {
        f32x4* xr = (f32x4*)(x + (size_t)m * D) + F.lane; f32x4 v[4]; float s = 0.f;
#pragma unroll
        for (int j = 0; j < 4; ++j) { v[j] = xr[64 * j]; s += (v[j].x * v[j].x + v[j].y * v[j].y) + (v[j].z * v[j].z + v[j].w * v[j].w); }
        const float r = 1.0f / sqrtf(wave_sum(s) * (1.f / D) + EPS);
#pragma unroll
        for (int j = 0; j < 4; ++j) xr[64 * j] = v[j] * r * g[j];
    }
}

constexpr int LD = 68;
constexpr int MATF = 64 * LD;

__device__ __forceinline__ void ld8(const bf16* p, float (&o)[8]) { const u32x4 w = *(const u32x4*)p; o[0] = bflo(w.x); o[1] = bfhi(w.x); o[2] = bflo(w.y); o[3] = bfhi(w.y); o[4] = bflo(w.z); o[5] = bfhi(w.z); o[6] = bflo(w.w); o[7] = bfhi(w.w); }

__device__ __forceinline__ void conv8(const bf16* PROJ, int b, int tpos  , int col, const float* cw, int cwld, int c0, float (&y)[8]) {
#pragma unroll
    for (int e = 0; e < 8; ++e) y[e] = 0.f;
#pragma unroll
    for (int j = 0; j < 4; ++j) { const int tp = tpos - 3 + j;
        if (tp >= 0) { float xv[8]; ld8(PROJ + (size_t)(b * SEQ + tp) * PP + col, xv);
            const f32x4 w0 = *(const f32x4*)(cw + j * cwld + c0), w1 = *(const f32x4*)(cw + j * cwld + c0 + 4);
            y[0] += xv[0] * w0.x; y[1] += xv[1] * w0.y; y[2] += xv[2] * w0.z; y[3] += xv[3] * w0.w; y[4] += xv[4] * w1.x; y[5] += xv[5] * w1.y; y[6] += xv[6] * w1.z; y[7] += xv[7] * w1.w; } }
}

__device__ __forceinline__ void conv8r(const u32x4 (&r)[4], const float* cw, int cwld, int c0, float (&y)[8]) {
#pragma unroll
    for (int e = 0; e < 8; ++e) y[e] = 0.f;
#pragma unroll
    for (int j = 0; j < 4; ++j) { const u32x4 w = r[j]; const float xv[8] = {bflo(w.x), bfhi(w.x), bflo(w.y), bfhi(w.y), bflo(w.z), bfhi(w.z), bflo(w.w), bfhi(w.w)};
        const f32x4 w0 = *(const f32x4*)(cw + j * cwld + c0), w1 = *(const f32x4*)(cw + j * cwld + c0 + 4);
        y[0] += xv[0] * w0.x; y[1] += xv[1] * w0.y; y[2] += xv[2] * w0.z; y[3] += xv[3] * w0.w; y[4] += xv[4] * w1.x; y[5] += xv[5] * w1.y; y[6] += xv[6] * w1.z; y[7] += xv[7] * w1.w; }
}
__device__ __forceinline__ void fetch_rows(const bf16* PROJ, int b, int tpos, int col, u32x4 (&r)[4]) {
#pragma unroll
    for (int j = 0; j < 4; ++j) { const int tp = tpos - 3 + j; r[j] = tp >= 0 ? *(const u32x4*)(PROJ + (size_t)(b * SEQ + tp) * PP + col) : (u32x4){0u, 0u, 0u, 0u}; }
}
__device__ __forceinline__ void gdn_fetch(const Frame& F, int b, int n, int h, u32x4 (&rows)[3][4]) {
    const bf16* PROJ = (const bf16*)(F.ws + WS_PROJ);
#pragma unroll
    for (int i = 0; i < 3; ++i) { const int u = F.tid + NTHR * i, grp = u % 24, t = u / 24; fetch_rows(PROJ, b, n * CH + t, (grp >> 3) * 256 + h * 64 + (grp & 7) * 8, rows[i]); }
}
__device__ __forceinline__ void rg_fetch(const Frame& F, int b, int n, int nb, u32x4 (&rows)[4]) {
    fetch_rows((const bf16*)(F.ws + WS_PROJ), b, n * CH + (F.tid >> 3), XC + nb * 64 + 8 * (F.tid & 7), rows);
}
struct GlaIn { u32x4 v, qk; f32x4 lr; };
__device__ __forceinline__ void gla_fetch(const Frame& F, int b, int n, int h, GlaIn& g) {
    const bf16* PROJ = (const bf16*)(F.ws + WS_PROJ); const float* SM = (const float*)(F.ws + WS_SMALL);
    const int tok0 = b * SEQ + n * CH, t = F.tid >> 3, p = F.tid & 7;
    g.v = *(const u32x4*)(PROJ + (size_t)(tok0 + t) * PP + VD + h * 64 + 8 * p);
    g.qk = *(const u32x4*)(PROJ + (size_t)(tok0 + t) * PP + (p < 4 ? QD + h * 32 + 8 * p : KD + h * 32 + 8 * (p - 4)));
    g.lr = F.tid < 256 ? *(const f32x4*)(SM + (size_t)(tok0 + (F.tid >> 2)) * 32 + 8 + 4 * (F.tid & 3)) : (f32x4){0.f, 0.f, 0.f, 0.f};
}
__device__ __forceinline__ void unpack8(const u32x4 w, float (&o)[8]) { o[0] = bflo(w.x); o[1] = bfhi(w.x); o[2] = bflo(w.y); o[3] = bfhi(w.y); o[4] = bflo(w.z); o[5] = bfhi(w.z); o[6] = bflo(w.w); o[7] = bfhi(w.w); }

__device__ __forceinline__ void gdn_prep(const Frame& F0, int l, int b, int n, int h, const u32x4 (&rows)[3][4]) { Frame F = opq(F0);
    LAS float* Q = (LAS float*)F.lds; LAS float* Kk = Q + MATF; LAS float* UT = Kk + MATF; LAS float* WT = UT + MATF; LAS float* A = WT + MATF; LAS float* AQ = A + MATF; LAS float* KDT = AQ + MATF;
    LAS float* sBeta = KDT + MATF; LAS float* sG = sBeta + 64;
    const float* SM = (const float*)(F.ws + WS_SMALL);
    const float* cw = F.in[3] + (size_t)l * 4 * 768;
    const int tok0 = b * SEQ + n * CH, ch = ((b * NCH + n) * 4 + h);
#pragma unroll
    for (int i = 0; i < 3; ++i) { const int u = F.tid + NTHR * i, grp = u % 24, t = u / 24, which = grp >> 3, d0 = (grp & 7) * 8, c0 = which * 256 + h * 64 + d0;
        float y[8]; conv8r(rows[i], cw, 768, c0, y);
        if (which < 2) { LAS float* dst = (which == 0 ? Q : Kk) + t * LD + d0;
            *(LAS f32x4*)dst = (f32x4){siluf_(y[0]), siluf_(y[1]), siluf_(y[2]), siluf_(y[3])}; *(LAS f32x4*)(dst + 4) = (f32x4){siluf_(y[4]), siluf_(y[5]), siluf_(y[6]), siluf_(y[7])}; }
        else {
#pragma unroll
            for (int e = 0; e < 8; ++e) UT[(d0 + e) * LD + t] = siluf_(y[e]); } }
    if (F.wave == 0) { const int t = F.lane; const float bl = SM[(size_t)(tok0 + t) * 32 + h], al = SM[(size_t)(tok0 + t) * 32 + 4 + h];
        float g = -__expf(F.in[4][l * 4 + h]) * softplusf_(al + F.in[5][l * 4 + h]);
#pragma unroll
        for (int o = 1; o < 64; o <<= 1) { const float up = __shfl_up(g, o); if (t >= o) g += up; }
        sBeta[t] = sigmoidf_(bl); sG[t] = g; }
    __syncthreads();
    { const int t = F.tid >> 3, p = F.tid & 7; LAS float* qp = Q + t * LD + 8 * p; LAS float* kp = Kk + t * LD + 8 * p;
        f32x4 q0 = *(LAS f32x4*)qp, q1 = *(LAS f32x4*)(qp + 4), k0 = *(LAS f32x4*)kp, k1 = *(LAS f32x4*)(kp + 4);
        float sq = (q0.x * q0.x + q0.y * q0.y) + (q0.z * q0.z + q0.w * q0.w) + (q1.x * q1.x + q1.y * q1.y) + (q1.z * q1.z + q1.w * q1.w);
        float sk = (k0.x * k0.x + k0.y * k0.y) + (k0.z * k0.z + k0.w * k0.w) + (k1.x * k1.x + k1.y * k1.y) + (k1.z * k1.z + k1.w * k1.w);
#pragma unroll
        for (int o = 1; o < 8; o <<= 1) { sq += __shfl_xor(sq, o); sk += __shfl_xor(sk, o); }
        const float rq = 0.125f / sqrtf(sq + EPS), rk = 1.0f / sqrtf(sk + EPS), be = sBeta[t], eg = __expf(sG[t]);
        q0 = q0 * rq; q1 = q1 * rq; k0 = k0 * rk; k1 = k1 * rk;
        *(LAS f32x4*)qp = q0; *(LAS f32x4*)(qp + 4) = q1; *(LAS f32x4*)kp = k0; *(LAS f32x4*)(kp + 4) = k1;
        const float kw[8] = {k0.x, k0.y, k0.z, k0.w, k1.x, k1.y, k1.z, k1.w};
#pragma unroll
        for (int e = 0; e < 8; ++e) { WT[(8 * p + e) * LD + t] = kw[e] * (be * eg); UT[(8 * p + e) * LD + t] *= be; } }
    __syncthreads();
    { const int lr = F.lane & 15, lg = F.lane >> 4;
        for (int tl = F.wave; tl < 32; tl += NWAVES) { const int mat = tl >> 4, mi = (tl >> 2) & 3, ni = tl & 3; LAS float* dst = mat ? AQ : A;
            f32x4 acc = (f32x4){0.f, 0.f, 0.f, 0.f};
            if (mi >= ni) acc = mm16b<false, true>(mat ? Q : Kk, LD, Kk, LD, 16 * mi, 16 * ni, 64, acc, F.lane);
#pragma unroll
            for (int r = 0; r < 4; ++r) { const int i = 16 * mi + 4 * lg + r, j = 16 * ni + lr; float v = 0.f;
                if (mat ? (i >= j) : (i > j)) v = acc[r] * __expf(sG[i] - sG[j]) * (mat ? 1.0f : sBeta[i]);
                dst[i * LD + j] = v; } } }
    __syncthreads();
    { LAS float* TI = sG + 64; constexpr int TLD = 20;
        if (F.wave == 0) { const int blk = F.lane >> 4, c = F.lane & 15; float x[16];
#pragma unroll
            for (int r = 0; r < 16; ++r) { float v = (r == c) ? 1.0f : 0.0f;
#pragma unroll
                for (int c2 = 0; c2 < r; ++c2) v -= A[(16 * blk + r) * LD + 16 * blk + c2] * x[c2];
                x[r] = v; TI[(blk * 16 + r) * TLD + c] = v; } }
        __syncthreads();
        LAS float* XT = F.wave < 4 ? UT : WT; const int j0 = 16 * (F.wave & 3), lr = F.lane & 15, lg = F.lane >> 4;
        for (int bi = 0; bi < 4; ++bi) { LAS f32x4* xp = (LAS f32x4*)(XT + (j0 + lr) * LD + 16 * bi + 4 * lg);
            if (bi > 0) { const f32x4 acc = mm16b<false, true>(A, LD, XT, LD, 16 * bi, j0, 16 * bi, (f32x4){0.f, 0.f, 0.f, 0.f}, F.lane); *xp = *xp - acc; }
            const f32x4 xs = mm16b<false, true>(TI + bi * 16 * TLD, TLD, XT + 16 * bi, LD, 0, j0, 16, (f32x4){0.f, 0.f, 0.f, 0.f}, F.lane);
            *xp = xs; }
        __syncthreads(); }
    { const int t = F.tid >> 3, p = F.tid & 7; const float gl = sG[63], gt = sG[t], e1 = __expf(gl - gt), e2 = __expf(gt);
        LAS float* qp = Q + t * LD + 8 * p; const LAS float* kp = Kk + t * LD + 8 * p;
        *(LAS f32x4*)qp = *(LAS f32x4*)qp * e2; *(LAS f32x4*)(qp + 4) = *(LAS f32x4*)(qp + 4) * e2;
        const f32x4 k0 = *(const LAS f32x4*)kp, k1 = *(const LAS f32x4*)(kp + 4); const float kw[8] = {k0.x, k0.y, k0.z, k0.w, k1.x, k1.y, k1.z, k1.w};
#pragma unroll
        for (int e = 0; e < 8; ++e) KDT[(8 * p + e) * LD + t] = kw[e] * e1; }
    __syncthreads();
    { const int lr = F.lane & 15, lg = F.lane >> 4; const float dl = __expf(sG[63]);
        float* GM = (float*)(F.ws + WS_GM) + (size_t)ch * 4096; float* GN = (float*)(F.ws + WS_GN) + (size_t)ch * 4096;
        float* GQ = (float*)(F.ws + WS_GQ) + (size_t)ch * 4096; float* GO = (float*)(F.ws + WS_GO) + (size_t)ch * 4096;
        for (int tl = F.wave; tl < 16; tl += NWAVES) { const int mi = tl >> 2, ni = tl & 3;
            const f32x4 acc = mm16b<false, true>(KDT, LD, WT, LD, 16 * mi, 16 * ni, 64, (f32x4){0.f, 0.f, 0.f, 0.f}, F.lane);
#pragma unroll
            for (int r = 0; r < 4; ++r) { const int i = 16 * mi + 4 * lg + r, j = 16 * ni + lr, ks = j >> 2; const float v = (i == j ? dl : 0.f) - acc[r];
                GM[((mi * 4 + (ks >> 2)) * 64 + (i & 15) + 16 * (j & 3)) * 4 + (ks & 3)] = v; } }
        for (int tl = F.wave; tl < 16; tl += NWAVES) { const int mi = tl >> 2, ni = tl & 3;
            const f32x4 acc = mm16b<false, true>(KDT, LD, UT, LD, 16 * mi, 16 * ni, 64, (f32x4){0.f, 0.f, 0.f, 0.f}, F.lane);
#pragma unroll
            for (int r = 0; r < 4; ++r) GN[(16 * mi + 4 * lg + r) * 64 + 16 * ni + lr] = acc[r]; }
        for (int tl = F.wave; tl < 16; tl += NWAVES) { const int mi = tl >> 2, ni = tl & 3;
            const f32x4 acc = mm16b<false, true>(AQ, LD, WT, LD, 16 * mi, 16 * ni, 64, (f32x4){0.f, 0.f, 0.f, 0.f}, F.lane);
#pragma unroll
            for (int r = 0; r < 4; ++r) { const int i = 16 * mi + 4 * lg + r, j = 16 * ni + lr; GQ[i * 64 + j] = Q[i * LD + j] - acc[r]; } }
        for (int tl = F.wave; tl < 16; tl += NWAVES) { const int mi = tl >> 2, ni = tl & 3;
            const f32x4 acc = mm16b<false, true>(AQ, LD, UT, LD, 16 * mi, 16 * ni, 64, (f32x4){0.f, 0.f, 0.f, 0.f}, F.lane);
#pragma unroll
            for (int r = 0; r < 4; ++r) GO[(16 * mi + 4 * lg + r) * 64 + 16 * ni + lr] = acc[r]; } }
    __syncthreads();
}

__device__ __forceinline__ void gla_prep(const Frame& F0, int l, int b, int n, int h, const GlaIn& gin, bool load_w) { Frame F = opq(F0);
    constexpr int L3 = 36;
    LAS float* QE = (LAS float*)F.lds; LAS float* KE = QE + 64 * L3; LAS float* KDm = KE + 64 * L3; LAS float* Gm = KDm + 64 * L3; LAS float* V = Gm + 64 * L3; LAS float* AIN = V + MATF;
    LAS float* LR = AIN + MATF; LAS float* WL = LR + 64 * 16; LAS float* Qr = WL + 16 * 32; LAS float* Kr = Qr + 64 * L3;
    const bf16* PROJ = (const bf16*)(F.ws + WS_PROJ); const float* SM = (const float*)(F.ws + WS_SMALL);
    const int tok0 = b * SEQ + n * CH, ch = ((b * NCH + n) * 4 + h);
    { const int t = F.tid >> 3, p = F.tid & 7; float xv[8];
        unpack8(gin.v, xv);
        *(LAS f32x4*)(V + t * LD + 8 * p) = (f32x4){xv[0], xv[1], xv[2], xv[3]}; *(LAS f32x4*)(V + t * LD + 8 * p + 4) = (f32x4){xv[4], xv[5], xv[6], xv[7]};
        unpack8(gin.qk, xv);
        { LAS float* dst = (p < 4 ? Qr : Kr) + t * L3 + 8 * (p & 3); *(LAS f32x4*)dst = (f32x4){xv[0], xv[1], xv[2], xv[3]}; *(LAS f32x4*)(dst + 4) = (f32x4){xv[4], xv[5], xv[6], xv[7]}; }
        if (F.tid < 256) { const int t2 = F.tid >> 2, q4 = F.tid & 3; *(LAS f32x4*)(LR + t2 * 16 + 4 * q4) = gin.lr; }
        if (load_w) { const int r = F.tid >> 5, d = F.tid & 31; WL[r * 32 + d] = F.in[17][(size_t)l * 16 * 128 + r * 128 + h * 32 + d]; } }
    __syncthreads();
    { const int t = F.lane;
#pragma unroll
        for (int c = 0; c < 4; ++c) { const int d = F.wave * 4 + c; float s = F.in[18][l * 128 + h * 32 + d];
#pragma unroll
            for (int r = 0; r < 16; ++r) s += LR[t * 16 + r] * WL[r * 32 + d];
            float la = -softplusf_(-s) * (1.0f / 16.0f);
#pragma unroll
            for (int o = 1; o < 64; o <<= 1) { const float up = __shfl_up(la, o); if (t >= o) la += up; }
            Gm[t * L3 + d] = la; } }
    __syncthreads();
    { float* LQG = (float*)(F.ws + WS_LQG) + (size_t)ch * 2048; float* LDL = (float*)(F.ws + WS_LDL) + (size_t)ch * 32;
        const float sc = 0.17677669529663687f;
        for (int u = F.tid; u < 2048; u += NTHR) { const int t = u >> 5, d = u & 31; const float G = Gm[t * L3 + d], Gr = Gm[32 * L3 + d], Gl = Gm[63 * L3 + d];
            const float q = Qr[t * L3 + d] * sc, k = Kr[t * L3 + d];
            QE[t * L3 + d] = q * __expf(G - Gr); KE[t * L3 + d] = k * __expf(Gr - G); KDm[t * L3 + d] = k * __expf(Gl - G);
            LQG[t * 32 + d] = q * __expf(G); if (t == 63) LDL[d] = __expf(Gl); } }
    __syncthreads();
    { const int lr = F.lane & 15, lg = F.lane >> 4;
        for (int tl = F.wave; tl < 16; tl += NWAVES) { const int mi = tl >> 2, ni = tl & 3; f32x4 acc = (f32x4){0.f, 0.f, 0.f, 0.f};
            if (mi >= ni) acc = mm16b<false, true>(QE, L3, KE, L3, 16 * mi, 16 * ni, 32, acc, F.lane);
#pragma unroll
            for (int r = 0; r < 4; ++r) { const int i = 16 * mi + 4 * lg + r, j = 16 * ni + lr; AIN[i * LD + j] = (i >= j) ? acc[r] : 0.f; } } }
    __syncthreads();
    { const int lr = F.lane & 15, lg = F.lane >> 4; float* LOI = (float*)(F.ws + WS_LOI) + (size_t)ch * 4096; float* LKV = (float*)(F.ws + WS_LKV) + (size_t)ch * 2048;
        for (int tl = F.wave; tl < 16; tl += NWAVES) { const int mi = tl >> 2, ni = tl & 3;
            const f32x4 acc = mm16b<false, false>(AIN, LD, V, LD, 16 * mi, 16 * ni, 64, (f32x4){0.f, 0.f, 0.f, 0.f}, F.lane);
#pragma unroll
            for (int r = 0; r < 4; ++r) LOI[(16 * mi + 4 * lg + r) * 64 + 16 * ni + lr] = acc[r]; }
        { const int mi = F.wave >> 2, ni = F.wave & 3;
            const f32x4 acc = mm16b<true, false>(KDm, L3, V, LD, 16 * mi, 16 * ni, 64, (f32x4){0.f, 0.f, 0.f, 0.f}, F.lane);
#pragma unroll
            for (int r = 0; r < 4; ++r) LKV[(16 * mi + 4 * lg + r) * 64 + 16 * ni + lr] = acc[r]; } }
    __syncthreads();
}

__device__ __forceinline__ void rg_prep(const Frame& F0, int l, int b, int n, int nb, const u32x4 (&rows)[4], bool load_w) { Frame F = opq(F0);
    LAS float* XCm = (LAS float*)F.lds; LAS float* WA = XCm + MATF; LAS float* WX = WA + MATF; LAS float* AA = WX + MATF; LAS float* segA = AA + MATF; LAS float* segH = segA + 512;
    const bf16* PROJ = (const bf16*)(F.ws + WS_PROJ);
    const int tok0 = b * SEQ + n * CH;
    { const int t = F.tid >> 3, p = F.tid & 7, c0 = nb * 64 + 8 * p; float y[8];
        conv8r(rows, F.in[10] + (size_t)l * 4 * 256, 256, c0, y);
        const float* cb = F.in[11] + l * 256 + c0;
        *(LAS f32x4*)(XCm + t * LD + 8 * p) = (f32x4){y[0] + cb[0], y[1] + cb[1], y[2] + cb[2], y[3] + cb[3]}; *(LAS f32x4*)(XCm + t * LD + 8 * p + 4) = (f32x4){y[4] + cb[4], y[5] + cb[5], y[6] + cb[6], y[7] + cb[7]};
        const float* wa = F.in[12] + ((size_t)l * 4 + nb) * 4096; const float* wx = F.in[14] + ((size_t)l * 4 + nb) * 4096;
        if (load_w)
#pragma unroll
        for (int i = 0; i < 2; ++i) { const int e = F.tid + NTHR * i, r = e >> 4, c4 = (e & 15) * 4;
            const f32x4 va = *(const f32x4*)(wa + r * 64 + c4), vx = *(const f32x4*)(wx + r * 64 + c4);
            WA[(c4 + 0) * LD + r] = va.x; WA[(c4 + 1) * LD + r] = va.y; WA[(c4 + 2) * LD + r] = va.z; WA[(c4 + 3) * LD + r] = va.w;
            WX[(c4 + 0) * LD + r] = vx.x; WX[(c4 + 1) * LD + r] = vx.y; WX[(c4 + 2) * LD + r] = vx.z; WX[(c4 + 3) * LD + r] = vx.w; }
        if (load_w && F.tid < 64) { const int cg = nb * 64 + F.tid; LAS float* BV = segH + 512; BV[F.tid] = F.in[13][l * 256 + cg]; BV[64 + F.tid] = F.in[15][l * 256 + cg]; BV[128 + F.tid] = softplusf_(F.in[16][l * 256 + cg]); } }
    __syncthreads();
    { const int lr = F.lane & 15, lg = F.lane >> 4; f32x4 ga[2], gx[2];
#pragma unroll
        for (int q = 0; q < 2; ++q) { const int tl = F.wave + 8 * q, mi = tl >> 2, ni = tl & 3;
            ga[q] = mm16b<false, true>(XCm, LD, WA, LD, 16 * mi, 16 * ni, 64, (f32x4){0.f, 0.f, 0.f, 0.f}, F.lane);
            gx[q] = mm16b<false, true>(XCm, LD, WX, LD, 16 * mi, 16 * ni, 64, (f32x4){0.f, 0.f, 0.f, 0.f}, F.lane); }
        __syncthreads();
#pragma unroll
        for (int q = 0; q < 2; ++q) { const int tl = F.wave + 8 * q, mi = tl >> 2, ni = tl & 3, j = 16 * ni + lr, cg = nb * 64 + j;
            const LAS float* BV = segH + 512; const float ba = BV[j], bx = BV[64 + j], sp = BV[128 + j]; (void)cg;
#pragma unroll
            for (int r = 0; r < 4; ++r) { const int i = 16 * mi + 4 * lg + r; const float la = -8.0f * sigmoidf_(ga[q][r] + ba) * sp, a = __expf(la);
                const float mult = sqrtf(fmaxf(-expm1f(2.0f * la), 0.f)); const float xc = XCm[i * LD + j];
                AA[i * LD + j] = a; XCm[i * LD + j] = xc * sigmoidf_(gx[q][r] + bx) * mult; } } }
    __syncthreads();
    { const int c = F.tid & 63, sg = F.tid >> 6; float hh = 0.f, pp = 1.f; float hl[8], pl[8];
#pragma unroll
        for (int tt = 0; tt < 8; ++tt) { const int t = 8 * sg + tt; const float a = AA[t * LD + c], u = XCm[t * LD + c]; hh = a * hh + u; pp = pp * a; hl[tt] = hh; pl[tt] = pp; }
        segA[sg * 64 + c] = pp; segH[sg * 64 + c] = hh;
        __syncthreads();
        float hin = 0.f, pin = 1.f;
        for (int s2 = 0; s2 < sg; ++s2) { const float a = segA[s2 * 64 + c]; hin = a * hin + segH[s2 * 64 + c]; pin *= a; }
        bf16* RHL = (bf16*)(F.ws + WS_RHL); bf16* RP = (bf16*)(F.ws + WS_RP);
#pragma unroll
        for (int tt = 0; tt < 8; ++tt) { const int t = 8 * sg + tt; const float hv = hl[tt] + pl[tt] * hin, pv = pl[tt] * pin;
            RHL[(size_t)(tok0 + t) * 256 + nb * 64 + c] = (bf16)f2bf(hv); RP[(size_t)(tok0 + t) * 256 + nb * 64 + c] = (bf16)f2bf(pv);
            if (t == 63) { ((float*)(F.ws + WS_RAT))[(b * NCH + n) * 256 + nb * 64 + c] = pv; ((float*)(F.ws + WS_RHE))[(b * NCH + n) * 256 + nb * 64 + c] = hv; } } }
    __syncthreads();
}
__device__ __forceinline__ void prep_phase(Frame& F, int l) {
    { u32x4 nx[3][4]; int idx = F.bid;
        if (idx < 2048) gdn_fetch(F, (idx >> 2) >> 6, (idx >> 2) & 63, idx & 3, nx);
        for (; idx < 2048; idx += F.G) { u32x4 cur[3][4];
#pragma unroll
            for (int i = 0; i < 3; ++i)
#pragma unroll
                for (int j = 0; j < 4; ++j) cur[i][j] = nx[i][j];
            const int ni = idx + F.G; if (ni < 2048) gdn_fetch(F, (ni >> 2) >> 6, (ni >> 2) & 63, ni & 3, nx);
            gdn_prep(F, l, (idx >> 2) >> 6, (idx >> 2) & 63, idx & 3, cur); } }
    { GlaIn nx; int idx = F.bid, hw = -1;
        if (idx < 2048) gla_fetch(F, (idx >> 2) >> 6, (idx >> 2) & 63, idx & 3, nx);
        for (; idx < 2048; idx += F.G) { const GlaIn cur = nx;
            const int ni = idx + F.G; if (ni < 2048) gla_fetch(F, (ni >> 2) >> 6, (ni >> 2) & 63, ni & 3, nx);
            gla_prep(F, l, (idx >> 2) >> 6, (idx >> 2) & 63, idx & 3, cur, (idx & 3) != hw); hw = idx & 3; } }
    { u32x4 nx[4]; int idx = F.bid, bw = -1;
        if (idx < 2048) rg_fetch(F, (idx >> 2) >> 6, (idx >> 2) & 63, idx & 3, nx);
        for (; idx < 2048; idx += F.G) { u32x4 cur[4];
#pragma unroll
            for (int j = 0; j < 4; ++j) cur[j] = nx[j];
            const int ni = idx + F.G; if (ni < 2048) rg_fetch(F, (ni >> 2) >> 6, (ni >> 2) & 63, ni & 3, nx);
            rg_prep(F, l, (idx >> 2) >> 6, (idx >> 2) & 63, idx & 3, cur, (idx & 3) != bw); bw = idx & 3; } }
}

__device__ __forceinline__ f32x16 mfma32(bf16x8 a, bf16x8 b, f32x16 c) { return __builtin_amdgcn_mfma_f32_32x32x16_bf16(a, b, c, 0, 0, 0); }
typedef short v4i16_t __attribute__((ext_vector_type(4)));
__device__ __forceinline__ s16x4 vtr(const LAS unsigned char* p) { return __builtin_bit_cast(s16x4, __builtin_amdgcn_ds_read_tr16_b64_v4i16((LAS v4i16_t*)p)); }

__device__ __forceinline__ void attn_item(const Frame& F0, int l, int b, int h, int qb) { Frame F = opq(F0);
    constexpr int KP = 144, KT_BYTES = 64 * KP;
    LAS unsigned char* Kt = F.lds; LAS unsigned char* Vt = F.lds + 4 * KT_BYTES;
    LAS float* LUT = (LAS float*)(F.lds + 8 * KT_BYTES); LAS float* sLam = LUT + 256; LAS float* ML = sLam + 64;
    LAS float* MO = (LAS float*)F.lds;
    const bf16* PROJ = (const bf16*)(F.ws + WS_PROJ); bf16* MIX = (bf16*)(F.ws + WS_HM);
    const float lam_init = l == 0 ? 0.2f : 0.35550906759096926f;
    if (F.tid < 256) { const int delta = F.tid - 191, na = delta < 0 ? -delta : delta;
        int bk = na < 8 ? na : na < 12 ? 8 : na < 16 ? 9 : na < 23 ? 10 : na < 32 ? 11 : na < 46 ? 12 : na < 64 ? 13 : na < 91 ? 14 : 15;
        if (delta > 0) bk += 16;
        LUT[F.tid] = F.in[9][bk * 4 + h] * LOG2E; }
    if (F.wave == 4) { const float* lv = F.in[7] + l * 128; const int i = F.lane & 31;
        float p = F.lane < 32 ? lv[i] * lv[32 + i] : lv[64 + i] * lv[96 + i];
#pragma unroll
        for (int o = 1; o < 32; o <<= 1) p += __shfl_xor(p, o);
        const float e = __expf(p), e2 = __shfl_xor(e, 32);
        if (F.lane == 0) sLam[0] = e - e2 + lam_init; }
    __syncthreads();
    const float lam = sLam[0];
    const int w = F.wave, w4 = w & 3, half = w >> 2, cq = qb * 2 + (w4 >> 1), r32 = F.lane & 31, hh = F.lane >> 5, qoff = 32 * (w4 & 1) + r32;
    const size_t t0 = (size_t)b * SEQ + qb * 128 + 32 * w4 + r32;
    bf16x8 qf[2][2];
#pragma unroll
    for (int c = 0; c < 2; ++c)
#pragma unroll
        for (int s = 0; s < 2; ++s) qf[c][s] = *(const bf16x8*)(PROJ + t0 * PP + QB + h * 64 + c * 32 + 16 * s + 8 * hh);
    f32x16 O[2][2]; float mrun[2], lrun[2];
#pragma unroll
    for (int c = 0; c < 2; ++c) { mrun[c] = -1.0e30f; lrun[c] = 0.f;
#pragma unroll
        for (int mt = 0; mt < 2; ++mt)
#pragma unroll
            for (int i = 0; i < 16; ++i) O[c][mt][i] = 0.f; }
    const int skey = F.tid >> 3, sseg = F.tid & 7, nstep = qb + 1;
    const bf16* kg = PROJ + ((size_t)b * SEQ + skey) * PP + KB + h * 64 + sseg * 8; const bf16* vg = PROJ + ((size_t)b * SEQ + skey) * PP + VB + h * 64 + sseg * 8;
    u32x4 kreg0 = *(const u32x4*)kg, vreg0 = *(const u32x4*)vg, kreg1 = *(const u32x4*)(kg + (size_t)64 * PP), vreg1 = *(const u32x4*)(vg + (size_t)64 * PP);
    const float SC = 0.17677669529663687f * LOG2E;
    for (int j = 0; j < nstep; ++j) {
        const int buf = j & 1, kt = 2 * j + half;
        *(LAS u32x4*)(Kt + (buf * 2 + 0) * KT_BYTES + skey * KP + sseg * 16) = kreg0; *(LAS u32x4*)(Vt + (buf * 2 + 0) * KT_BYTES + skey * KP + sseg * 16) = vreg0;
        *(LAS u32x4*)(Kt + (buf * 2 + 1) * KT_BYTES + skey * KP + sseg * 16) = kreg1; *(LAS u32x4*)(Vt + (buf * 2 + 1) * KT_BYTES + skey * KP + sseg * 16) = vreg1;
        __syncthreads();
        if (j + 1 < nstep) { const size_t o0 = (size_t)(2 * j + 2) * 64 * PP, o1 = o0 + (size_t)64 * PP;
            kreg0 = *(const u32x4*)(kg + o0); vreg0 = *(const u32x4*)(vg + o0); kreg1 = *(const u32x4*)(kg + o1); vreg1 = *(const u32x4*)(vg + o1); }
        if (kt <= cq) {
            const int lutbase = (kt - cq) * 64 - qoff + 191;
            const LAS unsigned char* Kb = Kt + (buf * 2 + half) * KT_BYTES; const LAS unsigned char* Vb = Vt + (buf * 2 + half) * KT_BYTES;
#pragma unroll
            for (int kb = 0; kb < 2; ++kb) {
                f32x16 S[2];
#pragma unroll
                for (int c = 0; c < 2; ++c) { f32x16 z;
#pragma unroll
                    for (int i = 0; i < 16; ++i) z[i] = 0.f;
                    const bf16x8 k0 = *(const LAS bf16x8*)(Kb + (32 * kb + r32) * KP + (c * 32 + 8 * hh) * 2), k1 = *(const LAS bf16x8*)(Kb + (32 * kb + r32) * KP + (c * 32 + 16 + 8 * hh) * 2);
                    z = mfma32(k0, qf[c][0], z); S[c] = mfma32(k1, qf[c][1], z); }
                float bias[16];
#pragma unroll
                for (int i = 0; i < 16; ++i) { const int idx = lutbase + 32 * kb + (i & 3) + 8 * (i >> 2) + 4 * hh; bias[i] = LUT[idx > 0 ? idx : 0]; }
                bf16x8 pb[2][2];
#pragma unroll
                for (int c = 0; c < 2; ++c) {
                    float mx = -1.0e30f;
#pragma unroll
                    for (int i = 0; i < 16; ++i) { S[c][i] = S[c][i] * SC + bias[i]; mx = fmaxf(mx, S[c][i]); }
                    mx = fmaxf(mx, __shfl_xor(mx, 32));
                    if (__any(mx > mrun[c] + 8.0f)) {
                        const float mn = fmaxf(mrun[c], mx), alpha = __builtin_amdgcn_exp2f(mrun[c] - mn); mrun[c] = mn; lrun[c] *= alpha;
#pragma unroll
                        for (int mt = 0; mt < 2; ++mt)
#pragma unroll
                            for (int i = 0; i < 16; ++i) O[c][mt][i] *= alpha; }
                    const float mr = mrun[c]; float ps = 0.f;
#pragma unroll
                    for (int i = 0; i < 16; ++i) { S[c][i] = __builtin_amdgcn_exp2f(S[c][i] - mr); ps += S[c][i]; }
                    lrun[c] += ps;
#pragma unroll
                    for (int s = 0; s < 2; ++s) { u32x4 pw; pw.x = pg8::cvt_pk_bf16(S[c][8 * s + 0], S[c][8 * s + 1]); pw.y = pg8::cvt_pk_bf16(S[c][8 * s + 2], S[c][8 * s + 3]); pw.z = pg8::cvt_pk_bf16(S[c][8 * s + 4], S[c][8 * s + 5]); pw.w = pg8::cvt_pk_bf16(S[c][8 * s + 6], S[c][8 * s + 7]);
                        pb[c][s] = __builtin_bit_cast(bf16x8, pw); }
                }
#pragma unroll
                for (int mt = 0; mt < 2; ++mt)
#pragma unroll
                    for (int s = 0; s < 2; ++s) {
                        const LAS unsigned char* vp = Vb + (32 * kb + 16 * s + 4 * hh + ((F.lane & 15) >> 2)) * KP + (32 * mt + 16 * ((F.lane >> 4) & 1) + 4 * (F.lane & 3)) * 2;
                        const s16x4 v0 = vtr(vp), v1 = vtr(vp + 8 * KP);
                        bf16x8 vf; vf[0] = v0[0]; vf[1] = v0[1]; vf[2] = v0[2]; vf[3] = v0[3]; vf[4] = v1[0]; vf[5] = v1[1]; vf[6] = v1[2]; vf[7] = v1[3];
                        O[0][mt] = mfma32(vf, pb[0][s], O[0][mt]); O[1][mt] = mfma32(vf, pb[1][s], O[1][mt]); }
            }
        }
    }
    __syncthreads();
    if (half) {
#pragma unroll
        for (int c = 0; c < 2; ++c) { ML[(w4 * 4 + c) * 64 + F.lane] = mrun[c]; ML[(w4 * 4 + 2 + c) * 64 + F.lane] = lrun[c];
#pragma unroll
            for (int mt = 0; mt < 2; ++mt)
#pragma unroll
                for (int i = 0; i < 16; ++i) MO[(w4 * 64 + c * 32 + mt * 16 + i) * 64 + F.lane] = O[c][mt][i]; } }
    __syncthreads();
    if (!half) {
#pragma unroll
        for (int c = 0; c < 2; ++c) { const float m2 = ML[(w4 * 4 + c) * 64 + F.lane], l2 = ML[(w4 * 4 + 2 + c) * 64 + F.lane];
            const float mn = fmaxf(mrun[c], m2), a1 = __builtin_amdgcn_exp2f(mrun[c] - mn), a2 = __builtin_amdgcn_exp2f(m2 - mn);
            lrun[c] = lrun[c] * a1 + l2 * a2;
#pragma unroll
            for (int mt = 0; mt < 2; ++mt)
#pragma unroll
                for (int i = 0; i < 16; ++i) O[c][mt][i] = O[c][mt][i] * a1 + MO[(w4 * 64 + c * 32 + mt * 16 + i) * 64 + F.lane] * a2; } const float i0 = 1.0f / (lrun[0] + __shfl_xor(lrun[0], 32)), i1 = lam / (lrun[1] + __shfl_xor(lrun[1], 32));
        float ss = 0.f;
#pragma unroll
        for (int mt = 0; mt < 2; ++mt)
#pragma unroll
            for (int i = 0; i < 16; ++i) { const float a = O[0][mt][i] * i0 - O[1][mt][i] * i1; O[0][mt][i] = a; ss += a * a; }
        ss += __shfl_xor(ss, 32);
        const float rs = (1.0f - lam_init) / sqrtf(ss * (1.0f / 64.0f) + EPS);
        const float* bn = F.in[8] + l * 64;
#pragma unroll
        for (int mt = 0; mt < 2; ++mt)
#pragma unroll
            for (int g4 = 0; g4 < 4; ++g4) { const int dv0 = 32 * mt + 8 * g4 + 4 * hh; const f32x4 gn = *(const f32x4*)(bn + dv0);
                u32x2 o; o.x = pk2(O[0][mt][4 * g4 + 0] * rs * gn.x, O[0][mt][4 * g4 + 1] * rs * gn.y); o.y = pk2(O[0][mt][4 * g4 + 2] * rs * gn.z, O[0][mt][4 * g4 + 3] * rs * gn.w);
                if (ABL & 8) { o.x = 0u; o.y = 0u; }
                *(u32x2*)(MIX + t0 * D + 256 + h * 64 + dv0) = o; } }
    __syncthreads();
}

__device__ __forceinline__ void gdn_chain_item(const Frame& F0, int b, int h, int pair) { Frame F = opq(F0);
    const int w = F.wave, chain = w >> 2, cg = 2 * pair + chain, mi = w & 3, lr = F.lane & 15, lg = F.lane >> 4;
    LAS float* Sb = (LAS float*)F.lds + chain * 2048;
    const f32x4* GMv = (const f32x4*)(F.ws + WS_GM); float* GN = (float*)(F.ws + WS_GN);
    f32x4 s_cur = (f32x4){0.f, 0.f, 0.f, 0.f};
#pragma unroll
    for (int r = 0; r < 4; ++r) Sb[(16 * mi + 4 * lg + r) * 16 + lr] = 0.f;
    __syncthreads();
    f32x4 mq[4][4], nq[4];
#define GDN_LOAD(slot, n_) do { const size_t _ch = (size_t)((b * NCH + (n_)) * 4 + h); \
        _Pragma("unroll") for (int _q = 0; _q < 4; ++_q) mq[slot][_q] = GMv[_ch * 1024 + (mi * 4 + _q) * 64 + F.lane]; \
        _Pragma("unroll") for (int _r = 0; _r < 4; ++_r) nq[slot][_r] = GN[_ch * 4096 + (16 * mi + 4 * lg + _r) * 64 + 16 * cg + lr]; } while (0)
    GDN_LOAD(0, 0); GDN_LOAD(1, 1); GDN_LOAD(2, 2); GDN_LOAD(3, 3);
    for (int n0 = 0; n0 < NCH; n0 += 4) {
#pragma unroll
        for (int u = 0; u < 4; ++u) { const int n = n0 + u, buf = u & 1; const size_t ch = (size_t)((b * NCH + n) * 4 + h);
            f32x4 acc = nq[u];
#pragma unroll
            for (int r = 0; r < 4; ++r) GN[ch * 4096 + (16 * mi + 4 * lg + r) * 64 + 16 * cg + lr] = s_cur[r];
#pragma unroll
            for (int ks = 0; ks < 16; ++ks) { const float a = mq[u][ks >> 2][ks & 3], bv = Sb[buf * 1024 + (4 * ks + lg) * 16 + lr]; acc = __builtin_amdgcn_mfma_f32_16x16x4f32(a, bv, acc, 0, 0, 0); }
            asm volatile("s_nop 15\n\ts_nop 7" : "+v"(acc));
            s_cur = acc;
#pragma unroll
            for (int r = 0; r < 4; ++r) Sb[(buf ^ 1) * 1024 + (16 * mi + 4 * lg + r) * 16 + lr] = acc[r];
            if (n + 4 < NCH) GDN_LOAD(u, n + 4);
            __syncthreads(); }
    }
#undef GDN_LOAD
}
__device__ __forceinline__ void gla_prefix_item(const Frame& F0, int b, int h) { Frame F = opq(F0);
    f32x4* LKV = (f32x4*)(F.ws + WS_LKV); const float* LDL = (const float*)(F.ws + WS_LDL); const int dk = F.tid >> 4;
    f32x4 s = (f32x4){0.f, 0.f, 0.f, 0.f}, kvq[8]; float dq[8];
#pragma unroll
    for (int u = 0; u < 8; ++u) { const size_t ch = (size_t)((b * NCH + u) * 4 + h); kvq[u] = LKV[ch * 512 + F.tid]; dq[u] = LDL[ch * 32 + dk]; }
    for (int n0 = 0; n0 < NCH; n0 += 8) {
#pragma unroll
        for (int u = 0; u < 8; ++u) { const int n = n0 + u; const size_t ch = (size_t)((b * NCH + n) * 4 + h);
            const f32x4 kv = kvq[u]; const float d = dq[u];
            LKV[ch * 512 + F.tid] = s; s = s * d + kv;
            if (n + 8 < NCH) { const size_t c2 = (size_t)((b * NCH + n + 8) * 4 + h); kvq[u] = LKV[c2 * 512 + F.tid]; dq[u] = LDL[c2 * 32 + dk]; } }
    }
}
__device__ __forceinline__ void rg_carry_item(const Frame& F0, int j) { Frame F = opq(F0);
    const int gid = j * NTHR + F.tid, b = gid >> 8, c = gid & 255;
    const float* RAT = (const float*)(F.ws + WS_RAT); const float* RHE = (const float*)(F.ws + WS_RHE); float* RCA = (float*)(F.ws + WS_RCA);
    float carry = 0.f;
#pragma unroll 8
    for (int n = 0; n < NCH; ++n) { const int ci = (b * NCH + n) * 256 + c; const float a = RAT[ci], hn = RHE[ci]; RCA[ci] = carry; carry = a * carry + hn; }
}
constexpr int Q_GDN = 64, Q_GLA = 32, Q_RG = 4, Q_ATT = 1024, Q_ITEMS = Q_GDN + Q_GLA + Q_RG + Q_ATT;
__device__ __forceinline__ void scan_attn_phase(Frame& F, int l) {
    for (;;) {
        __syncthreads();
        if (F.tid == 0) F.MISC[16] = __hip_atomic_fetch_add(F.ctl + CW_QUEUE + 64 * l, 1u, __ATOMIC_RELAXED, __HIP_MEMORY_SCOPE_AGENT);
        __syncthreads();
        const int it = (int)F.MISC[16];
        if (it >= Q_ITEMS) break;
        if (it < Q_GDN) gdn_chain_item(F, it >> 3, (it >> 1) & 3, it & 1);
        else if (it < Q_GDN + Q_GLA) { const int q = it - Q_GDN; gla_prefix_item(F, q >> 2, q & 3); }
        else if (it < Q_GDN + Q_GLA + Q_RG) rg_carry_item(F, it - Q_GDN - Q_GLA);
        else { const int a = it - (Q_GDN + Q_GLA + Q_RG), qb = 31 - (a >> 5), bh = a & 31; attn_item(F, l, bh >> 2, bh & 3, qb); }
    }
    if (REPEAT & 4) for (;;) {
        __syncthreads();
        if (F.tid == 0) F.MISC[16] = __hip_atomic_fetch_add(F.ctl + CW_QUEUE + 64 * (2 + l), 1u, __ATOMIC_RELAXED, __HIP_MEMORY_SCOPE_AGENT);
        __syncthreads();
        const int a = (int)F.MISC[16];
        if (a >= Q_ATT) break;
        const int qb = 31 - (a >> 5), bh = a & 31; attn_item(F, l, bh >> 2, bh & 3, qb);
    }
}

__device__ __forceinline__ void norm_gate_store(Frame& F, const LAS float* OUT, const float* gain, const bf16* gate  , bf16* dst, bool silu_gate) {
    const int t = F.tid >> 3, p = F.tid & 7; const f32x4 a = *(const LAS f32x4*)(OUT + t * LD + 8 * p), c = *(const LAS f32x4*)(OUT + t * LD + 8 * p + 4);
    float ss = (a.x * a.x + a.y * a.y) + (a.z * a.z + a.w * a.w) + (c.x * c.x + c.y * c.y) + (c.z * c.z + c.w * c.w);
#pragma unroll
    for (int o = 1; o < 8; o <<= 1) ss += __shfl_xor(ss, o);
    const float rs = 1.0f / sqrtf(ss * (1.0f / 64.0f) + EPS);
    float gv[8]; ld8(gate + (size_t)t * PP + 8 * p, gv);
    const f32x4 g0 = *(const f32x4*)(gain + 8 * p), g1 = *(const f32x4*)(gain + 8 * p + 4);
    float o[8] = {a.x * rs * g0.x, a.y * rs * g0.y, a.z * rs * g0.z, a.w * rs * g0.w, c.x * rs * g1.x, c.y * rs * g1.y, c.z * rs * g1.z, c.w * rs * g1.w};
#pragma unroll
    for (int e = 0; e < 8; ++e) o[e] *= siluf_(gv[e]) * (((ABL & 512) && gain == F.in[6] + 0) ? 2.0f : 1.0f);
    u32x4 w; w.x = pk2(o[0], o[1]); w.y = pk2(o[2], o[3]); w.z = pk2(o[4], o[5]); w.w = pk2(o[6], o[7]);
    if (!silu_gate) w = (u32x4){0u, 0u, 0u, 0u};
    *(u32x4*)(dst + (size_t)t * D + 8 * p) = w;
}
struct FinIn { f32x4 a0, a1, b0, b1, c0, c1; u32x4 gate; };
__device__ __forceinline__ void fin_fetch(const Frame& F, int it, int hj, FinIn& x) {
    const int b = it >> 6, n = it & 63, h = hj & 3, lr = F.lane & 15, lg = F.lane >> 4; const size_t ch = (size_t)((b * NCH + n) * 4 + h), tok0 = (size_t)b * SEQ + n * CH;
    const bf16* PROJ = (const bf16*)(F.ws + WS_PROJ); const float* ini;
    if (hj < 4) { const f32x4* GQ = (const f32x4*)(F.ws + WS_GQ) + ch * 1024; const f32x4* GS = (const f32x4*)(F.ws + WS_GN) + ch * 1024; ini = (const float*)(F.ws + WS_GO) + ch * 4096;
        x.a0 = GQ[F.tid]; x.a1 = GQ[F.tid + NTHR]; x.b0 = GS[F.tid]; x.b1 = GS[F.tid + NTHR]; }
    else { const f32x4* LQG = (const f32x4*)(F.ws + WS_LQG) + ch * 512; const f32x4* LS = (const f32x4*)(F.ws + WS_LKV) + ch * 512; ini = (const float*)(F.ws + WS_LOI) + ch * 4096;
        x.a0 = LQG[F.tid]; x.b0 = LS[F.tid]; x.a1 = x.a0; x.b1 = x.b0; }
#pragma unroll
    for (int r = 0; r < 4; ++r) { const int t0 = F.wave, t1 = F.wave + 8; x.c0[r] = ini[(16 * (t0 >> 2) + 4 * lg + r) * 64 + 16 * (t0 & 3) + lr]; x.c1[r] = ini[(16 * (t1 >> 2) + 4 * lg + r) * 64 + 16 * (t1 & 3) + lr]; }
    x.gate = *(const u32x4*)(PROJ + (tok0 + (F.tid >> 3)) * PP + (hj < 4 ? GA : RD) + h * 64 + 8 * (F.tid & 7));
}
__device__ __forceinline__ void finalize_phase(const Frame& F0, int l) { Frame F = opq(F0);
    LAS float* QP = (LAS float*)F.lds; LAS float* SPT = QP + MATF; LAS float* OUT = SPT + MATF;
    const bf16* PROJ = (const bf16*)(F.ws + WS_PROJ); bf16* MIX = (bf16*)(F.ws + WS_HM);
    const int lr = F.lane & 15, lg = F.lane >> 4;
    FinIn nx; if (F.bid < NB * NCH) fin_fetch(F, F.bid, 0, nx);
    for (int it = F.bid; it < NB * NCH; it += F.G) { const int b = it >> 6, n = it & 63; const size_t tok0 = (size_t)b * SEQ + n * CH;
        for (int hj = 0; hj < 8; ++hj) { const FinIn cur = nx; const int h = hj & 3;
            if (hj < 4) {
#pragma unroll
                for (int i = 0; i < 2; ++i) { const int e = F.tid + NTHR * i, r = e >> 4, c4 = (e & 15) * 4; const f32x4 qv = i ? cur.a1 : cur.a0, sv = i ? cur.b1 : cur.b0;
                    *(LAS f32x4*)(QP + r * LD + c4) = qv; SPT[(c4 + 0) * LD + r] = sv.x; SPT[(c4 + 1) * LD + r] = sv.y; SPT[(c4 + 2) * LD + r] = sv.z; SPT[(c4 + 3) * LD + r] = sv.w; } }
            else { const int r = F.tid >> 3, c4 = (F.tid & 7) * 4; *(LAS f32x4*)(QP + r * 36 + c4) = cur.a0;
                const int r2 = F.tid >> 4, c42 = (F.tid & 15) * 4; SPT[(c42 + 0) * LD + r2] = cur.b0.x; SPT[(c42 + 1) * LD + r2] = cur.b0.y; SPT[(c42 + 2) * LD + r2] = cur.b0.z; SPT[(c42 + 3) * LD + r2] = cur.b0.w; }
            __syncthreads();
            { int nit = it, nhj = hj + 1; if (nhj == 8) { nhj = 0; nit = it + F.G; } if (nit < NB * NCH) fin_fetch(F, nit, nhj, nx); }
#pragma unroll
            for (int q = 0; q < 2; ++q) { const int tl = F.wave + 8 * q, mi = tl >> 2, ni = tl & 3; f32x4 acc = q ? cur.c1 : cur.c0;
                if (hj < 4) { if (!(ABL & 128)) acc = mm16b<false, true>(QP, LD, SPT, LD, 16 * mi, 16 * ni, 64, acc, F.lane); }
                else acc = mm16b<false, true>(QP, 36, SPT, LD, 16 * mi, 16 * ni, 32, acc, F.lane);
#pragma unroll
                for (int r = 0; r < 4; ++r) OUT[(16 * mi + 4 * lg + r) * LD + 16 * ni + lr] = acc[r]; }
            __syncthreads();
            { const int t = F.tid >> 3, p = F.tid & 7; const f32x4 a = *(const LAS f32x4*)(OUT + t * LD + 8 * p), c = *(const LAS f32x4*)(OUT + t * LD + 8 * p + 4);
                float ss = (a.x * a.x + a.y * a.y) + (a.z * a.z + a.w * a.w) + (c.x * c.x + c.y * c.y) + (c.z * c.z + c.w * c.w);
#pragma unroll
                for (int o = 1; o < 8; o <<= 1) ss += __shfl_xor(ss, o);
                const float rs = 1.0f / sqrtf(ss * (1.0f / 64.0f) + EPS);
                float gv[8]; unpack8(cur.gate, gv);
                const float* gain = (hj < 4 ? F.in[6] : F.in[19]) + l * 64;
                const f32x4 g0 = *(const f32x4*)(gain + 8 * p), g1 = *(const f32x4*)(gain + 8 * p + 4);
                float o[8] = {a.x * rs * g0.x, a.y * rs * g0.y, a.z * rs * g0.z, a.w * rs * g0.w, c.x * rs * g1.x, c.y * rs * g1.y, c.z * rs * g1.z, c.w * rs * g1.w};
#pragma unroll
                for (int e = 0; e < 8; ++e) o[e] *= siluf_(gv[e]);
                u32x4 w; w.x = pk2(o[0], o[1]); w.y = pk2(o[2], o[3]); w.z = pk2(o[4], o[5]); w.w = pk2(o[6], o[7]);
                *(u32x4*)(MIX + (tok0 + t) * D + (hj < 4 ? 0 : 768) + h * 64 + 8 * p) = w; }
        }
        { const int t = F.tid >> 3, c0 = (F.tid & 7) * 32; const size_t tok = tok0 + t;
            const bf16* RHL = (const bf16*)(F.ws + WS_RHL) + tok * 256; const bf16* RP = (const bf16*)(F.ws + WS_RP) + tok * 256; const float* RCA = (const float*)(F.ws + WS_RCA) + (b * NCH + n) * 256;
#pragma unroll
            for (int q = 0; q < 4; ++q) { const int c = c0 + 8 * q; float hl[8], pv[8], gc[8]; ld8(RHL + c, hl); ld8(RP + c, pv); ld8(PROJ + tok * PP + GC + c, gc);
                const f32x4 ca0 = *(const f32x4*)(RCA + c), ca1 = *(const f32x4*)(RCA + c + 4); const float ca[8] = {ca0.x, ca0.y, ca0.z, ca0.w, ca1.x, ca1.y, ca1.z, ca1.w};
                float o[8];
#pragma unroll
                for (int e = 0; e < 8; ++e) o[e] = (hl[e] + pv[e] * ca[e]) * gelu_tanh(gc[e]);
                u32x4 w; w.x = pk2(o[0], o[1]); w.y = pk2(o[2], o[3]); w.z = pk2(o[4], o[5]); w.w = pk2(o[6], o[7]);
                *(u32x4*)(MIX + tok * D + 512 + c) = w; } }
    }
    __syncthreads();
}

__device__ __forceinline__ void dbg_gdn_check(const Frame& F0, int l, int bsel, int hsel, int msel, float* dbgout) { Frame F = opq(F0);
    if (F.bid != 0) return;
    constexpr int NT = 512;
    LAS float* S = (LAS float*)F.lds;
    LAS float* qv = S + 4096; LAS float* kv = qv + 64; LAS float* vv = kv + 64; LAS float* tmp = vv + 64; LAS float* ov = tmp + 64; LAS float* sc = ov + 64;
    const bf16* PROJ = (const bf16*)(F.ws + WS_PROJ); const float* SM = (const float*)(F.ws + WS_SMALL); const bf16* MIX = (const bf16*)(F.ws + WS_HM);
    const float* cw = F.in[3] + (size_t)l * 4 * 768;
    for (int i = F.tid; i < 4096; i += NTHR) S[i] = 0.f;
    float errsum = 0.f, refsum = 0.f;
    __syncthreads();
    for (int t = 0; t < NT; ++t) {
        const size_t tok = (size_t)bsel * SEQ + t;
        if (F.tid < 192) { const int which = F.tid >> 6, d = F.tid & 63, c = which * 256 + hsel * 64 + d; float y = 0.f;
            for (int j = 0; j < 4; ++j) { const int tp = t - 3 + j; if (tp >= 0) y += bf2f(PROJ[((size_t)bsel * SEQ + tp) * PP + c]) * cw[j * 768 + c]; }
            y = y / (1.0f + expf(-y)); (which == 0 ? qv : which == 1 ? kv : vv)[d] = y; }
        __syncthreads();
        if (F.tid == 0) { float sq = 0.f, sk = 0.f; for (int d = 0; d < 64; ++d) { sq += qv[d] * qv[d]; sk += kv[d] * kv[d]; }
            sc[0] = 0.125f / sqrtf(sq + EPS); sc[1] = 1.0f / sqrtf(sk + EPS);
            sc[2] = 1.0f / (1.0f + expf(-SM[tok * 32 + hsel]));
            const float x = SM[tok * 32 + 4 + hsel] + F.in[5][l * 4 + hsel]; const float sp = fmaxf(x, 0.f) + log1pf(expf(-fabsf(x)));
            sc[3] = expf(-expf(F.in[4][l * 4 + hsel]) * sp); }
        __syncthreads();
        if (F.tid < 64) { qv[F.tid] *= sc[0]; kv[F.tid] *= sc[1]; }
        for (int i = F.tid; i < 4096; i += NTHR) S[i] *= sc[3];
        __syncthreads();
        if ((ABL & (1 << 21)) && t < 64 && F.tid < 64) { const float* dq = (const float*)(F.ctl + 8192); const int which = msel; if (which < 3) { const float r = which == 0 ? qv[F.tid] : which == 1 ? kv[F.tid] : vv[F.tid] * sc[2];
            const float m = dq[which * 4096 + t * 64 + F.tid]; errsum += (m - r) * (m - r); refsum += r * r; } }
        if ((ABL & (1 << 22)) && t < 64) { LAS float* KH = sc + 16; LAS float* GH = KH + 4096;
            if (F.tid < 64) KH[t * 64 + F.tid] = kv[F.tid];
            if (F.tid == 0) GH[t] = (t ? GH[t - 1] : 0.f) + logf(sc[3]);
            __syncthreads();
            if (F.tid <= t && msel < 2) { const int j = F.tid; float d = 0.f; for (int dk = 0; dk < 64; ++dk) d += (msel == 0 ? qv[dk] : kv[dk]) * KH[j * 64 + dk];
                float r = d * expf(GH[t] - GH[j]) * (msel == 0 ? 1.0f : sc[2]); if (msel == 1 && j == t) r = 0.f;
                const float m = ((const float*)(F.ctl + 8192 + 3 * 4096))[(msel == 0 ? 4096 : 0) + t * 64 + j]; errsum += (m - r) * (m - r); refsum += r * r; }
            __syncthreads(); }
        if (F.tid < 64) { float a = 0.f; for (int dk = 0; dk < 64; ++dk) a += S[dk * 64 + F.tid] * kv[dk]; tmp[F.tid] = sc[2] * (vv[F.tid] - a); }
        __syncthreads();
        if ((ABL & (1 << 22)) && msel == 2 && t < 64 && F.tid < 64) { const float m = ((const float*)(F.ctl + 8192 + 5 * 4096))[t * 64 + F.tid], r = tmp[F.tid]; errsum += (m - r) * (m - r); refsum += r * r; }
        for (int i = F.tid; i < 4096; i += NTHR) S[i] += kv[i >> 6] * tmp[i & 63];
        __syncthreads();
        if (F.tid < 64) { float a = 0.f; for (int dk = 0; dk < 64; ++dk) a += S[dk * 64 + F.tid] * qv[dk]; ov[F.tid] = a; }
        __syncthreads();
        if ((ABL & (1 << 21)) && msel == 3 && t < 64 && F.tid < 64) { const float* GO = (const float*)(F.ws + WS_GO) + (size_t)((bsel * NCH + 0) * 4 + hsel) * 4096;
            const float m = (ABL & (1 << 23)) ? ((const float*)(F.ctl + 8192 + 6 * 4096))[t * 64 + F.tid] : GO[t * 64 + F.tid], r = ov[F.tid]; errsum += (m - r) * (m - r); refsum += r * r; }
        if (F.tid == 0) { float ss = 0.f; for (int d = 0; d < 64; ++d) ss += ov[d] * ov[d]; sc[4] = 1.0f / sqrtf(ss / 64.0f + EPS); }
        __syncthreads();
        if (F.tid < 64) { const float gt = bf2f(PROJ[tok * PP + GA + hsel * 64 + F.tid]); const float r = ov[F.tid] * sc[4] * F.in[6][l * 64 + F.tid] * (gt / (1.0f + expf(-gt)));
            const float m = bf2f(MIX[tok * D + hsel * 64 + F.tid]);
            const bool use = msel == 0 ? true : msel == 1 ? ((t & 63) < 16) : msel == 2 ? (t < 64) : (t >= 64);
            if (use && !(ABL & (3 << 21))) { errsum += (m - r) * (m - r); refsum += r * r; } }
        __syncthreads();
    }
    if (F.tid < 64) { errsum = wave_sum(errsum); refsum = wave_sum(refsum); if (F.tid == 0) dbgout[0] = 1000.0f * sqrtf(errsum / fmaxf(refsum, 1e-30f)); }
}
#define IN_PH (lo <= ph && ph < hi)
#define END_PH do { if (IN_PH && ph + 1 < hi) xcd_barrier(bar); if (PROBE_A >= 0 && F.bid == 0 && F.tid == 0) ((volatile LAS unsigned long long*)(F.lds + MISC_OFF + 512))[ph + 1] = __builtin_amdgcn_s_memrealtime(); ++ph; } while (0)
template <int l>
__device__ __forceinline__ void layer_phases(Frame& F, const XcdBarrier& bar, const int lo, const int hi, int& ph) {
    LAS unsigned char* ring = F.lds;
    bf16* HM = (bf16*)(F.ws + WS_HM); bf16* PROJ = (bf16*)(F.ws + WS_PROJ); float* X = F.out;
        if (PHON(1) && IN_PH) {
            pg8::StaticOrder S; S.init(T, NIN, F.G, F.bid); pg8::EpiProj E{PROJ, (float*)(F.ws + WS_SMALL)};
            pg8::gemm_phase<pg8::EpiProj, pg8::StaticOrder, false>(ring, HM, (const bf16*)(F.ws + WS_WIN) + (size_t)l * NIN * D, D, S, E, nullptr); }
        END_PH;
        if (PHON(2) && IN_PH) { prep_phase(F, l); if (REPEAT & 1) { __syncthreads(); prep_phase(F, l); } }
        END_PH;
        if ((ABL & 4096) && (ABL & (1 << 24)) && l == ((ABL >> 15) & 1)) { if (IN_PH) dbg_gdn_check(F, l, (ABL >> 18) & 7, (ABL >> 16) & 3, (ABL >> 13) & 3, (float*)(F.ctl + 2048)); END_PH; }
        if (PHON(3) && IN_PH) scan_attn_phase(F, l);
        END_PH;
        if ((ABL & 4096) && (ABL & (1 << 25)) && l == ((ABL >> 15) & 1)) { if (IN_PH) dbg_gdn_check(F, l, (ABL >> 18) & 7, (ABL >> 16) & 3, (ABL >> 13) & 3, (float*)(F.ctl + 2048)); END_PH; }
        if (PHON(4) && IN_PH) { finalize_phase(F, l); if (REPEAT & 2) { __syncthreads(); finalize_phase(F, l); } }
        END_PH;
        if ((ABL & 4096) && !(ABL & (3 << 24)) && l == ((ABL >> 15) & 1)) { if (IN_PH) dbg_gdn_check(F, l, (ABL >> 18) & 7, (ABL >> 16) & 3, (ABL >> 13) & 3, (float*)(F.ctl + 2048)); END_PH; }
        if (PHON(5) && IN_PH) {
            pg8::StaticOrder S; S.init(T, D, F.G, F.bid); pg8::EpiResid E{l == 0 ? F.in[0] : (const float*)X, X};
            pg8::gemm_phase<pg8::EpiResid, pg8::StaticOrder, false>(ring, HM, (const bf16*)(F.ws + WS_WOUT) + (size_t)l * D * D, D, S, E, nullptr); }
        END_PH;
        if (l == 0) {
            if (PHON(6) && IN_PH) norm_phase(F, X, F.in[21]);
            END_PH;
            if (PHON(7) && !(ABL & 4) && IN_PH) { pg8::StaticOrder S; S.init(T, 2 * DFF, F.G, F.bid); pg8::EpiSwiglu E{PROJ, DFF, 22};
                pg8::gemm_phase<pg8::EpiSwiglu, pg8::StaticOrder, false>(ring, HM, (const bf16*)(F.ws + WS_WGU), D, S, E, nullptr); }
            END_PH;
            if (PHON(8) && !(ABL & 4) && IN_PH) { pg8::StaticOrder S; S.init(T, D, F.G, F.bid); pg8::EpiResid E{X, X};
                pg8::gemm_phase<pg8::EpiResid, pg8::StaticOrder, false>(ring, PROJ, (const bf16*)(F.ws + WS_WD), DFF, S, E, nullptr); }
            END_PH;
            if (PHON(6) && IN_PH) norm_phase(F, X, F.in[1] + D);
            END_PH;
        } else {
            if (PHON(9) && IN_PH) { norm_router_phase(F, X, F.in[21] + D, F.in[25]); __syncthreads();
                if (PROBE_A >= 0 && F.bid == 0 && F.tid == 0) ((volatile LAS unsigned long long*)(F.lds + MISC_OFF + 512))[30] = __builtin_amdgcn_s_memrealtime();
                moe_convert(F); }
            END_PH;
#define MOE_PASS(k) do {\
                const int* stok = (const int*)(F.ws + WS_STOK) + (size_t)k * NE * T; const float* sw = (const float*)(F.ws + WS_SW) + (size_t)k * NE * T;\
                if (PHON(10) && IN_PH) { pg8::MoeOrder S; S.init(F.ctl + CW_MOECNT + 8 * k, 28, F.G, F.bid); pg8::EpiSwiglu E{PROJ, DFE, 28};\
                    pg8::gemm_phase<pg8::EpiSwiglu, pg8::MoeOrder, true>(ring, HM, (const bf16*)(F.ws + WS_MOEW_GU), D, S, E, stok); }\
                END_PH;\
                if (PHON(11) && IN_PH) { pg8::MoeOrder S; S.init(F.ctl + CW_MOECNT + 8 * k, 4, F.G, F.bid); pg8::EpiScatter E{X, stok, sw, 4};\
                    pg8::gemm_phase<pg8::EpiScatter, pg8::MoeOrder, false>(ring, PROJ, (const bf16*)(F.ws + WS_MOEW_D), DFE, S, E, nullptr); }\
                END_PH; } while (0)
            MOE_PASS(0);
            MOE_PASS(1);
#undef MOE_PASS
            if (PHON(12) && IN_PH) final_norm_phase(F, X, F.in[29]);
            END_PH;
            if (ABL & 4096) { if (IN_PH) { for (size_t i = (size_t)F.bid * NTHR + F.tid; i < (size_t)T * D; i += (size_t)F.G * NTHR) X[i] = (i == 0) ? ((const float*)(F.ctl + 2048))[0] : 0.f; } END_PH; }
        }
}
#undef IN_PH
#undef END_PH
struct Args { const float* in[30]; float* out; unsigned char* ws; int ph_lo, ph_hi; };
constexpr int N_PHASES = 21 + ((ABL & 4096) ? 2 : 0);
__global__ void __launch_bounds__(NTHR, 2) fwd(Args args) {
    extern __shared__ __attribute__((aligned(16))) unsigned char lds[];
    Frame F;
    F.lds = (LAS unsigned char*)lds; F.MISC = (volatile LAS unsigned*)(F.lds + MISC_OFF);
    F.tid = threadIdx.x; F.lane = F.tid & 63; F.wave = __builtin_amdgcn_readfirstlane(F.tid >> 6);
    F.G = gridDim.x; F.bid = blockIdx.x; F.in = args.in; F.out = args.out; F.ws = args.ws; F.ctl = (unsigned*)(args.ws + WS_CTL);
    for (int u = F.tid; u < 64; u += NTHR) F.MISC[u] = 0u;
    __syncthreads();
    const int lo = args.ph_lo, hi = args.ph_hi;
    XcdBarrier bar; bar.bar = F.ctl + CW_BAR; bar.x = 0; bar.st = nullptr;
    if (hi - lo > 1) bar = xcd_barrier_post(F.ctl + CW_BAR, F.MISC + 8);
    int ph = 0;
#define IN_PH (lo <= ph && ph < hi)
#define END_PH do { if (IN_PH && ph + 1 < hi) xcd_barrier(bar); if (PROBE_A >= 0 && F.bid == 0 && F.tid == 0) ((volatile LAS unsigned long long*)(F.lds + MISC_OFF + 512))[ph + 1] = __builtin_amdgcn_s_memrealtime(); ++ph; } while (0)
    LAS unsigned char* ring = F.lds;
    bf16* HM = (bf16*)(F.ws + WS_HM); bf16* PROJ = (bf16*)(F.ws + WS_PROJ); float* X = F.out;

    if (PROBE_A >= 0 && F.bid == 0 && F.tid == 0) ((volatile LAS unsigned long long*)(F.lds + MISC_OFF + 512))[0] = __builtin_amdgcn_s_memrealtime();
    if (PHON(0) && IN_PH) p0_prologue(F);
    END_PH;
    layer_phases<0>(F, bar, lo, hi, ph);
    layer_phases<1>(F, bar, lo, hi, ph);
    if (PROBE_A >= 0 && F.bid == 0 && F.tid == 0) { volatile LAS unsigned long long* st = (volatile LAS unsigned long long*)(F.lds + MISC_OFF + 512);
        const unsigned long long d = (st[PROBE_B] - st[PROBE_A]) * 4ull, t0 = __builtin_amdgcn_s_memrealtime();
        while (__builtin_amdgcn_s_memrealtime() - t0 < d) __builtin_amdgcn_s_sleep(8); }
#undef IN_PH
#undef END_PH
}

extern "C" void kernel_launch(void* const* d_in, const int* in_sizes, int n_in, void* d_out, int out_size, void* d_ws, size_t ws_size, hipStream_t stream) {
    static int grid = 0;
    if (grid == 0) {
        if (n_in != 30 || in_sizes[0] != T * D || out_size != T * D || ws_size < WS_NEED) { fprintf(stderr, "kernel_launch: unexpected shapes (n_in %d, in0 %d, out %d, ws %zu < %zu); nothing launched\n", n_in, n_in > 0 ? in_sizes[0] : -1, out_size, ws_size, (size_t)WS_NEED); grid = -1; return; }
        int dev = 0, cus = 0, per_cu = 0;
        if (hipGetDevice(&dev) != hipSuccess || hipDeviceGetAttribute(&cus, hipDeviceAttributeMultiprocessorCount, dev) != hipSuccess) { grid = -1; return; }
        if (hipFuncSetAttribute((const void*)fwd, hipFuncAttributeMaxDynamicSharedMemorySize, LDS_BYTES) != hipSuccess) { fprintf(stderr, "kernel_launch: hipFuncSetAttribute failed\n"); grid = -1; return; }
        if (hipOccupancyMaxActiveBlocksPerMultiprocessor(&per_cu, (const void*)fwd, NTHR, LDS_BYTES) != hipSuccess || per_cu < 1) fprintf(stderr, "kernel_launch: occupancy query says %d\n", per_cu);
        (void)hipGetLastError();
        grid = cus;
    }
    if (grid < 0) return;
    if (hipMemsetAsync((char*)d_ws + WS_CTL, 0, CTL_ZERO_BYTES, stream) != hipSuccess) return;
    Args a{};
    for (int i = 0; i < 30; ++i) a.in[i] = (const float*)d_in[i];
    a.out = (float*)d_out; a.ws = (unsigned char*)d_ws;
#if MK_ONE_LAUNCH
    a.ph_lo = 0; a.ph_hi = N_PHASES;
    hipLaunchKernelGGL(fwd, dim3(grid), dim3(NTHR), LDS_BYTES, stream, a);
#else
    for (int p = 0; p < N_PHASES; ++p) { a.ph_lo = p; a.ph_hi = p + 1; hipLaunchKernelGGL(fwd, dim3(grid), dim3(NTHR), LDS_BYTES, stream, a); }
#endif
}
```
